# Optimizing an MI355X kernel written in HIP

```python
import jax, jax.numpy as jnp
from jax import lax
import numpy as np

D_MODEL = 1024
BATCH = 8
SEQ = 8192
DEPTH = 4

GRID_W = 64
CTX_LEN = 256
N_MIXERS = 3
N_A = len(range(0, DEPTH, N_MIXERS))
N_B = len(range(1, DEPTH, N_MIXERS))
N_C = len(range(2, DEPTH, N_MIXERS))
GMLP_CHUNK = 128
GMLP_HALF = 2 * D_MODEL
GMLP_GROUPS = 8
DIFF_HEADS = 8
DIFF_HEAD_DIM = 64
DIFF_VALUE_DIM = 2 * DIFF_HEAD_DIM
DIFF_SCALE = DIFF_HEAD_DIM ** -0.5
ROPE_BASE = 10000.0
Q_BLOCK = 128
CONV_WIDTH = 3
N_EXPERTS = 32
TOP_K = 4
EXPERT_FF = D_MODEL
SWIGLU_LIMIT = 7.0
SWIGLU_ALPHA = 1.702
MOE_BLOCK = 256
DEEPNORM_ALPHA = (2 * DEPTH) ** 0.25
DEEPNORM_BETA = (8 * DEPTH) ** -0.25
LN_EPS = 1e-5

kernel_name = 'hybrid_interleaved_gmlp_diffattn_shortconv_moe_dit'


def layer_norm(x, g, b):
    xf = x.astype(jnp.float32)
    mu = jnp.mean(xf, -1, keepdims=True)
    var = jnp.mean(jnp.square(xf - mu), -1, keepdims=True)
    return ((xf - mu) * lax.rsqrt(var + LN_EPS) * g + b).astype(x.dtype)


def rms_norm(x, g):
    xf = x.astype(jnp.float32)
    ms = jnp.mean(jnp.square(xf), -1, keepdims=True)
    return (xf * lax.rsqrt(ms + LN_EPS) * g).astype(x.dtype)


def modulate(x, shift, scale):
    return x * (1 + scale) + shift


def chunk_gmlp(h, w_in, ln_g, ln_b, w_s, b_s, w_out):
    B, L, _ = h.shape
    z = jax.nn.gelu(h @ w_in, approximate=False)
    u, v = z[..., :GMLP_HALF], z[..., GMLP_HALF:]
    v = layer_norm(v, ln_g, ln_b)
    v = v.reshape(B, L // GMLP_CHUNK, GMLP_CHUNK, GMLP_GROUPS, GMLP_HALF // GMLP_GROUPS)
    v = jnp.einsum('gpq,bnqge->bnpge', w_s.astype(v.dtype), v) + b_s.T[None, None, :, :, None]
    return (u * v.reshape(B, L, GMLP_HALF)) @ w_out


def rope_1d(x, pos):
    n = x.shape[-1] // 2
    inv = ROPE_BASE ** (-jnp.arange(n, dtype=jnp.float32) / n)
    ang = pos.astype(jnp.float32)[:, None] * inv
    shape = (1, pos.shape[0]) + (1,) * (x.ndim - 3) + (n,)
    cos = jnp.cos(ang).reshape(shape).astype(x.dtype)
    sin = jnp.sin(ang).reshape(shape).astype(x.dtype)
    x1, x2 = x[..., :n], x[..., n:]
    return jnp.concatenate([x1 * cos - x2 * sin, x1 * sin + x2 * cos], -1)


def axial_rope(x, rows, cols):
    half = x.shape[-1] // 2
    return jnp.concatenate([rope_1d(x[..., :half], rows), rope_1d(x[..., half:], cols)], -1)


def diff_attention(h_l, h_c, w_qkv, lam_params, subln_g, w_o, lam_init, rows, cols, need_ctx):
    B, S, _ = h_l.shape
    qk_w = DIFF_HEADS * 2 * DIFF_HEAD_DIM

    def project(h):
        qkv = h @ w_qkv
        lead = h.shape[:2]
        q = qkv[..., :qk_w].reshape(lead + (DIFF_HEADS, 2, DIFF_HEAD_DIM))
        k = qkv[..., qk_w:2 * qk_w].reshape(lead + (DIFF_HEADS, 2, DIFF_HEAD_DIM))
        v = qkv[..., 2 * qk_w:].reshape(lead + (DIFF_HEADS, DIFF_VALUE_DIM))
        return q, k, v

    q_l, k_l, v_l = project(h_l)
    q_l = axial_rope(q_l, rows, cols)
    k_l = axial_rope(k_l, rows, cols)
    q_c, k_c, v_c = project(h_c)
    lp = lam_params.astype(jnp.float32)
    lam = jnp.exp(jnp.sum(lp[0] * lp[1])) - jnp.exp(jnp.sum(lp[2] * lp[3])) + lam_init
    k_all = jnp.concatenate([k_c, k_l], axis=1)
    v_all = jnp.concatenate([v_c, v_l], axis=1)

    def attend(q, k, v):
        s = jnp.einsum('bqhcd,bkhcd->bhcqk', q, k).astype(jnp.float32) * DIFF_SCALE
        p = jax.nn.softmax(s, axis=-1)
        a = p[:, :, 0] - lam * p[:, :, 1]
        return jnp.einsum('bhqk,bkhe->bqhe', a.astype(v.dtype), v)

    n_blk = S // Q_BLOCK
    qb = q_l.reshape(B, n_blk, Q_BLOCK, DIFF_HEADS, 2, DIFF_HEAD_DIM).swapaxes(0, 1)
    o_l = lax.map(lambda q: attend(q, k_all, v_all), qb)
    o_l = o_l.swapaxes(0, 1).reshape(B, S, DIFF_HEADS, DIFF_VALUE_DIM)

    def finish(o):
        o = rms_norm(o, subln_g) * (1.0 - lam_init)
        return o.reshape(o.shape[:2] + (DIFF_HEADS * DIFF_VALUE_DIM,)) @ w_o

    y_l = finish(o_l)
    y_c = finish(attend(q_c, k_c, v_c)) if need_ctx else None
    return y_c, y_l


def depthwise_conv(x, w):
    pad = CONV_WIDTH // 2
    return lax.conv_general_dilated(
        x, w[:, None, :].astype(x.dtype), window_strides=(1,), padding=((pad, pad),),
        dimension_numbers=('NWC', 'WIO', 'NWC'), feature_group_count=x.shape[-1])


def short_conv(h, w_in, conv_w, w_out):
    bch = h @ w_in
    b_g, c_g, hx = jnp.split(bch, 3, axis=-1)
    return (b_g * depthwise_conv(c_g * hx, conv_w)) @ w_out


def expert_swiglu(xb, w_gu, b_gu, w_dn, b_dn):
    gu = xb @ w_gu + b_gu
    gate = jnp.minimum(gu[..., :EXPERT_FF], SWIGLU_LIMIT)
    up = jnp.clip(gu[..., EXPERT_FF:], -SWIGLU_LIMIT, SWIGLU_LIMIT)
    glu = gate * jax.nn.sigmoid(gate * SWIGLU_ALPHA)
    return ((up + 1) * glu) @ w_dn + b_dn


def moe_ffn(h, w_router, b_router, w_gu, b_gu, w_dn, b_dn):
    T, D = h.shape
    logits = (h @ w_router).astype(jnp.float32) + b_router.astype(jnp.float32)
    top_logit, top_e = lax.top_k(logits, TOP_K)
    gates = jax.nn.softmax(top_logit, axis=-1)
    n_assign = T * TOP_K
    flat_e = top_e.reshape(-1)
    order = jnp.argsort(flat_e)
    sorted_e = flat_e[order]
    counts = jnp.bincount(flat_e, length=N_EXPERTS)
    padded = (counts + MOE_BLOCK - 1) // MOE_BLOCK * MOE_BLOCK
    pad_end = jnp.cumsum(padded)
    pad_start = pad_end - padded
    start = jnp.cumsum(counts) - counts
    dest = pad_start[sorted_e] + jnp.arange(n_assign) - start[sorted_e]
    n_blocks = -(-n_assign // MOE_BLOCK) + N_EXPERTS
    n_slots = n_blocks * MOE_BLOCK
    slot_token = jnp.full((n_slots,), T, jnp.int32).at[dest].set((order // TOP_K).astype(jnp.int32))
    slot_gate = jnp.zeros((n_slots,), jnp.float32).at[dest].set(gates.reshape(-1)[order])
    block_e = jnp.minimum(
        jnp.searchsorted(pad_end, jnp.arange(n_blocks) * MOE_BLOCK, side='right'), N_EXPERTS - 1)
    h_pad = jnp.concatenate([h, jnp.zeros((1, D), h.dtype)], axis=0)

    def run_block(args):
        tok, g, e = args
        y = expert_swiglu(h_pad[tok], w_gu[e], b_gu[e], w_dn[e], b_dn[e])
        return y * g[:, None].astype(y.dtype)

    y = lax.map(run_block, (slot_token.reshape(n_blocks, MOE_BLOCK),
                            slot_gate.reshape(n_blocks, MOE_BLOCK), block_e))
    out = jax.ops.segment_sum(y.reshape(n_slots, D), slot_token, num_segments=T + 1)
    return out[:T]


def setup_inputs(seed: int = 0) -> dict:
    key = jax.random.key(seed)
    ks = iter(jax.random.split(key, 32))
    D = D_MODEL
    f32 = jnp.float32

    def nrm(shape, scale):
        return jax.random.normal(next(ks), shape, f32) * scale

    qkv_w = 2 * (DIFF_HEADS * 2 * DIFF_HEAD_DIM) + DIFF_HEADS * DIFF_VALUE_DIM
    return {
        'x': nrm((BATCH, SEQ, D), 1.0),
        'c': nrm((BATCH, D), 1.0),
        'ctx': nrm((BATCH, CTX_LEN, D), 1.0),
        'c_ctx': nrm((D,), 1.0),
        'w_mod': nrm((DEPTH, D, 6 * D), D ** -0.5),
        'b_mod': nrm((DEPTH, 6 * D), 0.02),
        'ln_g': 1.0 + nrm((DEPTH, 2, D), 0.02),
        'ln_b': nrm((DEPTH, 2, D), 0.02),
        'gmlp_w_in': nrm((N_A, D, 2 * GMLP_HALF), D ** -0.5),
        'gmlp_ln_g': 1.0 + nrm((N_A, GMLP_HALF), 0.02),
        'gmlp_ln_b': nrm((N_A, GMLP_HALF), 0.02),
        'gmlp_w_s': nrm((N_A, GMLP_GROUPS, GMLP_CHUNK, GMLP_CHUNK), GMLP_CHUNK ** -0.5),
        'gmlp_b_s': 1.0 + nrm((N_A, GMLP_GROUPS, GMLP_CHUNK), 0.02),
        'gmlp_w_out': nrm((N_A, GMLP_HALF, D), GMLP_HALF ** -0.5 * DEEPNORM_BETA),
        'diff_w_qkv': nrm((N_B, D, qkv_w), D ** -0.5),
        'diff_lambda': nrm((N_B, 4, DIFF_HEAD_DIM), 0.1),
        'diff_subln_g': 1.0 + nrm((N_B, DIFF_VALUE_DIM), 0.02),
        'diff_w_o': nrm((N_B, DIFF_HEADS * DIFF_VALUE_DIM, D),
                        (DIFF_HEADS * DIFF_VALUE_DIM) ** -0.5 * DEEPNORM_BETA),
        'conv_w_in': nrm((N_C, D, 3 * D), D ** -0.5),
        'conv_w': nrm((N_C, CONV_WIDTH, D), CONV_WIDTH ** -0.5),
        'conv_w_out': nrm((N_C, D, D), D ** -0.5 * DEEPNORM_BETA),
        'moe_w_router': nrm((DEPTH, D, N_EXPERTS), D ** -0.5),
        'moe_b_router': nrm((DEPTH, N_EXPERTS), 0.01),
        'moe_w_gate_up': nrm((DEPTH, N_EXPERTS, D, 2 * EXPERT_FF), D ** -0.5),
        'moe_b_gate_up': nrm((DEPTH, N_EXPERTS, 2 * EXPERT_FF), 0.02),
        'moe_w_down': nrm((DEPTH, N_EXPERTS, EXPERT_FF, D), EXPERT_FF ** -0.5 * DEEPNORM_BETA),
        'moe_b_down': nrm((DEPTH, N_EXPERTS, D), 0.02),
    }


def reference(x, c, ctx, c_ctx, w_mod, b_mod, ln_g, ln_b,
              gmlp_w_in, gmlp_ln_g, gmlp_ln_b, gmlp_w_s, gmlp_b_s, gmlp_w_out,
              diff_w_qkv, diff_lambda, diff_subln_g, diff_w_o,
              conv_w_in, conv_w, conv_w_out,
              moe_w_router, moe_b_router, moe_w_gate_up, moe_b_gate_up, moe_w_down, moe_b_down):
    D = D_MODEL
    S = x.shape[1]
    t = jnp.arange(S)
    rows, cols = t // GRID_W, t % GRID_W
    cond_l = jax.nn.silu(c)
    cond_c = jax.nn.silu(c_ctx)
    for i in range(DEPTH):
        last = i == DEPTH - 1
        kind = i % N_MIXERS
        j = i // N_MIXERS
        mod_l = jnp.split((cond_l @ w_mod[i] + b_mod[i])[:, None, :], 6, axis=-1)
        mod_c = jnp.split((cond_c @ w_mod[i] + b_mod[i])[None, None, :], 6, axis=-1)
        h_l = modulate(x, mod_l[0], mod_l[1])
        h_c = modulate(ctx, mod_c[0], mod_c[1]) if (kind == 1 or not last) else None
        if kind == 0:
            y_l = chunk_gmlp(h_l, gmlp_w_in[j], gmlp_ln_g[j], gmlp_ln_b[j], gmlp_w_s[j], gmlp_b_s[j], gmlp_w_out[j])
            y_c = None if last else chunk_gmlp(h_c, gmlp_w_in[j], gmlp_ln_g[j], gmlp_ln_b[j],
                                               gmlp_w_s[j], gmlp_b_s[j], gmlp_w_out[j])
        elif kind == 1:
            lam_init = 0.8 - 0.6 * float(np.exp(-0.3 * i))
            y_c, y_l = diff_attention(h_l, h_c, diff_w_qkv[j], diff_lambda[j], diff_subln_g[j], diff_w_o[j],
                                      lam_init, rows, cols, not last)
        else:
            y_l = short_conv(h_l, conv_w_in[j], conv_w[j], conv_w_out[j])
            y_c = None if last else short_conv(h_c, conv_w_in[j], conv_w[j], conv_w_out[j])
        x = layer_norm(DEEPNORM_ALPHA * x + mod_l[2] * y_l, ln_g[i, 0], ln_b[i, 0])
        if not last:
            ctx = layer_norm(DEEPNORM_ALPHA * ctx + mod_c[2] * y_c, ln_g[i, 0], ln_b[i, 0])
        h_l = modulate(x, mod_l[3], mod_l[4])
        moe_args = (moe_w_router[i], moe_b_router[i], moe_w_gate_up[i], moe_b_gate_up[i],
                    moe_w_down[i], moe_b_down[i])
        if last:
            y_l = moe_ffn(h_l.reshape(-1, D), *moe_args).reshape(h_l.shape)
        else:
            h_c = modulate(ctx, mod_c[3], mod_c[4])
            n_ctx = h_c.shape[0] * h_c.shape[1]
            y = moe_ffn(jnp.concatenate([h_c.reshape(-1, D), h_l.reshape(-1, D)], axis=0), *moe_args)
            y_c = y[:n_ctx].reshape(h_c.shape)
            y_l = y[n_ctx:].reshape(h_l.shape)
            ctx = layer_norm(DEEPNORM_ALPHA * ctx + mod_c[5] * y_c, ln_g[i, 1], ln_b[i, 1])
        x = layer_norm(DEEPNORM_ALPHA * x + mod_l[5] * y_l, ln_g[i, 1], ln_b[i, 1])
    return x
```

```cpp
#include <hip/hip_runtime.h>
#include <hip/hip_bf16.h>
#include <cstdio>
#include <cstdint>
#include <cmath>

#define GAS __attribute__((address_space(1)))
#define LAS __attribute__((address_space(3)))
typedef unsigned short bf16_t;
typedef short bf16x8 __attribute__((ext_vector_type(8)));
typedef short s16x4 __attribute__((ext_vector_type(4)));
typedef float f32x4 __attribute__((ext_vector_type(4)));
typedef float f32x2 __attribute__((ext_vector_type(2)));
typedef float f32x16 __attribute__((ext_vector_type(16)));
typedef unsigned u32x4 __attribute__((ext_vector_type(4)));
typedef unsigned u32x2 __attribute__((ext_vector_type(2)));
typedef GAS unsigned gu32;
#define RLX_AGENT __ATOMIC_RELAXED, __HIP_MEMORY_SCOPE_AGENT

constexpr int DM = 1024, NB = 8, SEQ = 8192, CTXL = 256, DEPTH = 4;
constexpr int NCTX = NB * CTXL;
constexpr int NLAT = NB * SEQ;
constexpr int TALL = NCTX + NLAT;
constexpr int NEXP = 32, TOPK = 4;
constexpr int NBLK_MAX = TALL * TOPK / 256 + NEXP;
constexpr int NSLOT_MAX = NBLK_MAX * 256;
constexpr float LN_EPS = 1e-5f;
constexpr float DN_ALPHA = 1.681792830507429f;
constexpr float LAM_INIT = 0.35550906759096927f;
constexpr int NWAVES = 8;

constexpr size_t MiB = 1u << 20;
constexpr size_t WS_CTL = 0, CTL_ZERO_BYTES = 1 * MiB;
constexpr size_t WS_MOD = 1 * MiB;
constexpr size_t WS_ROPE = 2 * MiB;
constexpr size_t WS_META = 2 * MiB + 64 * 1024;
constexpr size_t WS_STAT = 3 * MiB;
constexpr size_t WS_LOGIT = 4 * MiB;
constexpr size_t WS_TOKE = 13 * MiB;
constexpr size_t WS_TOKG = 15 * MiB;
constexpr size_t WS_SLOTTOK = 17 * MiB;
constexpr size_t WS_SLOTGATE = 19 * MiB;
constexpr size_t WS_SLOTDST = 21 * MiB;
constexpr size_t WS_WIN = 24 * MiB;
constexpr size_t WS_WOUT = 40 * MiB;
constexpr size_t WS_WS = 48 * MiB;
constexpr size_t WS_WQKV = 49 * MiB;
constexpr size_t WS_WO = 55 * MiB;
constexpr size_t WS_CWIN = 57 * MiB;
constexpr size_t WS_CWOUT = 63 * MiB;
constexpr size_t WS_WR = 65 * MiB;
constexpr size_t WS_WGU = 68 * MiB;
constexpr size_t WS_WDN = 580 * MiB;
constexpr size_t WS_X = 836 * MiB;
constexpr size_t WS_H = 1100 * MiB;
constexpr size_t WS_Y = 1234 * MiB;
constexpr size_t WS_R1 = 1368 * MiB;
constexpr size_t R1_Z = 0, R1_VT = 528 * MiB, R1_T = 792 * MiB;
constexpr size_t R1_Q = 0, R1_K = 132 * MiB, R1_V = 264 * MiB, R1_O = 396 * MiB;
constexpr size_t R1_P = 0, R1_BG = 132 * MiB, R1_T2 = 264 * MiB;
constexpr size_t R1_ACT = 0, R1_YK = 544 * MiB;
static_assert(R1_V - R1_K == R1_K - R1_Q, "Q | K | V equally spaced");
constexpr size_t WS_END = WS_R1 + 1080 * MiB;
static_assert((size_t)TALL * 4096 * 2 <= 528 * MiB && (size_t)NSLOT_MAX * 1024 * 2 <= 544 * MiB && (size_t)TALL * 4 * 1024 * 2 <= 528 * MiB, "R1 map");
static_assert((size_t)(TALL + 256) * 1024 * 2 <= 134 * MiB && (size_t)TALL * 1024 * 4 <= 264 * MiB, "X/H map");
constexpr int CW_TMO = 0;
constexpr int CW_CNT = 1024;
constexpr int CW_CUR = 2048;
constexpr int CW_BAR = 4096;

constexpr int RING_BYTES = 131072;
constexpr int MISC_OFF = RING_BYTES;
constexpr int LDS_BYTES = 147456;

#define LDS_WAIT() asm volatile("s_waitcnt lgkmcnt(0)" ::: "memory")
#define VM_WAIT() asm volatile("s_waitcnt vmcnt(0)" ::: "memory")

__device__ __forceinline__ unsigned f2bf(float f) { unsigned u = __builtin_bit_cast(unsigned, f); return (u + 0x7fffu + ((u >> 16) & 1u)) >> 16; }
__device__ __forceinline__ unsigned pk2(float lo, float hi) { return f2bf(lo) | (f2bf(hi) << 16); }
__device__ __forceinline__ float bf2f(unsigned short b) { return __builtin_bit_cast(float, (unsigned)b << 16); }
__device__ __forceinline__ float bflo(unsigned w) { return __builtin_bit_cast(float, w << 16); }
__device__ __forceinline__ float bfhi(unsigned w) { return __builtin_bit_cast(float, w & 0xffff0000u); }
__device__ __forceinline__ unsigned cvt_pk_bf16(float lo, float hi) { unsigned r; asm volatile("v_cvt_pk_bf16_f32 %0, %1, %2" : "=v"(r) : "v"(lo), "v"(hi)); return r; }
__device__ __forceinline__ int opaque_tid() { int t = threadIdx.x; asm volatile("" : "+v"(t)); return t; }
__device__ __forceinline__ float wave_sum(float v) {
#pragma unroll
    for (int o = 1; o < 64; o <<= 1) v += __shfl_xor(v, o);
    return v;
}

#define XB_TMO      128
#define XB_XCNT(j)  (256  + 64 * (j))
#define XB_XSUB(j)  (1280 + 64 * (j))
#define XB_XGEN(j)  (2304 + 64 * (j))
#define XB_TOP      3328
#define XB_TOPGEN   3392
#define XCD_BAR_WORDS 3456
#define XB_SPIN_CAP (1u << 22)

__device__ __forceinline__ unsigned xb_ld(unsigned* p)              { return __hip_atomic_load(p, __ATOMIC_RELAXED, __HIP_MEMORY_SCOPE_AGENT); }
__device__ __forceinline__ unsigned xb_add(unsigned* p, unsigned v) { return __hip_atomic_fetch_add(p, v, __ATOMIC_RELAXED, __HIP_MEMORY_SCOPE_AGENT); }
__device__ __forceinline__ unsigned xb_xcc_id() { return (unsigned)__builtin_amdgcn_s_getreg((3 << 11) | 20) & 0xFu; }
#define XB_SPIN(cond, bar) do { unsigned _sp = 0; while (cond) { __builtin_amdgcn_s_sleep(1); \
    if ((++_sp & 255u) == 0u) { if (xb_ld(&(bar)[XB_TMO])) break; if (_sp > XB_SPIN_CAP) { atomicAdd(&(bar)[XB_TMO], 1u); break; } } } } while (0)

struct XcdBarrier { unsigned* bar; unsigned x; volatile LAS unsigned* st; };

__device__ __forceinline__ XcdBarrier xcd_barrier_post(unsigned* bar, volatile LAS unsigned* st) {
    XcdBarrier b; b.bar = bar; b.x = xb_xcc_id(); b.st = st;
    if (threadIdx.x == 0) (void)xb_add(&bar[XB_XCNT(b.x)], 1u);
    return b;
}
__device__ __forceinline__ void xcd_barrier_complete(unsigned* bar, unsigned x, unsigned& nloc, unsigned& nx) {
    const unsigned G = gridDim.x * gridDim.y * gridDim.z;
    unsigned sum, cnt, mine, sp = 0u;
    for (;;) {
        sum = 0u; cnt = 0u; mine = 0u;
#pragma unroll
        for (unsigned j = 0; j < 16; ++j) { const unsigned c = xb_ld(&bar[XB_XCNT(j)]); sum += c; cnt += (c > 0u) ? 1u : 0u; mine = (j == x) ? c : mine; }
        if (sum == G) break;
        __builtin_amdgcn_s_sleep(1);
        if ((++sp & 255u) == 0u) { if (xb_ld(&bar[XB_TMO])) break; if (sp > XB_SPIN_CAP) { atomicAdd(&bar[XB_TMO], 1u); break; } }
    }
    nloc = mine > 0u ? mine : 1u; nx = cnt > 0u ? cnt : 1u;
}
__device__ __forceinline__ void xcd_barrier(const XcdBarrier& b) {
    asm volatile("s_waitcnt vmcnt(0)" ::: "memory");
    __syncthreads();
    if (threadIdx.x == 0) {
        GAS unsigned* gbar_ = (GAS unsigned*)b.bar; asm volatile("" : "+s"(gbar_)); unsigned* bar = (unsigned*)gbar_; const unsigned bx_ = (unsigned)__builtin_amdgcn_readfirstlane((int)xb_xcc_id());
        __builtin_amdgcn_s_waitcnt(0);
        unsigned nloc = b.st[0], nx = b.st[1];
        if (nloc == 0u) { xcd_barrier_complete(bar, bx_, nloc, nx); b.st[0] = nloc; b.st[1] = nx; }
        const unsigned old = xb_add(&bar[XB_XSUB(bx_)], 1u);
        const unsigned gen = old / nloc;
        if (old + 1u == (gen + 1u) * nloc) {
            __builtin_amdgcn_fence(__ATOMIC_RELEASE, "agent");
            asm volatile("s_waitcnt vmcnt(0)" ::: "memory");
            const unsigned og = xb_add(&bar[XB_TOP], 1u);
            const unsigned tg = og / nx;
            if (og + 1u == (tg + 1u) * nx) xb_add(&bar[XB_TOPGEN], 1u);
            else XB_SPIN(xb_ld(&bar[XB_TOPGEN]) == tg, bar);
            __builtin_amdgcn_fence(__ATOMIC_ACQUIRE, "agent");
            xb_add(&bar[XB_XGEN(bx_)], 1u);
            asm volatile("s_waitcnt vmcnt(0)" ::: "memory");
        } else {
            XB_SPIN(xb_ld(&bar[XB_XGEN(bx_)]) == gen, bar);
            __builtin_amdgcn_fence(__ATOMIC_ACQUIRE, "agent");
            asm volatile("s_waitcnt vmcnt(0)" ::: "memory");
        }
    }
    __syncthreads();
}

namespace pg8 {
constexpr int BM = 256, BK = 64, HALF = 128, HTB = HALF * BK * 2, STAGE_BYTES = 8 * HTB, NXCD = 8, WGM = 8;
__host__ __device__ __forceinline__ int lds_byte(int r, int c) { const int st = (r >> 4) * 2 + (c >> 5), rr = r & 15, cc = c & 31, ob = rr * 64 + cc * 2; return st * 1024 + (ob ^ (((ob >> 9) & 1) << 5)); }
__host__ __device__ __forceinline__ void stage_rc(int b, int& R, int& C) { const int st = b / 1024, sb = b % 1024, swz = sb ^ (((sb >> 9) & 1) << 5); R = (st >> 1) * 16 + swz / 64; C = (st & 1) * 32 + (swz % 64) / 2; }
__host__ __device__ __forceinline__ int perm32(int rho) { const int n = rho >> 4, i = rho & 15; return 8 * (i >> 2) + 4 * n + (i & 3); }

struct Unit { int pm, pn, e; };

struct TileOrder {
    int nM, nN, nwg, G, c;
    __device__ __forceinline__ void init(int nM_, int nN_, int G_, int c_) { nM = nM_; nN = nN_; nwg = nM * nN; G = G_; c = c_; }
    __device__ __forceinline__ bool tile(int i, int& pm, int& pn) const {
        const long L = (long)i * G + c; if (L >= nwg) return false;
        int wgid = (int)L; { const int q = nwg / NXCD, r = nwg % NXCD, xcd = wgid % NXCD, off = wgid / NXCD; wgid = (xcd < r ? xcd * (q + 1) : r * (q + 1) + (xcd - r) * q) + off; }
        const int nig = WGM * nN, gid = wgid / nig, fm = gid * WGM, gsz = (nM - fm) < WGM ? (nM - fm) : WGM;
        pm = fm + ((wgid % nig) % gsz); pn = (wgid % nig) / gsz; return true;
    }
};
struct DenseSched {
    TileOrder o; int K;
    __device__ __forceinline__ bool next(int i, Unit& u) const { u.e = 0; return o.tile(i, u.pm, u.pn); }
    __device__ __forceinline__ unsigned a_row(const Unit& u, int r) const { return (unsigned)(u.pm * BM + r); }
    __device__ __forceinline__ size_t b_off(const Unit& u) const { return (size_t)u.pn * BM * K; }
};
template <bool GATHER> struct MoeSched {
    TileOrder o; int K, N; const int* block_e; const int* slot_tok;
    __device__ __forceinline__ bool next(int i, Unit& u) const {
        if (!o.tile(i, u.pm, u.pn)) return false;
        u.e = __builtin_amdgcn_readfirstlane((int)__hip_atomic_load((const unsigned*)block_e + u.pm, RLX_AGENT)); return true; }
    __device__ __forceinline__ unsigned a_row(const Unit& u, int r) const { if (GATHER) return (unsigned)slot_tok[u.pm * BM + r]; else return (unsigned)(u.pm * BM + r); }
    __device__ __forceinline__ size_t b_off(const Unit& u) const { return ((size_t)u.e * N + (size_t)u.pn * BM) * K; }
};

__device__ __forceinline__ f32x2 gelu_pk(f32x2 v) {
    const f32x2 av = __builtin_elementwise_abs(v), d = av * 0.2316418882f + 1.0f;
    f32x2 t; t.x = __builtin_amdgcn_rcpf(d.x); t.y = __builtin_amdgcn_rcpf(d.y);
    f32x2 q = t * 0.5307027145f + (-0.7265760135f); q = q * t + 0.7107068705f; q = q * t + (-0.142248368f); q = q * t + 0.127414796f; q = q * t;
    const f32x2 s = (v * v) * (-0.72134752044f);
    f32x2 e; e.x = __builtin_amdgcn_exp2f(s.x); e.y = __builtin_amdgcn_exp2f(s.y);
    const f32x2 m = v * (q * e), r = v - m;
    f32x2 o; o.x = v.x < 0.f ? m.x : r.x; o.y = v.y < 0.f ? m.y : r.y; return o;
}
__device__ __forceinline__ u32x4 pack8(f32x4 v0, f32x4 v1) { u32x4 w; w.x = cvt_pk_bf16(v0[0], v0[1]); w.y = cvt_pk_bf16(v0[2], v0[3]); w.z = cvt_pk_bf16(v1[0], v1[1]); w.w = cvt_pk_bf16(v1[2], v1[3]); return w; }
__device__ __forceinline__ u32x2 pack4(f32x4 v) { u32x2 w; w.x = cvt_pk_bf16(v[0], v[1]); w.y = cvt_pk_bf16(v[2], v[3]); return w; }

template <int ACT> struct EpiBf16 {
    static constexpr bool PERM = true;
    bf16_t* O; int ldc;
    __device__ __forceinline__ void operator()(const f32x4 (&acc)[2][2][4][2], const Unit& u, int wr, int wc, int fr, int fq) const {
        const int row0 = u.pm * BM + wr * 64 + fr, col0 = u.pn * BM + wc * 32 + 8 * fq;
#pragma unroll
        for (int ai = 0; ai < 2; ++ai)
#pragma unroll
            for (int m = 0; m < 4; ++m) { bf16_t* rowp = O + (size_t)(row0 + ai * HALF + m * 16) * ldc + col0;
#pragma unroll
                for (int bj = 0; bj < 2; ++bj) { f32x4 v0 = acc[ai][bj][m][0], v1 = acc[ai][bj][m][1];
                    if (ACT == 1) { f32x2 a = gelu_pk((f32x2){v0[0], v0[1]}), b = gelu_pk((f32x2){v0[2], v0[3]}), c = gelu_pk((f32x2){v1[0], v1[1]}), d = gelu_pk((f32x2){v1[2], v1[3]});
                        v0 = (f32x4){a.x, a.y, b.x, b.y}; v1 = (f32x4){c.x, c.y, d.x, d.y}; }
                    *(u32x4*)(rowp + bj * HALF) = pack8(v0, v1); } }
    }
};
struct EpiQKV {
    static constexpr bool PERM = false;
    bf16_t* Q; size_t qkv_stride; const float* ropec; const float* ropes;
    __device__ __forceinline__ void operator()(const f32x4 (&acc)[2][2][4][2], const Unit& u, int wr, int wc, int fr, int fq) const {
        const int t = u.pn >> 2, colt = (u.pn & 3) * BM;
        bf16_t* base = Q + (size_t)t * qkv_stride;
#pragma unroll
        for (int ai = 0; ai < 2; ++ai)
#pragma unroll
            for (int m = 0; m < 4; ++m) {
                const int row = u.pm * BM + ai * HALF + wr * 64 + m * 16 + fr;
                f32x4 cs = (f32x4){1.f, 1.f, 1.f, 1.f}, sn = (f32x4){0.f, 0.f, 0.f, 0.f};
                if (t < 2 && row >= NCTX) { const int tp = (row - NCTX) & (SEQ - 1); const int pos = (wc & 1) ? (tp & 63) : (tp >> 6);
                    cs = *(const f32x4*)(ropec + pos * 16 + 4 * fq); sn = *(const f32x4*)(ropes + pos * 16 + 4 * fq); }
                bf16_t* rowp = base + (size_t)row * DM + colt + wc * 32 + 4 * fq;
#pragma unroll
                for (int bj = 0; bj < 2; ++bj) { const f32x4 x1 = acc[ai][bj][m][0], x2 = acc[ai][bj][m][1];
                    const f32x4 o1 = x1 * cs - x2 * sn, o2 = x1 * sn + x2 * cs;
                    *(u32x2*)(rowp + bj * HALF) = pack4(o1); *(u32x2*)(rowp + bj * HALF + 16) = pack4(o2); } }
    }
};
struct EpiConvIn {
    static constexpr bool PERM = true;
    bf16_t* P; bf16_t* BG;
    __device__ __forceinline__ void operator()(const f32x4 (&acc)[2][2][4][2], const Unit& u, int wr, int wc, int fr, int fq) const {
        const int row0 = u.pm * BM + wr * 64 + fr;
#pragma unroll
        for (int ai = 0; ai < 2; ++ai)
#pragma unroll
            for (int m = 0; m < 4; ++m) { const size_t row = (size_t)(row0 + ai * HALF + m * 16);
                if (u.pn < 8) { *(u32x4*)(P + row * DM + u.pn * HALF + wc * 32 + 8 * fq) = pack8(acc[ai][0][m][0] * acc[ai][1][m][0], acc[ai][0][m][1] * acc[ai][1][m][1]); }
                else {
#pragma unroll
                    for (int bj = 0; bj < 2; ++bj) *(u32x4*)(BG + row * DM + (u.pn - 8) * BM + bj * HALF + wc * 32 + 8 * fq) = pack8(acc[ai][bj][m][0], acc[ai][bj][m][1]); } }
    }
};
struct EpiRouter {
    static constexpr bool PERM = false;
    float* L;
    __device__ __forceinline__ void operator()(const f32x4 (&acc)[2][2][4][2], const Unit& u, int wr, int wc, int fr, int fq) const {
        if (wc != 0) return;
#pragma unroll
        for (int ai = 0; ai < 2; ++ai)
#pragma unroll
            for (int m = 0; m < 4; ++m) { float* rowp = L + (size_t)(u.pm * BM + ai * HALF + wr * 64 + m * 16 + fr) * NEXP + 4 * fq;
                *(f32x4*)(rowp) = acc[ai][0][m][0]; *(f32x4*)(rowp + 16) = acc[ai][0][m][1]; }
    }
};
struct EpiMoe1 {
    static constexpr bool PERM = true;
    bf16_t* ACT; const float* bgu;
    __device__ __forceinline__ void operator()(const f32x4 (&acc)[2][2][4][2], const Unit& u, int wr, int wc, int fr, int fq) const {
        const int ff0 = u.pn * HALF + wc * 32 + 8 * fq; const float* bias = bgu + (size_t)u.e * 2048;
        f32x4 bg[2], bu[2];
#pragma unroll
        for (int n = 0; n < 2; ++n) { bg[n] = *(const f32x4*)(bias + ff0 + 4 * n); bu[n] = *(const f32x4*)(bias + 1024 + ff0 + 4 * n); }
#pragma unroll
        for (int ai = 0; ai < 2; ++ai)
#pragma unroll
            for (int m = 0; m < 4; ++m) { const size_t row = (size_t)(u.pm * BM + ai * HALF + wr * 64 + m * 16 + fr);
                f32x4 o[2];
#pragma unroll
                for (int n = 0; n < 2; ++n) { const f32x4 gv = acc[ai][0][m][n] + bg[n], uv = acc[ai][1][m][n] + bu[n];
#pragma unroll
                    for (int j = 0; j < 4; ++j) { const float g = fminf(gv[j], 7.0f), up = fminf(fmaxf(uv[j], -7.0f), 7.0f);
                        const float sg = __builtin_amdgcn_rcpf(1.0f + __builtin_amdgcn_exp2f(g * (-1.702f * 1.4426950408889634f)));
                        o[n][j] = (up + 1.0f) * (g * sg); } }
                *(u32x4*)(ACT + row * DM + ff0) = pack8(o[0], o[1]); }
    }
};
struct EpiMoe2 {
    static constexpr bool PERM = true;
    bf16_t* YK; const float* bdn; const int* slot_dst; const float* slot_gate;
    __device__ __forceinline__ void operator()(const f32x4 (&acc)[2][2][4][2], const Unit& u, int wr, int wc, int fr, int fq) const {
        const int col0 = u.pn * BM + wc * 32 + 8 * fq; const float* bias = bdn + (size_t)u.e * 1024;
        f32x4 bv[2][2];
#pragma unroll
        for (int bj = 0; bj < 2; ++bj)
#pragma unroll
            for (int n = 0; n < 2; ++n) bv[bj][n] = *(const f32x4*)(bias + col0 + bj * HALF + 4 * n);
#pragma unroll
        for (int ai = 0; ai < 2; ++ai)
#pragma unroll
            for (int m = 0; m < 4; ++m) { const int slot = u.pm * BM + ai * HALF + wr * 64 + m * 16 + fr;
                const int dst = slot_dst[slot]; const float gate = slot_gate[slot];
                if (dst >= 0) { bf16_t* rowp = YK + (size_t)dst * DM + col0;
#pragma unroll
                    for (int bj = 0; bj < 2; ++bj) *(u32x4*)(rowp + bj * HALF) = pack8((acc[ai][bj][m][0] + bv[bj][0]) * gate, (acc[ai][bj][m][1] + bv[bj][1]) * gate); } }
    }
};

template <class Epi, class Sched, bool ALIGN_EPI>
__device__ __forceinline__ void gemm_phase(LAS unsigned char* lds, const bf16_t* A, const bf16_t* Bt, const int K, const Sched& S, const Epi& E) {
    const int tid = opaque_tid(), wid = __builtin_amdgcn_readfirstlane(tid >> 6), lane = tid & 63, wr = wid >> 2, wc = wid & 3, fr = lane & 15, fq = lane >> 4;
    const int nt = K / BK;
    int sR[2], sC[2]; unsigned voffB[2];
#pragma unroll
    for (int i = 0; i < 2; ++i) { stage_rc(tid * 16 + i * 8192, sR[i], sC[i]); const int Rb = Epi::PERM ? ((sR[i] & ~31) + perm32(sR[i] & 31)) : sR[i];
        voffB[i] = (unsigned)(Rb * K + sC[i]) * 2u; }
    const size_t kstep = (size_t)(BK * 2);
    const size_t hstep = (size_t)HALF * K * 2;
    const unsigned ldsw = (unsigned)wid * 1024u;
    const int aoff = lds_byte(wr * 64 + fr, fq * 8), boff = lds_byte(wc * 32 + fr, fq * 8);
#define PG8_SA(b, h) (((b) * 2 + (h)) * HTB)
#define PG8_SB(b, h) ((4 + (b) * 2 + (h)) * HTB)
#define PG8_STAGE(bufoff, gbase, v0, v1) do { \
        __builtin_amdgcn_global_load_lds((const unsigned*)((const char*)(gbase) + (v0)), (LAS unsigned*)(lds + (bufoff) + ldsw), 16, 0, 0); \
        __builtin_amdgcn_global_load_lds((const unsigned*)((const char*)(gbase) + (v1)), (LAS unsigned*)(lds + (bufoff) + ldsw + 8192), 16, 0, 0); } while (0)
#define PG8_LDA(dst, b, h) do { _Pragma("unroll") for (int m = 0; m < 4; ++m) _Pragma("unroll") for (int k = 0; k < 2; ++k) dst[m][k] = *(const LAS bf16x8*)(lds + PG8_SA(b, h) + aoff + m * 2048 + k * 1024); } while (0)
#define PG8_LDB(dst, b, h) do { _Pragma("unroll") for (int n = 0; n < 2; ++n) _Pragma("unroll") for (int k = 0; k < 2; ++k) dst[n][k] = *(const LAS bf16x8*)(lds + PG8_SB(b, h) + boff + n * 2048 + k * 1024); } while (0)
#define PG8_MMA(ai, bj, At, Bt_) do { __builtin_amdgcn_s_setprio(1); _Pragma("unroll") for (int m = 0; m < 4; ++m) _Pragma("unroll") for (int n = 0; n < 2; ++n) _Pragma("unroll") for (int k = 0; k < 2; ++k) \
        acc[ai][bj][m][n] = __builtin_amdgcn_mfma_f32_16x16x32_bf16(Bt_[n][k], At[m][k], acc[ai][bj][m][n], 0, 0, 0); __builtin_amdgcn_s_setprio(0); } while (0)
#define PG8_WAIT_V(n) asm volatile("s_waitcnt vmcnt(" #n ")" ::: "memory")
#define PG8_WAIT_L(n) asm volatile("s_waitcnt lgkmcnt(" #n ")" ::: "memory")
#define PG8_BAR __builtin_amdgcn_s_barrier()
#define PG8_SCHED __builtin_amdgcn_sched_barrier(0)
#define PG8_AOFF(dst, u) do { _Pragma("unroll") for (int h = 0; h < 2; ++h) _Pragma("unroll") for (int i = 0; i < 2; ++i) dst[h][i] = (S.a_row(u, h * HALF + sR[i]) * (unsigned)K + (unsigned)sC[i]) * 2u; } while (0)
    Unit cur, nxt; int ui = 0;
    if (!S.next(0, cur)) return;
    f32x4 acc[2][2][4][2];
#pragma unroll
    for (int a = 0; a < 2; ++a)
#pragma unroll
        for (int b = 0; b < 2; ++b)
#pragma unroll
            for (int m = 0; m < 4; ++m)
#pragma unroll
                for (int n = 0; n < 2; ++n) acc[a][b][m][n] = (f32x4){0.f, 0.f, 0.f, 0.f};
    bf16x8 At[4][2], B0[2][2], B1[2][2];
    unsigned vA[2][2], vN[2][2];
    PG8_AOFF(vA, cur);
    const char* const cA = (const char*)A;
    const char* cB = (const char*)Bt + S.b_off(cur) * 2;
    PG8_STAGE(PG8_SB(0, 0), cB, voffB[0], voffB[1]); PG8_STAGE(PG8_SB(0, 1), cB + hstep, voffB[0], voffB[1]); PG8_STAGE(PG8_SA(0, 0), cA, vA[0][0], vA[0][1]); PG8_STAGE(PG8_SA(0, 1), cA, vA[1][0], vA[1][1]);
    if (wr == 1) PG8_BAR;
    PG8_WAIT_V(2); PG8_BAR;
    PG8_STAGE(PG8_SB(1, 0), cB + kstep, voffB[0], voffB[1]); PG8_STAGE(PG8_SA(1, 0), cA + kstep, vA[0][0], vA[0][1]); PG8_STAGE(PG8_SB(1, 1), cB + hstep + kstep, voffB[0], voffB[1]);
    PG8_WAIT_V(6); PG8_BAR;
    for (;;) {
        const bool has_next = S.next(ui + 1, nxt);
        const char* nB = cB;
        if (has_next) { PG8_AOFF(vN, nxt); nB = (const char*)Bt + S.b_off(nxt) * 2; }
        else {
#pragma unroll
            for (int h = 0; h < 2; ++h)
#pragma unroll
                for (int i = 0; i < 2; ++i) vN[h][i] = vA[h][i]; }
        for (int t = 0; t < nt; t += 2) {
            const bool last = (t == nt - 2);
            const char* a1 = cA + (size_t)(t + 1) * kstep;
            const char* a2 = last ? cA : cA + (size_t)(t + 2) * kstep; const char* b2 = last ? nB : cB + (size_t)(t + 2) * kstep;
            const char* a3 = a2 + kstep; const char* b3 = b2 + kstep;
            const unsigned w00 = last ? vN[0][0] : vA[0][0], w01 = last ? vN[0][1] : vA[0][1], w10 = last ? vN[1][0] : vA[1][0], w11 = last ? vN[1][1] : vA[1][1];
            PG8_LDB(B0, 0, 0); PG8_LDB(B1, 0, 1); PG8_SCHED; PG8_LDA(At, 0, 0); PG8_STAGE(PG8_SA(1, 1), a1, vA[1][0], vA[1][1]);
            PG8_WAIT_V(8); PG8_WAIT_L(0); PG8_BAR; PG8_MMA(0, 0, At, B0); PG8_MMA(0, 1, At, B1); PG8_BAR; PG8_SCHED;
            PG8_LDA(At, 0, 1); PG8_STAGE(PG8_SB(0, 0), b2, voffB[0], voffB[1]); PG8_STAGE(PG8_SB(0, 1), b2 + hstep, voffB[0], voffB[1]); PG8_STAGE(PG8_SA(0, 0), a2, w00, w01);
            PG8_WAIT_V(8); PG8_WAIT_L(0); PG8_BAR; PG8_MMA(1, 0, At, B0); PG8_MMA(1, 1, At, B1); PG8_BAR; PG8_SCHED;
            PG8_LDB(B0, 1, 0); PG8_LDB(B1, 1, 1); PG8_SCHED; PG8_LDA(At, 1, 0); PG8_STAGE(PG8_SA(0, 1), a2, w10, w11);
            PG8_WAIT_V(8); PG8_WAIT_L(0); PG8_BAR; PG8_MMA(0, 0, At, B0); PG8_MMA(0, 1, At, B1); PG8_BAR; PG8_SCHED;
            PG8_LDA(At, 1, 1); PG8_STAGE(PG8_SB(1, 0), b3, voffB[0], voffB[1]); PG8_STAGE(PG8_SB(1, 1), b3 + hstep, voffB[0], voffB[1]); PG8_STAGE(PG8_SA(1, 0), a3, w00, w01);
            PG8_WAIT_V(8); PG8_WAIT_L(0); PG8_BAR; PG8_MMA(1, 0, At, B0); PG8_MMA(1, 1, At, B1); PG8_BAR; PG8_SCHED;
        }
        if constexpr (ALIGN_EPI) { if (wr == 0) PG8_BAR; }
        E(acc, cur, wr, wc, fr, fq);
        if (!has_next) break;
#pragma unroll
        for (int a = 0; a < 2; ++a)
#pragma unroll
            for (int b = 0; b < 2; ++b)
#pragma unroll
                for (int m = 0; m < 4; ++m)
#pragma unroll
                    for (int n = 0; n < 2; ++n) acc[a][b][m][n] = (f32x4){0.f, 0.f, 0.f, 0.f};
        cur = nxt; cB = nB; ++ui;
#pragma unroll
        for (int h = 0; h < 2; ++h)
#pragma unroll
            for (int i = 0; i < 2; ++i) vA[h][i] = vN[h][i];
        if constexpr (ALIGN_EPI) { if (wr == 1) PG8_BAR; }
    }
    PG8_WAIT_V(0);
    if constexpr (!ALIGN_EPI) { if (wr == 0) PG8_BAR; }
    PG8_BAR;
#undef PG8_SA
#undef PG8_SB
#undef PG8_STAGE
#undef PG8_LDA
#undef PG8_LDB
#undef PG8_MMA
#undef PG8_WAIT_V
#undef PG8_WAIT_L
#undef PG8_BAR
#undef PG8_SCHED
#undef PG8_AOFF
}
}

namespace att {
constexpr int QBLK = 32, KVBLK = 64;
constexpr float SCALE = 0.125f;
constexpr float THR = 8.f;
constexpr int SHM_V = KVBLK * 128 * 2, SHM_K = KVBLK * 128 * 2;
constexpr int LDS_WSF = 2 * SHM_V + 2 * SHM_K;
#define KSWZ(row, colB) ((row) * 256 + ((colB) ^ (((row) & 7) << 4)))
#define SBAR() __builtin_amdgcn_sched_barrier(0)
__device__ __forceinline__ int crow(int r, int hi) { return (r & 3) + 8 * (r >> 2) + 4 * hi; }

__device__ __forceinline__ void partialSM(f32x16& p0, f32x16& p1, float& m_reg, float& mn, float& alpha) {
  constexpr float C = SCALE * 1.4426950408889634f;
  float pmax = p0[0];
#pragma unroll
  for (int r = 1; r < 16; ++r) pmax = fmaxf(pmax, p0[r]);
#pragma unroll
  for (int r = 0; r < 16; ++r) pmax = fmaxf(pmax, p1[r]);
  { auto rr = __builtin_amdgcn_permlane32_swap(__float_as_uint(pmax), __float_as_uint(pmax), false, false);
    pmax = fmaxf(__uint_as_float(rr[0]), __uint_as_float(rr[1])); }
  if (__builtin_expect(__all(pmax - m_reg <= THR / SCALE), 1)) { mn = m_reg; alpha = 1.f; }
  else { mn = fmaxf(m_reg, pmax); alpha = __builtin_amdgcn_exp2f((m_reg - mn) * C); m_reg = mn; }
  const float mnC = -mn * C;
#pragma unroll
  for (int r = 0; r < 16; ++r) p0[r] = fmaf(p0[r], C, mnC);
#pragma unroll
  for (int r = 0; r < 16; ++r) p1[r] = fmaf(p1[r], C, mnC);
#pragma unroll
  for (int r = 0; r < 16; ++r) p0[r] = __builtin_amdgcn_exp2f(p0[r]);
}
__device__ __forceinline__ void finishSM(f32x16& p0, f32x16& p1, float alpha, float& l_reg, bf16x8& pa0, bf16x8& pa1, bf16x8& pa2, bf16x8& pa3) {
#pragma unroll
  for (int r = 0; r < 16; ++r) p1[r] = __builtin_amdgcn_exp2f(p1[r]);
  float ps = 0;
#pragma unroll
  for (int r = 0; r < 16; ++r) ps += p0[r];
#pragma unroll
  for (int r = 0; r < 16; ++r) ps += p1[r];
  { auto rr = __builtin_amdgcn_permlane32_swap(__float_as_uint(ps), __float_as_uint(ps), false, false);
    ps = __uint_as_float(rr[0]) + __uint_as_float(rr[1]); }
  l_reg = l_reg * alpha + ps;
#define PK4(P, BASE, OUT) do { unsigned a0 = cvt_pk_bf16(P[BASE + 0], P[BASE + 1]), a1 = cvt_pk_bf16(P[BASE + 2], P[BASE + 3]);   \
    unsigned b0 = cvt_pk_bf16(P[BASE + 4], P[BASE + 5]), b1 = cvt_pk_bf16(P[BASE + 6], P[BASE + 7]);                              \
    auto r0 = __builtin_amdgcn_permlane32_swap(a0, b0, false, false); auto r1 = __builtin_amdgcn_permlane32_swap(a1, b1, false, false); \
    u32x4 w = {r0[0], r1[0], r0[1], r1[1]}; OUT = __builtin_bit_cast(bf16x8, w); } while (0)
  PK4(p0, 0, pa0); PK4(p0, 8, pa1); PK4(p1, 0, pa2); PK4(p1, 8, pa3);
#undef PK4
}
__device__ __forceinline__ void qkt(f32x16& p0, f32x16& p1, const char* Ks, const bf16x8* qr, int r32, int hi, int cq) {
  p0 = f32x16{}; p1 = f32x16{};
#pragma unroll
  for (int d0 = 0; d0 < 4; ++d0) { const int cb = (cq * 64 + d0 * 16 + hi * 8) * 2;
    const bf16x8 b0 = *reinterpret_cast<const bf16x8*>(Ks + KSWZ(r32, cb));
    const bf16x8 b1 = *reinterpret_cast<const bf16x8*>(Ks + KSWZ(32 + r32, cb));
    p0 = __builtin_amdgcn_mfma_f32_32x32x16_bf16(b0, qr[d0], p0, 0, 0, 0);
    p1 = __builtin_amdgcn_mfma_f32_32x32x16_bf16(b1, qr[d0], p1, 0, 0, 0); }
}
__device__ __forceinline__ int v_st(int k, int c) { const int kk = (k & ~0xC) | ((k & 4) << 1) | ((k & 8) >> 1); return ((kk >> 3) * 4 + (c >> 5)) * 512 + ((kk & 7) * 32 + (c & 31)) * 2; }
__device__ __forceinline__ int v_rd_base(int lane) { return ((lane & 3) << 3) | (((lane >> 2) & 3) << 6) | (((lane >> 4) & 1) << 5) | (((lane >> 5) & 1) << 8); }
constexpr int v_rd_off(int d0, int ks, int half) { return d0 * 512 + ks * 4096 + half * 2048; }
template <int OFF> __device__ __forceinline__ s16x4 tr_read(int vb) {
  s16x4 r; asm volatile("ds_read_b64_tr_b16 %0, %1 offset:%2" : "=&v"(r) : "v"(vb), "i"(OFF) : "memory"); return r;
}
template <int D0> __device__ __forceinline__ void pv_one(f32x16& od, int vb, bf16x8 pa0, bf16x8 pa1, bf16x8 pa2, bf16x8 pa3) {
  const s16x4 l0 = tr_read<v_rd_off(D0, 0, 0)>(vb), h0 = tr_read<v_rd_off(D0, 0, 1)>(vb), l1 = tr_read<v_rd_off(D0, 1, 0)>(vb), h1 = tr_read<v_rd_off(D0, 1, 1)>(vb);
  const s16x4 l2 = tr_read<v_rd_off(D0, 2, 0)>(vb), h2 = tr_read<v_rd_off(D0, 2, 1)>(vb), l3 = tr_read<v_rd_off(D0, 3, 0)>(vb), h3 = tr_read<v_rd_off(D0, 3, 1)>(vb);
  asm volatile("s_waitcnt lgkmcnt(0)" ::: "memory"); SBAR();
#define PK(L, H) (bf16x8){L[0], L[1], L[2], L[3], H[0], H[1], H[2], H[3]}
  od = __builtin_amdgcn_mfma_f32_32x32x16_bf16(pa0, PK(l0, h0), od, 0, 0, 0);
  od = __builtin_amdgcn_mfma_f32_32x32x16_bf16(pa1, PK(l1, h1), od, 0, 0, 0);
  od = __builtin_amdgcn_mfma_f32_32x32x16_bf16(pa2, PK(l2, h2), od, 0, 0, 0);
  od = __builtin_amdgcn_mfma_f32_32x32x16_bf16(pa3, PK(l3, h3), od, 0, 0, 0);
#undef PK
}
__device__ __forceinline__ void pv_d0(f32x16* o, int vb, bf16x8 pa0, bf16x8 pa1, bf16x8 pa2, bf16x8 pa3) {
  pv_one<0>(o[0], vb, pa0, pa1, pa2, pa3); pv_one<1>(o[1], vb, pa0, pa1, pa2, pa3); pv_one<2>(o[2], vb, pa0, pa1, pa2, pa3); pv_one<3>(o[3], vb, pa0, pa1, pa2, pa3);
}

__device__ __forceinline__ void attn_unit(const bf16_t* __restrict__ Q, const bf16_t* __restrict__ Kb, const bf16_t* __restrict__ Vb, bf16_t* __restrict__ O,
                                          int qrow0, int kc0, int kl0, int NT, int h, float lam, const float* __restrict__ subg, char* lds) {
  const int tid = opaque_tid(), wid = __builtin_amdgcn_readfirstlane(tid >> 6), lane = tid & 63, r32 = lane & 31, hi = lane >> 5;
  const int cq = wid >> 2, wq = wid & 3;
  char* V_lds = lds; char* K_lds = lds + 2 * SHM_V;
  float* ws = (float*)(lds + LDS_WSF) + wid * 64; float* li_l = ws; float* al_l = ws + 32;
  float m_reg = -1e30f, l_reg = 0; f32x16 o[4] = {}; bf16x8 qr[4];
  const bf16_t* Qw = Q + (size_t)(qrow0 + wq * QBLK + r32) * DM + h * 128 + cq * 64 + hi * 8;
#pragma unroll
  for (int d0 = 0; d0 < 4; ++d0) qr[d0] = *reinterpret_cast<const bf16x8*>(Qw + d0 * 16);
  const int sr = tid >> 4, sc = (tid & 15) * 8, vst0 = v_st(sr, sc), vst1 = v_st(32 + sr, sc);
  const int vb0 = (int)(uintptr_t)V_lds + v_rd_base(lane);
  const bf16_t* Kh = Kb + h * 128 + sc; const bf16_t* Vh = Vb + h * 128 + sc;
  struct { bf16x8 vs0, vs1, ks0, ks1; } sr_[2];
#define KROW(j) ((j) < 4 ? kc0 + 64 * (j) : kl0 + 64 * ((j) - 4))
#define SLOAD(i, j) do { const size_t k0_ = (size_t)KROW(j); sr_[i].vs0 = *(const bf16x8*)(Vh + (k0_ + sr) * DM); sr_[i].vs1 = *(const bf16x8*)(Vh + (k0_ + 32 + sr) * DM); \
    sr_[i].ks0 = *(const bf16x8*)(Kh + (k0_ + sr) * DM); sr_[i].ks1 = *(const bf16x8*)(Kh + (k0_ + 32 + sr) * DM); } while (0)
#define SWRITE(b, i) do { *(bf16x8*)(V_lds + (b) * SHM_V + vst0) = sr_[i].vs0; *(bf16x8*)(V_lds + (b) * SHM_V + vst1) = sr_[i].vs1; const int kc = sc * 2; \
    *(bf16x8*)(K_lds + (b) * SHM_K + KSWZ(sr, kc)) = sr_[i].ks0; *(bf16x8*)(K_lds + (b) * SHM_K + KSWZ(32 + sr, kc)) = sr_[i].ks1; } while (0)
#define SWAIT() asm volatile("s_waitcnt vmcnt(4)" ::: "memory")
#define RESC(a) do { if (__any((a) < 1.f)) { if (hi == 0) al_l[r32] = (a); asm volatile("s_waitcnt lgkmcnt(0)" ::: "memory"); \
    _Pragma("unroll") for (int d = 0; d < 4; ++d) _Pragma("unroll") for (int r = 0; r < 16; ++r) o[d][r] *= al_l[crow(r, hi)]; } } while (0)
  f32x16 pA0, pA1, pB0, pB1; float mnA, mnB, alA, alB; bf16x8 pa0, pa1, pa2, pa3;
  constexpr int SE = 0, SO = 1;
  SLOAD(SE, 0); asm volatile("s_waitcnt vmcnt(0)" ::: "memory"); SWRITE(0, SE); __syncthreads();
  qkt(pA0, pA1, K_lds, qr, r32, hi, cq); partialSM(pA0, pA1, m_reg, mnA, alA);
  SLOAD(SO, 1); if (2 < NT) SLOAD(SE, 2);
  SWAIT(); SWRITE(1, SO); __syncthreads();
  for (int j = 1; j + 1 < NT; j += 2) {
    SBAR(); qkt(pB0, pB1, K_lds + SHM_K, qr, r32, hi, cq);
    finishSM(pA0, pA1, alA, l_reg, pa0, pa1, pa2, pa3); SBAR();
    SLOAD(SO, j + 2); SBAR();
    pv_d0(o, vb0, pa0, pa1, pa2, pa3); partialSM(pB0, pB1, m_reg, mnB, alB);
    __syncthreads(); SWAIT(); SWRITE(0, SE);
    RESC(alB); __syncthreads();
    SBAR(); qkt(pA0, pA1, K_lds, qr, r32, hi, cq);
    finishSM(pB0, pB1, alB, l_reg, pa0, pa1, pa2, pa3); SBAR();
    if (j + 3 < NT) SLOAD(SE, j + 3); SBAR();
    pv_d0(o, vb0 + SHM_V, pa0, pa1, pa2, pa3); partialSM(pA0, pA1, m_reg, mnA, alA);
    __syncthreads(); SWAIT(); SWRITE(1, SO);
    RESC(alA); __syncthreads();
  }
  SBAR(); qkt(pB0, pB1, K_lds + SHM_K, qr, r32, hi, cq);
  finishSM(pA0, pA1, alA, l_reg, pa0, pa1, pa2, pa3); SBAR();
  pv_d0(o, vb0, pa0, pa1, pa2, pa3); partialSM(pB0, pB1, m_reg, mnB, alB);
  __syncthreads(); RESC(alB);
  finishSM(pB0, pB1, alB, l_reg, pa0, pa1, pa2, pa3); SBAR();
  pv_d0(o, vb0 + SHM_V, pa0, pa1, pa2, pa3);
  if (hi == 0) li_l[r32] = l_reg; asm volatile("s_waitcnt lgkmcnt(0)" ::: "memory");
  float rli[16];
#pragma unroll
  for (int r = 0; r < 16; ++r) rli[r] = __builtin_amdgcn_rcpf(li_l[crow(r, hi)]);
  asm volatile("s_waitcnt vmcnt(0)" ::: "memory");
  __syncthreads();
  float* xb = (float*)lds + wq * (32 * 128);
  if (cq == 1) {
#pragma unroll
    for (int r = 0; r < 16; ++r)
#pragma unroll
      for (int d0 = 0; d0 < 4; ++d0) xb[crow(r, hi) * 128 + d0 * 32 + r32] = o[d0][r] * rli[r];
  }
  asm volatile("s_waitcnt lgkmcnt(0)" ::: "memory");
  __syncthreads();
  if (cq == 0) {
    float ss[16];
#pragma unroll
    for (int r = 0; r < 16; ++r) { float s = 0.f;
#pragma unroll
      for (int d0 = 0; d0 < 4; ++d0) { const float v = o[d0][r] * rli[r] - lam * xb[crow(r, hi) * 128 + d0 * 32 + r32]; o[d0][r] = v; s += v * v; }
      ss[r] = s; }
#pragma unroll
    for (int r = 0; r < 16; ++r) { float s = ss[r];
      s += __shfl_xor(s, 1); s += __shfl_xor(s, 2); s += __shfl_xor(s, 4); s += __shfl_xor(s, 8); s += __shfl_xor(s, 16);
      ss[r] = __builtin_amdgcn_rsqf(s * (1.0f / 128.0f) + LN_EPS) * (1.0f - LAM_INIT); }
    float gsub[4];
#pragma unroll
    for (int d0 = 0; d0 < 4; ++d0) gsub[d0] = subg[d0 * 32 + r32];
    bf16_t* Ow = O + (size_t)(qrow0 + wq * QBLK) * DM + h * 128;
#pragma unroll
    for (int r = 0; r < 16; ++r) { const int orow = crow(r, hi);
#pragma unroll
      for (int d0 = 0; d0 < 4; ++d0) Ow[(size_t)orow * DM + d0 * 32 + r32] = (bf16_t)f2bf(o[d0][r] * ss[r] * gsub[d0]); }
  }
  asm volatile("s_waitcnt lgkmcnt(0)" ::: "memory");
  __syncthreads();
#undef KROW
#undef SLOAD
#undef SWRITE
#undef SWAIT
#undef RESC
}
#undef KSWZ
#undef SBAR
}

struct Args { const float* in[27]; float* out; unsigned char* ws; };
enum { IN_X = 0, IN_C, IN_CTX, IN_CCTX, IN_WMOD, IN_BMOD, IN_LNG, IN_LNB, IN_GWIN, IN_GLNG, IN_GLNB, IN_GWS, IN_GBS, IN_GWOUT, IN_DWQKV, IN_DLAM, IN_DSUBG, IN_DWO,
       IN_CWIN, IN_CW, IN_CWOUT, IN_MWR, IN_MBR, IN_MWGU, IN_MBGU, IN_MWDN, IN_MBDN };


__device__ __forceinline__ const float* inp_ptr(int k) {
    const __attribute__((address_space(4))) char* kp = (const __attribute__((address_space(4))) char*)__builtin_amdgcn_kernarg_segment_ptr();
    asm volatile("" : "+s"(kp));
    return (const float*)*(GAS const float* const __attribute__((address_space(4)))*)(kp + 8 * k);
}
#define INP(k) inp_ptr(k)

struct Frame {
    LAS unsigned char* lds; char* ldsg;
    int tid, lane, wave, G, gw, NGW, bid;
    float* out; unsigned char* ws; gu32* ctl;
};

__device__ __forceinline__ int drow_map(int kind, int n) {
    if (kind == 1) { if (n < 1024) return 256 * (n >> 7) + (n & 127); const int ff = n - 1024; return 256 * (ff >> 7) + 128 + (ff & 127); }
    if (kind == 2) { if (n < 1024) return 2048 + n; if (n < 2048) { const int ch = n - 1024; return 256 * (ch >> 7) + (ch & 127); } const int ch = n - 2048; return 256 * (ch >> 7) + 128 + (ch & 127); }
    return n;
}
__device__ __forceinline__ void p0_transpose_item(const float* W, int K, int N, bf16_t* WT, int kind, LAS float* scr, int item, int lane) {
    const int nblk = N / 32, kb = item / nblk, nb = item % nblk, k0 = 64 * kb, n0 = 32 * nb;
#pragma unroll 8
    for (int i = 0; i < 32; ++i) { const int kk = 2 * i + (lane >> 5); scr[kk * 33 + (lane & 31)] = W[(size_t)(k0 + kk) * N + n0 + (lane & 31)]; }
    LDS_WAIT(); asm volatile("" ::: "memory");
    const int c = lane & 7; const int d0 = drow_map(kind, n0);
#pragma unroll
    for (int j = 0; j < 4; ++j) { const int n = (lane >> 3) + 8 * j; const LAS float* s = scr + (8 * c) * 33 + n;
        u32x4 o; o.x = pk2(s[0 * 33], s[1 * 33]); o.y = pk2(s[2 * 33], s[3 * 33]); o.z = pk2(s[4 * 33], s[5 * 33]); o.w = pk2(s[6 * 33], s[7 * 33]);
        *(GAS u32x4*)(WT + (size_t)(d0 + n) * K + k0 + 8 * c) = o; }
    LDS_WAIT(); asm volatile("" ::: "memory");
}
__device__ __forceinline__ void p0_job(Frame& F, LAS float* scr, long& base, const float* src, int K, int N, int M, bf16_t* dst, int ND, int kind) {
    const int per = (K / 64) * (N / 32); const long tot = (long)per * M;
    long first = (long)F.gw - (base % F.NGW); if (first < 0) first += F.NGW;
    for (long it = first; it < tot; it += F.NGW) { const int mtx = (int)(it / per), loc = (int)(it % per);
        p0_transpose_item(src + (size_t)mtx * K * N, K, N, dst + (size_t)mtx * ND * K, kind, scr, loc, F.lane); }
    base += tot;
}
__device__ __forceinline__ void p0_weights(Frame& F) {
    LAS float* scr = (LAS float*)(F.lds + F.wave * 16384);
    long base = 0;
    p0_job(F, scr, base, INP(IN_GWIN), 1024, 4096, 2, (bf16_t*)(F.ws + WS_WIN), 4096, 0);
    p0_job(F, scr, base, INP(IN_GWOUT), 2048, 1024, 2, (bf16_t*)(F.ws + WS_WOUT), 1024, 0);
    p0_job(F, scr, base, INP(IN_DWQKV), 1024, 3072, 1, (bf16_t*)(F.ws + WS_WQKV), 3072, 0);
    p0_job(F, scr, base, INP(IN_DWO), 1024, 1024, 1, (bf16_t*)(F.ws + WS_WO), 1024, 0);
    p0_job(F, scr, base, INP(IN_CWIN), 1024, 3072, 1, (bf16_t*)(F.ws + WS_CWIN), 3072, 2);
    p0_job(F, scr, base, INP(IN_CWOUT), 1024, 1024, 1, (bf16_t*)(F.ws + WS_CWOUT), 1024, 0);
    p0_job(F, scr, base, INP(IN_MWR), 1024, 32, 4, (bf16_t*)(F.ws + WS_WR), 256, 0);
    p0_job(F, scr, base, INP(IN_MWGU), 1024, 2048, 128, (bf16_t*)(F.ws + WS_WGU), 2048, 1);
    p0_job(F, scr, base, INP(IN_MWDN), 1024, 1024, 128, (bf16_t*)(F.ws + WS_WDN), 1024, 0);
    { const float* src = INP(IN_GWS); bf16_t* dst = (bf16_t*)(F.ws + WS_WS); const int n4 = 2 * 8 * 128 * 128 / 4;
      for (int i = F.gw * 64 + F.lane; i < n4; i += F.NGW * 64) { const f32x4 v = *(const f32x4*)(src + 4 * (size_t)i); u32x2 w; w.x = pk2(v[0], v[1]); w.y = pk2(v[2], v[3]); *(u32x2*)(dst + 4 * (size_t)i) = w; } }
}
__device__ __forceinline__ void p0_mod(Frame& F) {
    LAS float* cond = (LAS float*)(F.lds);
    LAS float* red = (LAS float*)(F.lds + 40960);
    const int nitem = 4 * 96;
    if (F.bid >= nitem) return;
    for (int i = F.tid; i < 9 * 1024; i += 512) { const int m = i >> 10, k = i & 1023; const float c = (m < 8) ? INP(IN_C)[m * 1024 + k] : INP(IN_CCTX)[k]; cond[i] = c / (1.0f + __expf(-c)); }
    __syncthreads();
    float* MOD = (float*)(F.ws + WS_MOD);
    for (int it = F.bid; it < nitem; it += F.G) {
        const int layer = it / 96, n0 = (it % 96) * 64;
        const float* W = INP(IN_WMOD) + (size_t)layer * 1024 * 6144 + n0 + F.lane;
        float acc[9];
#pragma unroll
        for (int m = 0; m < 9; ++m) acc[m] = 0.f;
        const int kb = F.wave * 128;
#pragma unroll 8
        for (int k = 0; k < 128; ++k) { const float w = W[(size_t)(kb + k) * 6144];
#pragma unroll
            for (int m = 0; m < 9; ++m) acc[m] += cond[m * 1024 + kb + k] * w; }
#pragma unroll
        for (int m = 0; m < 9; ++m) red[(F.wave * 9 + m) * 64 + F.lane] = acc[m];
        __syncthreads();
        for (int i = F.tid; i < 9 * 64; i += 512) { const int m = i >> 6, l = i & 63; float s = 0.f;
#pragma unroll
            for (int w = 0; w < 8; ++w) s += red[(w * 9 + m) * 64 + l];
            MOD[((size_t)layer * 9 + m) * 6144 + n0 + l] = s + INP(IN_BMOD)[layer * 6144 + n0 + l]; }
        __syncthreads();
    }
}
__device__ __forceinline__ void p0_misc(Frame& F) {
    const int gt = F.bid * 512 + F.tid;
    if (gt < 2048) { const int pos = gt >> 4, i = gt & 15; const float inv = powf(10000.0f, -(float)i / 16.0f); const float ang = (float)pos * inv; float s, c; sincosf(ang, &s, &c);
        ((float*)(F.ws + WS_ROPE))[gt] = c; ((float*)(F.ws + WS_ROPE))[2048 + gt] = s; }
    if (F.bid == F.G - 1) { bf16_t* H = (bf16_t*)(F.ws + WS_H); for (int i = F.tid; i < 1024; i += 512) H[(size_t)TALL * DM + i] = 0; }
}

__device__ __forceinline__ int mod_index(int row) { return row < NCTX ? 8 : ((row - NCTX) >> 13); }

template <int MODE>
__device__ __forceinline__ void row_pass(Frame& F, int layer, bool first_layer_x, bool final_out) {
    const float* MOD = (const float*)(F.ws + WS_MOD);
    float* X = (float*)(F.ws + WS_X); bf16_t* H = (bf16_t*)(F.ws + WS_H);
    const bf16_t* Y = (const bf16_t*)(F.ws + WS_Y); const bf16_t* YK = (const bf16_t*)(F.ws + WS_R1 + R1_YK);
    const int rpw = (TALL + F.NGW - 1) / F.NGW;
    const int r0 = F.gw * rpw, r1 = (r0 + rpw < TALL) ? r0 + rpw : TALL;
    const int sub = (MODE == 2) ? 1 : 0;
    const int gate_i = (MODE == 2) ? 5 : 2;
    const int nlayer = (MODE == 2) ? layer + 1 : layer;
    const int sh_i = (MODE == 1) ? 3 : 0, sc_i = (MODE == 1) ? 4 : 1;
    f32x4 lg[4], lb[4], gt[4], sh[4], sc[4];
    if (MODE != 0) {
#pragma unroll
        for (int j = 0; j < 4; ++j) { lg[j] = *(const f32x4*)(INP(IN_LNG) + (layer * 2 + sub) * 1024 + 4 * F.lane + 256 * j); lb[j] = *(const f32x4*)(INP(IN_LNB) + (layer * 2 + sub) * 1024 + 4 * F.lane + 256 * j); } }
    int curm = -1;
    for (int row = r0; row < r1; ++row) {
        const int mi = mod_index(row);
        if (mi != curm) { curm = mi;
#pragma unroll
            for (int j = 0; j < 4; ++j) { const int c = 4 * F.lane + 256 * j;
                if (MODE != 0) gt[j] = *(const f32x4*)(MOD + ((size_t)layer * 9 + mi) * 6144 + gate_i * 1024 + c);
                if (!final_out) { sh[j] = *(const f32x4*)(MOD + ((size_t)nlayer * 9 + mi) * 6144 + sh_i * 1024 + c); sc[j] = *(const f32x4*)(MOD + ((size_t)nlayer * 9 + mi) * 6144 + sc_i * 1024 + c); } } }
        const float* xr = first_layer_x ? (row < NCTX ? INP(IN_CTX) + (size_t)row * DM : INP(IN_X) + (size_t)(row - NCTX) * DM) : X + (size_t)row * DM;
        f32x4 v[4];
#pragma unroll
        for (int j = 0; j < 4; ++j) v[j] = *(const f32x4*)(xr + 4 * F.lane + 256 * j);
        if (MODE == 1) {
#pragma unroll
            for (int j = 0; j < 4; ++j) { const u32x2 w = *(const u32x2*)(Y + (size_t)row * DM + 4 * F.lane + 256 * j);
                const f32x4 y = (f32x4){bflo(w.x), bfhi(w.x), bflo(w.y), bfhi(w.y)}; v[j] = v[j] * DN_ALPHA + gt[j] * y; }
        } else if (MODE == 2) {
#pragma unroll
            for (int j = 0; j < 4; ++j) { f32x4 y = (f32x4){0.f, 0.f, 0.f, 0.f};
#pragma unroll
                for (int k = 0; k < 4; ++k) { const u32x2 w = *(const u32x2*)(YK + ((size_t)row * 4 + k) * DM + 4 * F.lane + 256 * j); y += (f32x4){bflo(w.x), bfhi(w.x), bflo(w.y), bfhi(w.y)}; }
                v[j] = v[j] * DN_ALPHA + gt[j] * y; }
        }
        if (MODE != 0) {
            float s = 0.f;
#pragma unroll
            for (int j = 0; j < 4; ++j) s += (v[j][0] + v[j][1]) + (v[j][2] + v[j][3]);
            const float mean = wave_sum(s) * (1.0f / DM); float q = 0.f;
#pragma unroll
            for (int j = 0; j < 4; ++j) { v[j] = v[j] - mean; q += (v[j][0] * v[j][0] + v[j][1] * v[j][1]) + (v[j][2] * v[j][2] + v[j][3] * v[j][3]); }
            const float rstd = 1.0f / sqrtf(wave_sum(q) * (1.0f / DM) + LN_EPS);
#pragma unroll
            for (int j = 0; j < 4; ++j) v[j] = v[j] * rstd * lg[j] + lb[j];
            if (final_out) { if (row >= NCTX) {
#pragma unroll
                for (int j = 0; j < 4; ++j) *(f32x4*)(F.out + (size_t)(row - NCTX) * DM + 4 * F.lane + 256 * j) = v[j]; } }
            else {
#pragma unroll
                for (int j = 0; j < 4; ++j) *(f32x4*)(X + (size_t)row * DM + 4 * F.lane + 256 * j) = v[j]; }
        }
        if (!final_out) {
#pragma unroll
            for (int j = 0; j < 4; ++j) { const f32x4 hv = v[j] * (sc[j] + 1.0f) + sh[j]; u32x2 w; w.x = pk2(hv[0], hv[1]); w.y = pk2(hv[2], hv[3]);
                *(u32x2*)(H + (size_t)row * DM + 4 * F.lane + 256 * j) = w; }
        }
    }
}

__device__ __forceinline__ void gmlp_stats(Frame& F) {
    const bf16_t* Z = (const bf16_t*)(F.ws + WS_R1 + R1_Z); float* ST = (float*)(F.ws + WS_STAT);
    for (int row = F.gw; row < TALL; row += F.NGW) {
        float v[32]; float s = 0.f;
#pragma unroll
        for (int j = 0; j < 4; ++j) { const u32x4 w = *(const u32x4*)(Z + (size_t)row * 4096 + 2048 + 8 * F.lane + 512 * j);
#pragma unroll
            for (int e = 0; e < 4; ++e) { v[8 * j + 2 * e] = bflo(w[e]); v[8 * j + 2 * e + 1] = bfhi(w[e]); } }
#pragma unroll
        for (int i = 0; i < 32; ++i) s += v[i];
        const float mean = wave_sum(s) * (1.0f / 2048.0f); float q = 0.f;
#pragma unroll
        for (int i = 0; i < 32; ++i) { const float d = v[i] - mean; q += d * d; }
        const float rstd = 1.0f / sqrtf(wave_sum(q) * (1.0f / 2048.0f) + LN_EPS);
        if (F.lane == 0) { ST[2 * row] = mean; ST[2 * row + 1] = rstd; }
    }
}
__device__ __forceinline__ void gmlp_vt(Frame& F, int j) {
    const bf16_t* Z = (const bf16_t*)(F.ws + WS_R1 + R1_Z); const float* ST = (const float*)(F.ws + WS_STAT); bf16_t* VT = (bf16_t*)(F.ws + WS_R1 + R1_VT);
    const float* g = INP(IN_GLNG) + j * 2048; const float* b = INP(IN_GLNB) + j * 2048;
    const int nitem = (TALL / 128) * 32 * 16;
    const int per = (nitem + F.NGW - 1) / F.NGW;
    const int i0 = F.gw * per, i1 = (i0 + per < nitem) ? i0 + per : nitem;
    for (int it = i0; it < i1; ++it) {
        const int qo = it & 15, cb = (it >> 4) & 31, chunk = it >> 9;
        const int ch = cb * 64 + F.lane; const float gg = g[ch], bb = b[ch];
        float o[8];
#pragma unroll
        for (int qq = 0; qq < 8; ++qq) { const int row = chunk * 128 + qo * 8 + qq; const float x = bf2f(Z[(size_t)row * 4096 + 2048 + ch]);
            const float mean = ST[2 * row], rstd = ST[2 * row + 1]; o[qq] = (x - mean) * rstd * gg + bb; }
        u32x4 w; w.x = pk2(o[0], o[1]); w.y = pk2(o[2], o[3]); w.z = pk2(o[4], o[5]); w.w = pk2(o[6], o[7]);
        *(u32x4*)(VT + ((size_t)chunk * 2048 + ch) * 128 + qo * 8) = w;
    }
}
__device__ __forceinline__ void gmlp_spatial(Frame& F, int j) {
    const bf16_t* Z = (const bf16_t*)(F.ws + WS_R1 + R1_Z); const bf16_t* VT = (const bf16_t*)(F.ws + WS_R1 + R1_VT); bf16_t* T = (bf16_t*)(F.ws + WS_R1 + R1_T);
    const bf16_t* WSb = (const bf16_t*)(F.ws + WS_WS) + (size_t)j * 8 * 128 * 128; const float* bs = INP(IN_GBS) + j * 8 * 128;
    const int r32 = F.lane & 31, hi = F.lane >> 5;
    const int nunit = (TALL / 128) * 8;
    for (int u = F.bid; u < nunit; u += F.G) {
        const int chunk = u >> 3, g = u & 7, e0 = 32 * F.wave;
        const bf16_t* vt = VT + ((size_t)chunk * 2048 + 256 * g + e0 + r32) * 128 + 8 * hi;
        const bf16_t* wsp = WSb + (size_t)g * 128 * 128 + (size_t)r32 * 128 + 8 * hi;
        f32x16 acc[4];
#pragma unroll
        for (int mt = 0; mt < 4; ++mt) acc[mt] = f32x16{};
#pragma unroll
        for (int ks = 0; ks < 8; ++ks) { const bf16x8 bfrag = *(const bf16x8*)(vt + 16 * ks);
#pragma unroll
            for (int mt = 0; mt < 4; ++mt) { const bf16x8 afrag = *(const bf16x8*)(wsp + (size_t)(32 * mt) * 128 + 16 * ks); acc[mt] = __builtin_amdgcn_mfma_f32_32x32x16_bf16(afrag, bfrag, acc[mt], 0, 0, 0); } }
        const int ch = 256 * g + e0 + r32;
#pragma unroll
        for (int mt = 0; mt < 4; ++mt)
#pragma unroll
            for (int r = 0; r < 16; ++r) { const int p = 32 * mt + att::crow(r, hi); const size_t row = (size_t)chunk * 128 + p;
                const float o = acc[mt][r] + bs[g * 128 + p]; const float uv = bf2f(Z[row * 4096 + ch]); T[row * 2048 + ch] = (bf16_t)f2bf(uv * o); }
    }
}
__device__ __forceinline__ void conv_mix(Frame& F) {
    const bf16_t* P = (const bf16_t*)(F.ws + WS_R1 + R1_P); const bf16_t* BG = (const bf16_t*)(F.ws + WS_R1 + R1_BG); bf16_t* T2 = (bf16_t*)(F.ws + WS_R1 + R1_T2);
    const float* cw = INP(IN_CW);
    const long nitem = (long)TALL * 128;
    for (long it = (long)F.bid * 512 + F.tid; it < nitem; it += (long)F.G * 512) {
        const int row = (int)(it >> 7), c8 = (int)(it & 127) * 8;
        const bool first = row < NCTX ? ((row & 255) == 0) : (((row - NCTX) & (SEQ - 1)) == 0);
        const bool last = row < NCTX ? ((row & 255) == 255) : (((row - NCTX) & (SEQ - 1)) == SEQ - 1);
        const u32x4 zero = (u32x4){0u, 0u, 0u, 0u};
        const u32x4 pm = first ? zero : *(const u32x4*)(P + (size_t)(row - 1) * DM + c8);
        const u32x4 pc = *(const u32x4*)(P + (size_t)row * DM + c8);
        const u32x4 pp = last ? zero : *(const u32x4*)(P + (size_t)(row + 1) * DM + c8);
        const u32x4 bg = *(const u32x4*)(BG + (size_t)row * DM + c8);
        float o[8];
#pragma unroll
        for (int e = 0; e < 4; ++e) {
            const float w0a = cw[c8 + 2 * e], w0b = cw[c8 + 2 * e + 1], w1a = cw[1024 + c8 + 2 * e], w1b = cw[1024 + c8 + 2 * e + 1], w2a = cw[2048 + c8 + 2 * e], w2b = cw[2048 + c8 + 2 * e + 1];
            o[2 * e] = bflo(bg[e]) * (w0a * bflo(pm[e]) + w1a * bflo(pc[e]) + w2a * bflo(pp[e]));
            o[2 * e + 1] = bfhi(bg[e]) * (w0b * bfhi(pm[e]) + w1b * bfhi(pc[e]) + w2b * bfhi(pp[e])); }
        u32x4 w; w.x = pk2(o[0], o[1]); w.y = pk2(o[2], o[3]); w.z = pk2(o[4], o[5]); w.w = pk2(o[6], o[7]);
        *(u32x4*)(T2 + (size_t)row * DM + c8) = w;
    }
}

__device__ __forceinline__ void moe_topk(Frame& F, int layer) {
    const float* L = (const float*)(F.ws + WS_LOGIT); const float* br = INP(IN_MBR) + layer * 32;
    int* TE = (int*)(F.ws + WS_TOKE); float* TG = (float*)(F.ws + WS_TOKG);
    int* ST = (int*)(F.ws + WS_SLOTTOK); int* SD = (int*)(F.ws + WS_SLOTDST); float* SG = (float*)(F.ws + WS_SLOTGATE);
    for (int i = F.bid * 512 + F.tid; i < NSLOT_MAX; i += F.G * 512) { ST[i] = TALL; SD[i] = -1; SG[i] = 0.f; }
    gu32* cnt = F.ctl + CW_CNT + layer * 64;
    for (int t0 = F.gw * 64; t0 < TALL; t0 += F.NGW * 64) {
        const int tok = t0 + F.lane;
        float lg[32];
#pragma unroll
        for (int j = 0; j < 8; ++j) { const f32x4 v = *(const f32x4*)(L + (size_t)tok * 32 + 4 * j); const f32x4 b = *(const f32x4*)(br + 4 * j);
            lg[4 * j] = v[0] + b[0]; lg[4 * j + 1] = v[1] + b[1]; lg[4 * j + 2] = v[2] + b[2]; lg[4 * j + 3] = v[3] + b[3]; }
        int e[4]; float tv[4];
#pragma unroll
        for (int k = 0; k < 4; ++k) { float best = -INFINITY; int bi = 0;
#pragma unroll
            for (int i = 0; i < 32; ++i) { const bool take = lg[i] > best; best = take ? lg[i] : best; bi = take ? i : bi; }
            e[k] = bi; tv[k] = best;
#pragma unroll
            for (int i = 0; i < 32; ++i) lg[i] = (i == bi) ? -INFINITY : lg[i]; }
        const float e1 = __expf(tv[1] - tv[0]), e2 = __expf(tv[2] - tv[0]), e3 = __expf(tv[3] - tv[0]); const float inv = 1.0f / (1.0f + e1 + e2 + e3);
        *(int4*)(TE + (size_t)tok * 4) = make_int4(e[0], e[1], e[2], e[3]);
        *(f32x4*)(TG + (size_t)tok * 4) = (f32x4){inv, e1 * inv, e2 * inv, e3 * inv};
        unsigned mycnt = 0;
        for (int x = 0; x < 32; ++x) { unsigned c = 0;
#pragma unroll
            for (int k = 0; k < 4; ++k) c += __popcll(__ballot(e[k] == x));
            if (F.lane == x) mycnt = c; }
        if (F.lane < 32 && mycnt) __hip_atomic_fetch_add(cnt + F.lane, mycnt, RLX_AGENT);
    }
}
__device__ __forceinline__ void moe_scatter(Frame& F, int layer) {
    const int* TE = (const int*)(F.ws + WS_TOKE); const float* TG = (const float*)(F.ws + WS_TOKG);
    int* ST = (int*)(F.ws + WS_SLOTTOK); int* SD = (int*)(F.ws + WS_SLOTDST); float* SG = (float*)(F.ws + WS_SLOTGATE);
    gu32* cnt = F.ctl + CW_CNT + layer * 64; gu32* cur = F.ctl + CW_CUR + layer * 64;
    unsigned c = (F.lane < 32) ? __hip_atomic_load(cnt + F.lane, RLX_AGENT) : 0u;
    unsigned padded = (c + 255u) & ~255u; unsigned incl = padded;
#pragma unroll
    for (int o = 1; o < 32; o <<= 1) { const unsigned t = __shfl_up(incl, o); if (F.lane >= o) incl += t; }
    const unsigned pstart = incl - padded;
    if (F.bid == 0 && F.wave == 0) {
        int* BE = (int*)(F.ws + WS_META);
        const unsigned total = __shfl(incl, 31);
        const unsigned nblk = total / 256u;
        for (unsigned b0 = 0; b0 < nblk; b0 += 64) { const unsigned blk = b0 + F.lane; int ex = 0;
            for (int x = 0; x < 32; ++x) { const unsigned ps = __shfl(pstart, x), pe = __shfl(incl, x); if (blk * 256u >= ps && blk * 256u < pe) ex = x; }
            if (blk < nblk) BE[blk] = ex; }
    }
    for (int t0 = F.gw * 64; t0 < TALL; t0 += F.NGW * 64) {
        const int tok = t0 + F.lane;
        const int4 ev = *(const int4*)(TE + (size_t)tok * 4); const f32x4 gv = *(const f32x4*)(TG + (size_t)tok * 4);
        const int e[4] = {ev.x, ev.y, ev.z, ev.w};
        unsigned mycnt = 0; unsigned rank[4] = {0u, 0u, 0u, 0u};
        const unsigned long long lt = (1ull << F.lane) - 1ull;
        for (int x = 0; x < 32; ++x) { unsigned run = 0;
#pragma unroll
            for (int k = 0; k < 4; ++k) { const unsigned long long m = __ballot(e[k] == x); if (e[k] == x) rank[k] = run + (unsigned)__popcll(m & lt); run += (unsigned)__popcll(m); }
            if (F.lane == x) mycnt = run; }
        unsigned base = 0;
        if (F.lane < 32 && mycnt) base = __hip_atomic_fetch_add(cur + F.lane, mycnt, RLX_AGENT);
        base += pstart;
#pragma unroll
        for (int k = 0; k < 4; ++k) { const unsigned slot = __shfl(base, e[k]) + rank[k];
            ST[slot] = tok; SD[slot] = tok * 4 + k; SG[slot] = gv[k]; }
    }
}

__device__ __forceinline__ void attn_phase(Frame& F) {
    const bf16_t* Q = (const bf16_t*)(F.ws + WS_R1 + R1_Q); const bf16_t* Kb = (const bf16_t*)(F.ws + WS_R1 + R1_K); const bf16_t* Vb = (const bf16_t*)(F.ws + WS_R1 + R1_V);
    bf16_t* O = (bf16_t*)(F.ws + WS_R1 + R1_O);
    float lam;
    { const float* lp = INP(IN_DLAM); const float a = wave_sum(lp[F.lane] * lp[64 + F.lane]), b = wave_sum(lp[128 + F.lane] * lp[192 + F.lane]); lam = expf(a) - expf(b) + LAM_INIT; }
    const float* subg = INP(IN_DSUBG);
    const int bx = F.bid; const int vcu = (F.G % 8 == 0) ? (bx % 8) * (F.G / 8) + bx / 8 : bx;
    for (int id = vcu; id < 4096 + 128; id += F.G) {
        if (id < 4096) { const int bh = id >> 6, qb = id & 63, b = bh >> 3, h = bh & 7;
            att::attn_unit(Q, Kb, Vb, O, NCTX + b * SEQ + qb * 128, b * CTXL, NCTX + b * SEQ, 4 + SEQ / 64, h, lam, subg, F.ldsg); }
        else { const int c = id - 4096, bh = c >> 1, half = c & 1, b = bh >> 3, h = bh & 7;
            att::attn_unit(Q, Kb, Vb, O, b * CTXL + half * 128, b * CTXL, NCTX + b * SEQ, 4, h, lam, subg, F.ldsg); }
    }
}

#ifndef NO_MAIN
__global__ void __launch_bounds__(NWAVES * 64, 2) fwd_kernel(Args args) {
    extern __shared__ __attribute__((aligned(16))) unsigned char lds[];
    Frame F;
    F.lds = (LAS unsigned char*)lds; F.ldsg = (char*)lds;
    F.tid = threadIdx.x; F.lane = F.tid & 63; F.wave = __builtin_amdgcn_readfirstlane(F.tid >> 6);
    F.G = gridDim.x; F.bid = blockIdx.x; F.gw = blockIdx.x * NWAVES + F.wave; F.NGW = F.G * NWAVES;
    F.out = args.out; F.ws = args.ws; F.ctl = (gu32*)(args.ws + WS_CTL);
    volatile LAS unsigned* MISC = (volatile LAS unsigned*)(F.lds + MISC_OFF);
    for (int u = F.tid; u < (LDS_BYTES - MISC_OFF) / 4; u += NWAVES * 64) MISC[u] = 0u;
    __syncthreads();
    XcdBarrier bar = xcd_barrier_post((unsigned*)(F.ctl + CW_BAR), MISC + 8);
#define GRID_BAR() xcd_barrier(bar)
#define REFRESH() do { F.tid = opaque_tid(); F.lane = F.tid & 63; F.wave = __builtin_amdgcn_readfirstlane(F.tid >> 6); { int b_ = blockIdx.x, g_ = gridDim.x; asm volatile("" : "+s"(b_), "+s"(g_)); F.bid = b_; F.G = g_; F.NGW = g_ * NWAVES; } F.gw = F.bid * NWAVES + F.wave; \
    { GAS unsigned char* g_ = (GAS unsigned char*)F.ws; asm volatile("" : "+s"(g_)); unsigned char* w_ = (unsigned char*)g_; F.ws = w_; F.ctl = (gu32*)(w_ + WS_CTL); R1 = w_ + WS_R1; H = (bf16_t*)(w_ + WS_H); Y = (bf16_t*)(w_ + WS_Y); } } while (0)
    unsigned char* R1 = F.ws + WS_R1;
    bf16_t* H = (bf16_t*)(F.ws + WS_H); bf16_t* Y = (bf16_t*)(F.ws + WS_Y);

#ifndef NO_P0
    p0_weights(F); __syncthreads(); p0_mod(F); p0_misc(F);
#endif
    GRID_BAR(); REFRESH();
    row_pass<0>(F, 0, true, false);
    GRID_BAR(); REFRESH();

    for (int layer = 0; layer < DEPTH; ++layer) {
        const int kind = layer % 3, j = layer / 3;
        const bf16_t* yA; const bf16_t* yW; int yK;
        if (kind == 0) {
            { pg8::DenseSched S; S.o.init(TALL / 256, 4096 / 256, F.G, F.bid); S.K = 1024;
              pg8::EpiBf16<1> E{(bf16_t*)(R1 + R1_Z), 4096};
              pg8::gemm_phase<pg8::EpiBf16<1>, pg8::DenseSched, true>(F.lds, H, (const bf16_t*)(F.ws + WS_WIN) + (size_t)j * 4096 * 1024, 1024, S, E); }
            GRID_BAR(); REFRESH();
            gmlp_stats(F);
            GRID_BAR(); REFRESH();
            gmlp_vt(F, j);
            GRID_BAR(); REFRESH();
#ifndef NO_SPAT
            gmlp_spatial(F, j);
#endif
            GRID_BAR(); REFRESH();
            yA = (const bf16_t*)(R1 + R1_T); yW = (const bf16_t*)(F.ws + WS_WOUT) + (size_t)j * 1024 * 2048; yK = 2048;
        } else if (kind == 1) {
            { pg8::DenseSched S; S.o.init(TALL / 256, 3072 / 256, F.G, F.bid); S.K = 1024;
              pg8::EpiQKV E{(bf16_t*)(R1 + R1_Q), (size_t)(R1_K - R1_Q) / 2, (const float*)(F.ws + WS_ROPE), (const float*)(F.ws + WS_ROPE) + 2048};
              pg8::gemm_phase<pg8::EpiQKV, pg8::DenseSched, true>(F.lds, H, (const bf16_t*)(F.ws + WS_WQKV), 1024, S, E); }
            GRID_BAR(); REFRESH();
#ifndef NO_ATTN
            attn_phase(F);
#endif
            GRID_BAR(); REFRESH();
            yA = (const bf16_t*)(R1 + R1_O); yW = (const bf16_t*)(F.ws + WS_WO); yK = 1024;
        } else {
            { pg8::DenseSched S; S.o.init(TALL / 256, 3072 / 256, F.G, F.bid); S.K = 1024;
              pg8::EpiConvIn E{(bf16_t*)(R1 + R1_P), (bf16_t*)(R1 + R1_BG)};
              pg8::gemm_phase<pg8::EpiConvIn, pg8::DenseSched, true>(F.lds, H, (const bf16_t*)(F.ws + WS_CWIN), 1024, S, E); }
            GRID_BAR(); REFRESH();
            conv_mix(F);
            GRID_BAR(); REFRESH();
            yA = (const bf16_t*)(R1 + R1_T2); yW = (const bf16_t*)(F.ws + WS_CWOUT); yK = 1024;
        }
        { pg8::DenseSched S; S.o.init(TALL / 256, 1024 / 256, F.G, F.bid); S.K = yK;
          pg8::EpiBf16<0> E{Y, 1024};
          pg8::gemm_phase<pg8::EpiBf16<0>, pg8::DenseSched, true>(F.lds, yA, yW, yK, S, E); }
        GRID_BAR(); REFRESH();
        row_pass<1>(F, layer, layer == 0, false);
        GRID_BAR(); REFRESH();
        { pg8::DenseSched S; S.o.init(TALL / 256, 1, F.G, F.bid); S.K = 1024;
          pg8::EpiRouter E{(float*)(F.ws + WS_LOGIT)};
          pg8::gemm_phase<pg8::EpiRouter, pg8::DenseSched, true>(F.lds, H, (const bf16_t*)(F.ws + WS_WR) + (size_t)layer * 256 * 1024, 1024, S, E); }
        GRID_BAR(); REFRESH();
#ifndef NO_TOPK
        moe_topk(F, layer);
#endif
        GRID_BAR(); REFRESH();
#ifndef NO_SCAT
        moe_scatter(F, layer);
#endif
        GRID_BAR(); REFRESH();
        int nblk;
        { unsigned c = (F.lane < 32) ? __hip_atomic_load(F.ctl + CW_CNT + layer * 64 + F.lane, RLX_AGENT) : 0u; unsigned nb = (c + 255u) >> 8;
#pragma unroll
          for (int o = 1; o < 64; o <<= 1) nb += __shfl_xor(nb, o);
          nblk = __builtin_amdgcn_readfirstlane((int)nb); }
        { pg8::MoeSched<true> S; S.o.init(nblk, 2048 / 256, F.G, F.bid); S.K = 1024; S.N = 2048; S.block_e = (const int*)(F.ws + WS_META); S.slot_tok = (const int*)(F.ws + WS_SLOTTOK);
          pg8::EpiMoe1 E{(bf16_t*)(R1 + R1_ACT), INP(IN_MBGU) + (size_t)layer * 32 * 2048};
          pg8::gemm_phase<pg8::EpiMoe1, pg8::MoeSched<true>, true>(F.lds, H, (const bf16_t*)(F.ws + WS_WGU) + (size_t)layer * 32 * 2048 * 1024, 1024, S, E); }
        GRID_BAR(); REFRESH();
        { pg8::MoeSched<false> S; S.o.init(nblk, 1024 / 256, F.G, F.bid); S.K = 1024; S.N = 1024; S.block_e = (const int*)(F.ws + WS_META); S.slot_tok = nullptr;
          pg8::EpiMoe2 E{(bf16_t*)(R1 + R1_YK), INP(IN_MBDN) + (size_t)layer * 32 * 1024, (const int*)(F.ws + WS_SLOTDST), (const float*)(F.ws + WS_SLOTGATE)};
          pg8::gemm_phase<pg8::EpiMoe2, pg8::MoeSched<false>, true>(F.lds, (const bf16_t*)(R1 + R1_ACT), (const bf16_t*)(F.ws + WS_WDN) + (size_t)layer * 32 * 1024 * 1024, 1024, S, E); }
        GRID_BAR(); REFRESH();
        row_pass<2>(F, layer, false, layer == DEPTH - 1);
        if (layer != DEPTH - 1) GRID_BAR(); REFRESH();
    }
}

extern "C" void kernel_launch(void* const* d_in, const int* in_sizes, int n_in, void* d_out, int out_size, void* d_ws, size_t ws_size, hipStream_t stream) {
    static int grid = 0;
    if (grid == 0) {
        if (n_in != 27 || out_size != NLAT * DM || ws_size < WS_END) { fprintf(stderr, "kernel_launch: unexpected shapes (n_in %d, out %d, ws %zu < %zu)\n", n_in, out_size, ws_size, (size_t)WS_END); grid = -1; return; }
        int dev = 0, cus = 0, per_cu = 0;
        if (hipGetDevice(&dev) != hipSuccess || hipDeviceGetAttribute(&cus, hipDeviceAttributeMultiprocessorCount, dev) != hipSuccess) { grid = -1; return; }
        if (hipFuncSetAttribute((const void*)fwd_kernel, hipFuncAttributeMaxDynamicSharedMemorySize, LDS_BYTES) != hipSuccess) { fprintf(stderr, "kernel_launch: hipFuncSetAttribute failed\n"); grid = -1; return; }
        if (hipOccupancyMaxActiveBlocksPerMultiprocessor(&per_cu, (const void*)fwd_kernel, NWAVES * 64, LDS_BYTES) != hipSuccess || per_cu < 1) { fprintf(stderr, "kernel_launch: occupancy query reports %d\n", per_cu); }
        (void)hipGetLastError();
        grid = cus;
    }
    if (grid < 0) return;
    if (hipMemsetAsync((char*)d_ws + WS_CTL, 0, CTL_ZERO_BYTES, stream) != hipSuccess) return;
    Args a{};
    for (int i = 0; i < 27; ++i) a.in[i] = (const float*)d_in[i];
    a.out = (float*)d_out; a.ws = (unsigned char*)d_ws;
    hipLaunchKernelGGL(fwd_kernel, dim3(grid), dim3(NWAVES * 64), LDS_BYTES, stream, a);
}
#endif
```

```cpp
#include <hip/hip_runtime.h>
#include <hip/hip_bf16.h>
#include <cstdio>
#include <cstdint>
#include <cmath>

#define GAS __attribute__((address_space(1)))
#define LAS __attribute__((address_space(3)))
typedef unsigned short bf16_t;
typedef short bf16x8 __attribute__((ext_vector_type(8)));
typedef short s16x4 __attribute__((ext_vector_type(4)));
typedef float f32x4 __attribute__((ext_vector_type(4)));
typedef float f32x2 __attribute__((ext_vector_type(2)));
typedef float f32x16 __attribute__((ext_vector_type(16)));
typedef unsigned u32x4 __attribute__((ext_vector_type(4)));
typedef unsigned u32x2 __attribute__((ext_vector_type(2)));
typedef GAS unsigned gu32;
#define RLX_AGENT __ATOMIC_RELAXED, __HIP_MEMORY_SCOPE_AGENT

constexpr int DM = 1024, NB = 8, SEQ = 8192, CTXL = 256, DEPTH = 4;
constexpr int NCTX = NB * CTXL;
constexpr int NLAT = NB * SEQ;
constexpr int TALL = NCTX + NLAT;
constexpr int NEXP = 32, TOPK = 4;
constexpr int NBLK_MAX = TALL * TOPK / 256 + NEXP;
constexpr int NSLOT_MAX = NBLK_MAX * 256;
constexpr float LN_EPS = 1e-5f;
constexpr float DN_ALPHA = 1.681792830507429f;
constexpr float LAM_INIT = 0.35550906759096927f;
constexpr int NWAVES = 8;

constexpr size_t MiB = 1u << 20;
constexpr size_t WS_CTL = 0, CTL_ZERO_BYTES = 1 * MiB;
constexpr size_t WS_MOD = 1 * MiB;
constexpr size_t WS_ROPE = 2 * MiB;
constexpr size_t WS_META = 2 * MiB + 64 * 1024;
constexpr size_t WS_STAT = 3 * MiB;
constexpr size_t WS_LOGIT = 4 * MiB;
constexpr size_t WS_TOKE = 13 * MiB;
constexpr size_t WS_TOKG = 15 * MiB;
constexpr size_t WS_SLOTTOK = 17 * MiB;
constexpr size_t WS_SLOTGATE = 19 * MiB;
constexpr size_t WS_SLOTDST = 21 * MiB;
constexpr size_t WS_WIN = 24 * MiB;
constexpr size_t WS_WOUT = 40 * MiB;
constexpr size_t WS_WS = 48 * MiB;
constexpr size_t WS_WQKV = 49 * MiB;
constexpr size_t WS_WO = 55 * MiB;
constexpr size_t WS_CWIN = 57 * MiB;
constexpr size_t WS_CWOUT = 63 * MiB;
constexpr size_t WS_WR = 65 * MiB;
constexpr size_t WS_WGU = 68 * MiB;
constexpr size_t WS_WDN = 580 * MiB;
constexpr size_t WS_X = 836 * MiB;
constexpr size_t WS_H = 1100 * MiB;
constexpr size_t WS_Y = 1234 * MiB;
constexpr size_t WS_R1 = 1368 * MiB;
constexpr size_t R1_Z = 0, R1_VT = 528 * MiB, R1_T = 792 * MiB;
constexpr size_t R1_Q = 0, R1_K = 132 * MiB, R1_V = 264 * MiB, R1_O = 396 * MiB;
constexpr size_t R1_P = 0, R1_BG = 132 * MiB, R1_T2 = 264 * MiB;
constexpr size_t R1_ACT = 0, R1_YK = 544 * MiB;
static_assert(R1_V - R1_K == R1_K - R1_Q, "Q | K | V equally spaced");
constexpr size_t WS_H8 = WS_R1 + 1080 * MiB;
constexpr size_t WS_END = WS_H8 + 68 * MiB;
static_assert((size_t)TALL * 4096 * 2 <= 528 * MiB && (size_t)NSLOT_MAX * 1024 * 2 <= 544 * MiB && (size_t)TALL * 4 * 1024 * 2 <= 528 * MiB, "R1 map");
static_assert((size_t)(TALL + 256) * 1024 * 2 <= 134 * MiB && (size_t)TALL * 1024 * 4 <= 264 * MiB, "X/H map");
constexpr int CW_TMO = 0;
constexpr int CW_CNT = 1024;
constexpr int CW_CUR = 2048;
constexpr int CW_BAR = 4096;

constexpr int RING_BYTES = 131072;
constexpr int MISC_OFF = RING_BYTES;
constexpr int LDS_BYTES = 147456;

#define LDS_WAIT() asm volatile("s_waitcnt lgkmcnt(0)" ::: "memory")
#define VM_WAIT() asm volatile("s_waitcnt vmcnt(0)" ::: "memory")

__device__ __forceinline__ unsigned f2bf(float f) { unsigned u = __builtin_bit_cast(unsigned, f); return (u + 0x7fffu + ((u >> 16) & 1u)) >> 16; }
__device__ __forceinline__ unsigned pk2(float lo, float hi) { return f2bf(lo) | (f2bf(hi) << 16); }
__device__ __forceinline__ float bf2f(unsigned short b) { return __builtin_bit_cast(float, (unsigned)b << 16); }
__device__ __forceinline__ float bflo(unsigned w) { return __builtin_bit_cast(float, w << 16); }
__device__ __forceinline__ float bfhi(unsigned w) { return __builtin_bit_cast(float, w & 0xffff0000u); }
__device__ __forceinline__ unsigned cvt_pk_bf16(float lo, float hi) { unsigned r; asm volatile("v_cvt_pk_bf16_f32 %0, %1, %2" : "=v"(r) : "v"(lo), "v"(hi)); return r; }
typedef int i32x8 __attribute__((ext_vector_type(8)));
__device__ __forceinline__ unsigned cvt_fp8x4(float a, float b, float c, float d) { int w = __builtin_amdgcn_cvt_pk_fp8_f32(a, b, 0, false); w = __builtin_amdgcn_cvt_pk_fp8_f32(c, d, w, true); return (unsigned)w; }
constexpr float W8_SCALE = 32.0f;
constexpr int W8_E8M0 = 0x7A7A7A7A, A8_E8M0 = 0x7F7F7F7F;
__device__ __forceinline__ int opaque_tid(int wave) { int t = wave * 64 + (int)__builtin_amdgcn_mbcnt_hi(~0u, __builtin_amdgcn_mbcnt_lo(~0u, 0u)); asm volatile("" : "+v"(t)); return t; }
template <int M> __device__ __forceinline__ int swz_xor_i(int v) { return __builtin_amdgcn_ds_swizzle(v, (M << 10) | 0x1f); }
template <int M> __device__ __forceinline__ float swz_xor_f(float v) { return __builtin_bit_cast(float, __builtin_amdgcn_ds_swizzle(__builtin_bit_cast(int, v), (M << 10) | 0x1f)); }
__device__ __forceinline__ float half_sum32(float v) { v += swz_xor_f<1>(v); v += swz_xor_f<2>(v); v += swz_xor_f<4>(v); v += swz_xor_f<8>(v); v += swz_xor_f<16>(v); return v; }
__device__ __forceinline__ float wave_sum(float v) {
    v = half_sum32(v);
    const auto rr = __builtin_amdgcn_permlane32_swap(__float_as_uint(v), __float_as_uint(v), false, false);
    return __uint_as_float(rr[0]) + __uint_as_float(rr[1]);
}
__device__ __forceinline__ unsigned wave_sum_u(unsigned v) {
    v += (unsigned)swz_xor_i<1>((int)v); v += (unsigned)swz_xor_i<2>((int)v); v += (unsigned)swz_xor_i<4>((int)v); v += (unsigned)swz_xor_i<8>((int)v); v += (unsigned)swz_xor_i<16>((int)v);
    const auto rr = __builtin_amdgcn_permlane32_swap(v, v, false, false);
    return rr[0] + rr[1];
}

#define XB_TMO      128
#define XB_XCNT(j)  (256  + 64 * (j))
#define XB_XSUB(j)  (1280 + 64 * (j))
#define XB_XGEN(j)  (2304 + 64 * (j))
#define XB_TOP      3328
#define XB_TOPGEN   3392
#define XCD_BAR_WORDS 3456
#define XB_SPIN_CAP (1u << 22)

__device__ __forceinline__ unsigned xb_ld(unsigned* p)              { return __hip_atomic_load(p, __ATOMIC_RELAXED, __HIP_MEMORY_SCOPE_AGENT); }
__device__ __forceinline__ unsigned xb_add(unsigned* p, unsigned v) { return __hip_atomic_fetch_add(p, v, __ATOMIC_RELAXED, __HIP_MEMORY_SCOPE_AGENT); }
__device__ __forceinline__ unsigned xb_xcc_id() { return (unsigned)__builtin_amdgcn_s_getreg((3 << 11) | 20) & 0xFu; }
#define XB_SPIN(cond, bar) do { unsigned _sp = 0; while (cond) { __builtin_amdgcn_s_sleep(1); \
    if ((++_sp & 255u) == 0u) { if (xb_ld(&(bar)[XB_TMO])) break; if (_sp > XB_SPIN_CAP) { atomicAdd(&(bar)[XB_TMO], 1u); break; } } } } while (0)

struct XcdBarrier { unsigned* bar; unsigned x; volatile LAS unsigned* st; };

__device__ __forceinline__ XcdBarrier xcd_barrier_post(unsigned* bar, volatile LAS unsigned* st) {
    XcdBarrier b; b.bar = bar; b.x = xb_xcc_id(); b.st = st;
    if (threadIdx.x == 0) (void)xb_add(&bar[XB_XCNT(b.x)], 1u);
    return b;
}
__device__ __forceinline__ void xcd_barrier_complete(unsigned* bar, unsigned x, unsigned& nloc, unsigned& nx) {
    const unsigned G = gridDim.x * gridDim.y * gridDim.z;
    unsigned sum, cnt, mine, sp = 0u;
    for (;;) {
        sum = 0u; cnt = 0u; mine = 0u;
#pragma unroll
        for (unsigned j = 0; j < 16; ++j) { const unsigned c = xb_ld(&bar[XB_XCNT(j)]); sum += c; cnt += (c > 0u) ? 1u : 0u; mine = (j == x) ? c : mine; }
        if (sum == G) break;
        __builtin_amdgcn_s_sleep(1);
        if ((++sp & 255u) == 0u) { if (xb_ld(&bar[XB_TMO])) break; if (sp > XB_SPIN_CAP) { atomicAdd(&bar[XB_TMO], 1u); break; } }
    }
    nloc = mine > 0u ? mine : 1u; nx = cnt > 0u ? cnt : 1u;
}
__device__ __forceinline__ void xcd_barrier(const XcdBarrier& b, const bool leader) {
    asm volatile("s_waitcnt vmcnt(0)" ::: "memory");
    __syncthreads();
    if (leader) {
        GAS unsigned* gbar_ = (GAS unsigned*)b.bar; asm volatile("" : "+s"(gbar_)); unsigned* bar = (unsigned*)gbar_; const unsigned bx_ = (unsigned)__builtin_amdgcn_readfirstlane((int)xb_xcc_id());
        __builtin_amdgcn_s_waitcnt(0);
        unsigned nloc = b.st[0], nx = b.st[1];
        if (nloc == 0u) { xcd_barrier_complete(bar, bx_, nloc, nx); b.st[0] = nloc; b.st[1] = nx; }
        const unsigned old = xb_add(&bar[XB_XSUB(bx_)], 1u);
        const unsigned gen = old / nloc;
        if (old + 1u == (gen + 1u) * nloc) {
            __builtin_amdgcn_fence(__ATOMIC_RELEASE, "agent");
            asm volatile("s_waitcnt vmcnt(0)" ::: "memory");
            const unsigned og = xb_add(&bar[XB_TOP], 1u);
            const unsigned tg = og / nx;
            if (og + 1u == (tg + 1u) * nx) xb_add(&bar[XB_TOPGEN], 1u);
            else XB_SPIN(xb_ld(&bar[XB_TOPGEN]) == tg, bar);
            __builtin_amdgcn_fence(__ATOMIC_ACQUIRE, "agent");
            xb_add(&bar[XB_XGEN(bx_)], 1u);
            asm volatile("s_waitcnt vmcnt(0)" ::: "memory");
        } else {
            XB_SPIN(xb_ld(&bar[XB_XGEN(bx_)]) == gen, bar);
            __builtin_amdgcn_fence(__ATOMIC_ACQUIRE, "agent");
            asm volatile("s_waitcnt vmcnt(0)" ::: "memory");
        }
    }
    __syncthreads();
}

namespace pg8 {
constexpr int BM = 256, BK = 64, HALF = 128, HTB = HALF * BK * 2, STAGE_BYTES = 8 * HTB, NXCD = 8, WGM = 8;
__host__ __device__ __forceinline__ int lds_byte(int r, int c) { const int st = (r >> 4) * 2 + (c >> 5), rr = r & 15, cc = c & 31, ob = rr * 64 + cc * 2; return st * 1024 + (ob ^ (((ob >> 9) & 1) << 5)); }
__host__ __device__ __forceinline__ void stage_rc(int b, int& R, int& C) { const int st = b / 1024, sb = b % 1024, swz = sb ^ (((sb >> 9) & 1) << 5); R = (st >> 1) * 16 + swz / 64; C = (st & 1) * 32 + (swz % 64) / 2; }
__host__ __device__ __forceinline__ int perm32(int rho) { const int n = rho >> 4, i = rho & 15; return 8 * (i >> 2) + 4 * n + (i & 3); }

struct Unit { int pm, pn, e; };

struct TileOrder {
    int nM, nN, nwg, G, c;
    __device__ __forceinline__ void init(int nM_, int nN_, int G_, int c_) { nM = nM_; nN = nN_; nwg = nM * nN; G = G_; c = c_; }
    __device__ __forceinline__ bool tile(int i, int& pm, int& pn) const {
        const long L = (long)i * G + c; if (L >= nwg) return false;
        int wgid = (int)L; { const int q = nwg / NXCD, r = nwg % NXCD, xcd = wgid % NXCD, off = wgid / NXCD; wgid = (xcd < r ? xcd * (q + 1) : r * (q + 1) + (xcd - r) * q) + off; }
        const int nig = WGM * nN, gid = wgid / nig, fm = gid * WGM, gsz = (nM - fm) < WGM ? (nM - fm) : WGM;
        pm = fm + ((wgid % nig) % gsz); pn = (wgid % nig) / gsz; return true;
    }
};
struct DenseSched {
    TileOrder o; int K;
    __device__ __forceinline__ bool next(int i, Unit& u) const { u.e = 0; return o.tile(i, u.pm, u.pn); }
    __device__ __forceinline__ unsigned a_row(const Unit& u, int r) const { return (unsigned)(u.pm * BM + r); }
    __device__ __forceinline__ size_t b_off(const Unit& u) const { return (size_t)u.pn * BM * K; }
};
template <bool GATHER> struct MoeSched {
    TileOrder o; int K, N; const int* block_e; const int* slot_tok;
    __device__ __forceinline__ bool next(int i, Unit& u) const {
        if (!o.tile(i, u.pm, u.pn)) return false;
        u.e = __builtin_amdgcn_readfirstlane((int)__hip_atomic_load((const unsigned*)block_e + u.pm, RLX_AGENT)); return true; }
    __device__ __forceinline__ unsigned a_row(const Unit& u, int r) const { if (GATHER) return (unsigned)slot_tok[u.pm * BM + r]; else return (unsigned)(u.pm * BM + r); }
    __device__ __forceinline__ size_t b_off(const Unit& u) const { return ((size_t)u.e * N + (size_t)u.pn * BM) * K; }
};

__device__ __forceinline__ f32x2 gelu_pk(f32x2 v) {
    const f32x2 av = __builtin_elementwise_abs(v), d = av * 0.2316418882f + 1.0f;
    f32x2 t; t.x = __builtin_amdgcn_rcpf(d.x); t.y = __builtin_amdgcn_rcpf(d.y);
    f32x2 q = t * 0.5307027145f + (-0.7265760135f); q = q * t + 0.7107068705f; q = q * t + (-0.142248368f); q = q * t + 0.127414796f; q = q * t;
    const f32x2 s = (v * v) * (-0.72134752044f);
    f32x2 e; e.x = __builtin_amdgcn_exp2f(s.x); e.y = __builtin_amdgcn_exp2f(s.y);
    const f32x2 m = v * (q * e), r = v - m;
    f32x2 o; o.x = v.x < 0.f ? m.x : r.x; o.y = v.y < 0.f ? m.y : r.y; return o;
}
__device__ __forceinline__ u32x4 pack8(f32x4 v0, f32x4 v1) { u32x4 w; w.x = cvt_pk_bf16(v0[0], v0[1]); w.y = cvt_pk_bf16(v0[2], v0[3]); w.z = cvt_pk_bf16(v1[0], v1[1]); w.w = cvt_pk_bf16(v1[2], v1[3]); return w; }
__device__ __forceinline__ u32x2 pack4(f32x4 v) { u32x2 w; w.x = cvt_pk_bf16(v[0], v[1]); w.y = cvt_pk_bf16(v[2], v[3]); return w; }

template <int ACT> struct EpiBf16 {
    static constexpr bool PERM = true;
    bf16_t* O; int ldc;
    __device__ __forceinline__ void operator()(const f32x4 (&acc)[2][2][4][2], const Unit& u, int wr, int wc, int fr, int fq) const {
        const int row0 = u.pm * BM + wr * 64 + fr, col0 = u.pn * BM + wc * 32 + 8 * fq;
#pragma unroll
        for (int ai = 0; ai < 2; ++ai)
#pragma unroll
            for (int m = 0; m < 4; ++m) { bf16_t* rowp = O + (size_t)(row0 + ai * HALF + m * 16) * ldc + col0;
#pragma unroll
                for (int bj = 0; bj < 2; ++bj) { f32x4 v0 = acc[ai][bj][m][0], v1 = acc[ai][bj][m][1];
                    if (ACT == 1) { f32x2 a = gelu_pk((f32x2){v0[0], v0[1]}), b = gelu_pk((f32x2){v0[2], v0[3]}), c = gelu_pk((f32x2){v1[0], v1[1]}), d = gelu_pk((f32x2){v1[2], v1[3]});
                        v0 = (f32x4){a.x, a.y, b.x, b.y}; v1 = (f32x4){c.x, c.y, d.x, d.y}; }
                    *(u32x4*)(rowp + bj * HALF) = pack8(v0, v1); } }
    }
};
struct EpiQKV {
    static constexpr bool PERM = false;
    bf16_t* Q; size_t qkv_stride; const float* ropec; const float* ropes;
    __device__ __forceinline__ void operator()(const f32x4 (&acc)[2][2][4][2], const Unit& u, int wr, int wc, int fr, int fq) const {
        const int t = u.pn >> 2, colt = (u.pn & 3) * BM;
        bf16_t* base = Q + (size_t)t * qkv_stride;
#pragma unroll
        for (int ai = 0; ai < 2; ++ai)
#pragma unroll
            for (int m = 0; m < 4; ++m) {
                const int row = u.pm * BM + ai * HALF + wr * 64 + m * 16 + fr;
                f32x4 cs = (f32x4){1.f, 1.f, 1.f, 1.f}, sn = (f32x4){0.f, 0.f, 0.f, 0.f};
                if (t < 2 && row >= NCTX) { const int tp = (row - NCTX) & (SEQ - 1); const int pos = (wc & 1) ? (tp & 63) : (tp >> 6);
                    cs = *(const f32x4*)(ropec + pos * 16 + 4 * fq); sn = *(const f32x4*)(ropes + pos * 16 + 4 * fq); }
                bf16_t* rowp = base + (size_t)row * DM + colt + wc * 32 + 4 * fq;
#pragma unroll
                for (int bj = 0; bj < 2; ++bj) { const f32x4 x1 = acc[ai][bj][m][0], x2 = acc[ai][bj][m][1];
                    const f32x4 o1 = x1 * cs - x2 * sn, o2 = x1 * sn + x2 * cs;
                    *(u32x2*)(rowp + bj * HALF) = pack4(o1); *(u32x2*)(rowp + bj * HALF + 16) = pack4(o2); } }
    }
};
struct EpiConvIn {
    static constexpr bool PERM = true;
    bf16_t* P; bf16_t* BG;
    __device__ __forceinline__ void operator()(const f32x4 (&acc)[2][2][4][2], const Unit& u, int wr, int wc, int fr, int fq) const {
        const int row0 = u.pm * BM + wr * 64 + fr;
#pragma unroll
        for (int ai = 0; ai < 2; ++ai)
#pragma unroll
            for (int m = 0; m < 4; ++m) { const size_t row = (size_t)(row0 + ai * HALF + m * 16);
                if (u.pn < 8) { *(u32x4*)(P + row * DM + u.pn * HALF + wc * 32 + 8 * fq) = pack8(acc[ai][0][m][0] * acc[ai][1][m][0], acc[ai][0][m][1] * acc[ai][1][m][1]); }
                else {
#pragma unroll
                    for (int bj = 0; bj < 2; ++bj) *(u32x4*)(BG + row * DM + (u.pn - 8) * BM + bj * HALF + wc * 32 + 8 * fq) = pack8(acc[ai][bj][m][0], acc[ai][bj][m][1]); } }
    }
};
struct EpiRouter {
    static constexpr bool PERM = false;
    float* L;
    __device__ __forceinline__ void operator()(const f32x4 (&acc)[2][2][4][2], const Unit& u, int wr, int wc, int fr, int fq) const {
        if (wc != 0) return;
#pragma unroll
        for (int ai = 0; ai < 2; ++ai)
#pragma unroll
            for (int m = 0; m < 4; ++m) { float* rowp = L + (size_t)(u.pm * BM + ai * HALF + wr * 64 + m * 16 + fr) * NEXP + 4 * fq;
                *(f32x4*)(rowp) = acc[ai][0][m][0]; *(f32x4*)(rowp + 16) = acc[ai][0][m][1]; }
    }
};
struct EpiMoe1 {
    static constexpr bool PERM = true;
    bf16_t* ACT; const float* bgu;
    __device__ __forceinline__ void operator()(const f32x4 (&acc)[2][2][4][2], const Unit& u, int wr, int wc, int fr, int fq) const {
        const int ff0 = u.pn * HALF + wc * 32 + 8 * fq; const float* bias = bgu + (size_t)u.e * 2048;
        f32x4 bg[2], bu[2];
#pragma unroll
        for (int n = 0; n < 2; ++n) { bg[n] = *(const f32x4*)(bias + ff0 + 4 * n); bu[n] = *(const f32x4*)(bias + 1024 + ff0 + 4 * n); }
#pragma unroll
        for (int ai = 0; ai < 2; ++ai)
#pragma unroll
            for (int m = 0; m < 4; ++m) { const size_t row = (size_t)(u.pm * BM + ai * HALF + wr * 64 + m * 16 + fr);
                f32x4 o[2];
#pragma unroll
                for (int n = 0; n < 2; ++n) { const f32x4 gv = acc[ai][0][m][n] + bg[n], uv = acc[ai][1][m][n] + bu[n];
#pragma unroll
                    for (int j = 0; j < 4; ++j) { const float g = fminf(gv[j], 7.0f), up = fminf(fmaxf(uv[j], -7.0f), 7.0f);
                        const float sg = __builtin_amdgcn_rcpf(1.0f + __builtin_amdgcn_exp2f(g * (-1.702f * 1.4426950408889634f)));
                        o[n][j] = (up + 1.0f) * (g * sg); } }
                u32x2 w8; w8.x = cvt_fp8x4(o[0][0], o[0][1], o[0][2], o[0][3]); w8.y = cvt_fp8x4(o[1][0], o[1][1], o[1][2], o[1][3]);
                *(u32x2*)((unsigned char*)ACT + row * DM + ff0) = w8; }
    }
};
struct EpiMoe2 {
    static constexpr bool PERM = true;
    bf16_t* YK; const float* bdn; const int* slot_dst; const float* slot_gate;
    __device__ __forceinline__ void operator()(const f32x4 (&acc)[2][2][4][2], const Unit& u, int wr, int wc, int fr, int fq) const {
        const int col0 = u.pn * BM + wc * 32 + 8 * fq; const float* bias = bdn + (size_t)u.e * 1024;
        f32x4 bv[2][2];
#pragma unroll
        for (int bj = 0; bj < 2; ++bj)
#pragma unroll
            for (int n = 0; n < 2; ++n) bv[bj][n] = *(const f32x4*)(bias + col0 + bj * HALF + 4 * n);
#pragma unroll
        for (int ai = 0; ai < 2; ++ai)
#pragma unroll
            for (int m = 0; m < 4; ++m) { const int slot = u.pm * BM + ai * HALF + wr * 64 + m * 16 + fr;
                const int dst = slot_dst[slot]; const float gate = slot_gate[slot];
                if (dst >= 0) { bf16_t* rowp = YK + (size_t)dst * DM + col0;
#pragma unroll
                    for (int bj = 0; bj < 2; ++bj) *(u32x4*)(rowp + bj * HALF) = pack8((acc[ai][bj][m][0] + bv[bj][0]) * gate, (acc[ai][bj][m][1] + bv[bj][1]) * gate); } }
    }
};

__device__ __forceinline__ void glds16_s(const char* gbase, unsigned voff, unsigned lds_dst) { unsigned keep;
    asm volatile("s_mov_b32 %0, m0\n\ts_mov_b32 m0, %3\n\ts_nop 0\n\tglobal_load_lds_dwordx4 %1, %2\n\ts_mov_b32 m0, %0" : "=&s"(keep) : "v"(voff), "s"(gbase), "s"(lds_dst) : "memory"); }
template <class Epi, class Sched, bool ALIGN_EPI, bool FP8 = false>
__device__ __forceinline__ void gemm_phase(LAS unsigned char* lds, const bf16_t* A, const bf16_t* Bt, const int K, const Sched& S, const Epi& E, const int tid) {
    const int wid = __builtin_amdgcn_readfirstlane(tid >> 6), lane = tid & 63, wr = wid >> 2, wc = wid & 3, fr = lane & 15, fq = lane >> 4;
    const int nt = K / BK;
    int sR[2], sC[2]; unsigned voffB[2];
#pragma unroll
    for (int i = 0; i < 2; ++i) { stage_rc(tid * 16 + i * 8192, sR[i], sC[i]); const int Rb = Epi::PERM ? ((sR[i] & ~31) + perm32(sR[i] & 31)) : sR[i];
        voffB[i] = (unsigned)(Rb * K + sC[i]) * 2u; }
    const size_t kstep = (size_t)(BK * 2);
    const size_t hstep = (size_t)HALF * K * 2;
    const unsigned ldsw = (unsigned)wid * 1024u;
    const unsigned ldsbase = (unsigned)__builtin_amdgcn_readfirstlane((int)((unsigned)(uintptr_t)lds + ldsw));
    const int aoff = lds_byte(wr * 64 + fr, fq * 8), boff = lds_byte(wc * 32 + fr, fq * 8);
#define PG8_SA(b, h) (((b) * 2 + (h)) * HTB)
#define PG8_SB(b, h) ((4 + (b) * 2 + (h)) * HTB)
#define PG8_STAGE(bufoff, gbase, v0, v1) do { glds16_s((gbase), (v0), ldsbase + (unsigned)(bufoff)); glds16_s((gbase), (v1), ldsbase + (unsigned)(bufoff) + 8192u); } while (0)
#define PG8_LDA(dst, b, h) do { _Pragma("unroll") for (int m = 0; m < 4; ++m) _Pragma("unroll") for (int k = 0; k < 2; ++k) dst[m][k] = *(const LAS bf16x8*)(lds + PG8_SA(b, h) + aoff + m * 2048 + k * 1024); } while (0)
#define PG8_LDB(dst, b, h) do { _Pragma("unroll") for (int n = 0; n < 2; ++n) _Pragma("unroll") for (int k = 0; k < 2; ++k) dst[n][k] = *(const LAS bf16x8*)(lds + PG8_SB(b, h) + boff + n * 2048 + k * 1024); } while (0)
#define PG8_CAT(x, y) __builtin_bit_cast(i32x8, __builtin_shufflevector(x, y, 0, 1, 2, 3, 4, 5, 6, 7, 8, 9, 10, 11, 12, 13, 14, 15))
#define PG8_MMA(ai, bj, At, Bt_) do { __builtin_amdgcn_s_setprio(1); _Pragma("unroll") for (int m = 0; m < 4; ++m) _Pragma("unroll") for (int n = 0; n < 2; ++n) { \
        if constexpr (FP8) asm volatile("v_mfma_scale_f32_16x16x128_f8f6f4 %0, %1, %2, %0, %3, %4 op_sel_hi:[0,0,0]" : "+v"(acc[ai][bj][m][n]) : "v"(PG8_CAT(Bt_[n][0], Bt_[n][1])), "v"(PG8_CAT(At[m][0], At[m][1])), "v"(sclW), "v"(sclA)); \
        else { _Pragma("unroll") for (int k = 0; k < 2; ++k) acc[ai][bj][m][n] = __builtin_amdgcn_mfma_f32_16x16x32_bf16(Bt_[n][k], At[m][k], acc[ai][bj][m][n], 0, 0, 0); } } __builtin_amdgcn_s_setprio(0); } while (0)
#define PG8_WAIT_V(n) asm volatile("s_waitcnt vmcnt(" #n ")" ::: "memory")
#define PG8_WAIT_L(n) asm volatile("s_waitcnt lgkmcnt(" #n ")" ::: "memory")
#define PG8_BAR __builtin_amdgcn_s_barrier()
#define PG8_SCHED __builtin_amdgcn_sched_barrier(0)
#define PG8_AOFF(dst, u) do { _Pragma("unroll") for (int h = 0; h < 2; ++h) _Pragma("unroll") for (int i = 0; i < 2; ++i) dst[h][i] = (S.a_row(u, h * HALF + sR[i]) * (unsigned)K + (unsigned)sC[i]) * 2u; } while (0)
    Unit cur, nxt; int ui = 0;
    if (!S.next(0, cur)) return;
    f32x4 acc[2][2][4][2];
#pragma unroll
    for (int a = 0; a < 2; ++a)
#pragma unroll
        for (int b = 0; b < 2; ++b)
#pragma unroll
            for (int m = 0; m < 4; ++m)
#pragma unroll
                for (int n = 0; n < 2; ++n) acc[a][b][m][n] = (f32x4){0.f, 0.f, 0.f, 0.f};
    bf16x8 At[4][2], B0[2][2], B1[2][2];
    const int sclW = W8_E8M0, sclA = A8_E8M0;
    unsigned vA[2][2], vN[2][2];
    PG8_AOFF(vA, cur);
    const char* const cA = (const char*)A;
    const char* cB = (const char*)Bt + S.b_off(cur) * 2;
    PG8_STAGE(PG8_SB(0, 0), cB, voffB[0], voffB[1]); PG8_STAGE(PG8_SB(0, 1), cB + hstep, voffB[0], voffB[1]); PG8_STAGE(PG8_SA(0, 0), cA, vA[0][0], vA[0][1]); PG8_STAGE(PG8_SA(0, 1), cA, vA[1][0], vA[1][1]);
    if (wr == 1) PG8_BAR;
    PG8_WAIT_V(2); PG8_BAR;
    PG8_STAGE(PG8_SB(1, 0), cB + kstep, voffB[0], voffB[1]); PG8_STAGE(PG8_SA(1, 0), cA + kstep, vA[0][0], vA[0][1]); PG8_STAGE(PG8_SB(1, 1), cB + hstep + kstep, voffB[0], voffB[1]);
    PG8_WAIT_V(6); PG8_BAR;
    for (;;) {
        const bool has_next = S.next(ui + 1, nxt);
        const char* nB = cB;
        if (has_next) { PG8_AOFF(vN, nxt); nB = (const char*)Bt + S.b_off(nxt) * 2; }
        else {
#pragma unroll
            for (int h = 0; h < 2; ++h)
#pragma unroll
                for (int i = 0; i < 2; ++i) vN[h][i] = vA[h][i]; }
#pragma clang loop unroll(disable)
        for (int t = 0; t < nt; t += 2) {
            const bool last = (t == nt - 2);
            const char* a1 = cA + (size_t)(t + 1) * kstep;
            const char* a2 = last ? cA : cA + (size_t)(t + 2) * kstep; const char* b2 = last ? nB : cB + (size_t)(t + 2) * kstep;
            const char* a3 = a2 + kstep; const char* b3 = b2 + kstep;
            const unsigned w00 = last ? vN[0][0] : vA[0][0], w01 = last ? vN[0][1] : vA[0][1], w10 = last ? vN[1][0] : vA[1][0], w11 = last ? vN[1][1] : vA[1][1];
            PG8_LDB(B0, 0, 0); PG8_LDB(B1, 0, 1); PG8_SCHED; PG8_LDA(At, 0, 0); PG8_STAGE(PG8_SA(1, 1), a1, vA[1][0], vA[1][1]);
            PG8_WAIT_V(8); PG8_WAIT_L(0); PG8_BAR; PG8_MMA(0, 0, At, B0); PG8_MMA(0, 1, At, B1); PG8_BAR; PG8_SCHED;
            PG8_LDA(At, 0, 1); PG8_STAGE(PG8_SB(0, 0), b2, voffB[0], voffB[1]); PG8_STAGE(PG8_SB(0, 1), b2 + hstep, voffB[0], voffB[1]); PG8_STAGE(PG8_SA(0, 0), a2, w00, w01);
            PG8_WAIT_V(8); PG8_WAIT_L(0); PG8_BAR; PG8_MMA(1, 0, At, B0); PG8_MMA(1, 1, At, B1); PG8_BAR; PG8_SCHED;
            PG8_LDB(B0, 1, 0); PG8_LDB(B1, 1, 1); PG8_SCHED; PG8_LDA(At, 1, 0); PG8_STAGE(PG8_SA(0, 1), a2, w10, w11);
            PG8_WAIT_V(8); PG8_WAIT_L(0); PG8_BAR; PG8_MMA(0, 0, At, B0); PG8_MMA(0, 1, At, B1); PG8_BAR; PG8_SCHED;
            PG8_LDA(At, 1, 1); PG8_STAGE(PG8_SB(1, 0), b3, voffB[0], voffB[1]); PG8_STAGE(PG8_SB(1, 1), b3 + hstep, voffB[0], voffB[1]); PG8_STAGE(PG8_SA(1, 0), a3, w00, w01);
            PG8_WAIT_V(8); PG8_WAIT_L(0); PG8_BAR; PG8_MMA(1, 0, At, B0); PG8_MMA(1, 1, At, B1); PG8_BAR; PG8_SCHED;
        }
        if constexpr (FP8) asm volatile("s_nop 15\n\ts_nop 15" ::: "memory");
        if constexpr (ALIGN_EPI) { if (wr == 0) PG8_BAR; }
        { int fr_ = fr, fq_ = fq; asm volatile("" : "+v"(fr_), "+v"(fq_)); E(acc, cur, wr, wc, fr_, fq_); }
        if (!has_next) break;
#pragma unroll
        for (int a = 0; a < 2; ++a)
#pragma unroll
            for (int b = 0; b < 2; ++b)
#pragma unroll
                for (int m = 0; m < 4; ++m)
#pragma unroll
                    for (int n = 0; n < 2; ++n) acc[a][b][m][n] = (f32x4){0.f, 0.f, 0.f, 0.f};
        cur = nxt; cB = nB; ++ui;
#pragma unroll
        for (int h = 0; h < 2; ++h)
#pragma unroll
            for (int i = 0; i < 2; ++i) vA[h][i] = vN[h][i];
        if constexpr (ALIGN_EPI) { if (wr == 1) PG8_BAR; }
    }
    PG8_WAIT_V(0);
    if constexpr (!ALIGN_EPI) { if (wr == 0) PG8_BAR; }
    PG8_BAR;
#undef PG8_SA
#undef PG8_SB
#undef PG8_STAGE
#undef PG8_LDA
#undef PG8_LDB
#undef PG8_MMA
#undef PG8_WAIT_V
#undef PG8_WAIT_L
#undef PG8_BAR
#undef PG8_SCHED
#undef PG8_AOFF
#undef PG8_CAT
}
}

namespace att {
constexpr int QBLK = 32, KVBLK = 64;
constexpr float SCALE = 0.125f;
constexpr float THR = 8.f;
constexpr int SHM_V = KVBLK * 128 * 2, SHM_K = KVBLK * 128 * 2;
constexpr int LDS_WSF = 2 * SHM_V + 2 * SHM_K;
#define KSWZ(row, colB) ((row) * 256 + ((colB) ^ (((row) & 7) << 4)))
#define SBAR() __builtin_amdgcn_sched_barrier(0)
__device__ __forceinline__ int crow(int r, int hi) { return (r & 3) + 8 * (r >> 2) + 4 * hi; }

__device__ __forceinline__ void partialSM(f32x16& p0, f32x16& p1, float& m_reg, float& mn, float& alpha) {
  constexpr float C = SCALE * 1.4426950408889634f;
  float pmax = p0[0];
#pragma unroll
  for (int r = 1; r < 16; ++r) pmax = fmaxf(pmax, p0[r]);
#pragma unroll
  for (int r = 0; r < 16; ++r) pmax = fmaxf(pmax, p1[r]);
  { auto rr = __builtin_amdgcn_permlane32_swap(__float_as_uint(pmax), __float_as_uint(pmax), false, false);
    pmax = fmaxf(__uint_as_float(rr[0]), __uint_as_float(rr[1])); }
  if (__builtin_expect(__all(pmax - m_reg <= THR / SCALE), 1)) { mn = m_reg; alpha = 1.f; }
  else { mn = fmaxf(m_reg, pmax); alpha = __builtin_amdgcn_exp2f((m_reg - mn) * C); m_reg = mn; }
  const float mnC = -mn * C;
#pragma unroll
  for (int r = 0; r < 16; ++r) p0[r] = fmaf(p0[r], C, mnC);
#pragma unroll
  for (int r = 0; r < 16; ++r) p1[r] = fmaf(p1[r], C, mnC);
#pragma unroll
  for (int r = 0; r < 16; ++r) p0[r] = __builtin_amdgcn_exp2f(p0[r]);
}
__device__ __forceinline__ void finishSM(f32x16& p0, f32x16& p1, float alpha, float& l_reg, bf16x8& pa0, bf16x8& pa1, bf16x8& pa2, bf16x8& pa3) {
#pragma unroll
  for (int r = 0; r < 16; ++r) p1[r] = __builtin_amdgcn_exp2f(p1[r]);
  float ps = 0;
#pragma unroll
  for (int r = 0; r < 16; ++r) ps += p0[r];
#pragma unroll
  for (int r = 0; r < 16; ++r) ps += p1[r];
  { auto rr = __builtin_amdgcn_permlane32_swap(__float_as_uint(ps), __float_as_uint(ps), false, false);
    ps = __uint_as_float(rr[0]) + __uint_as_float(rr[1]); }
  l_reg = l_reg * alpha + ps;
#define PK4(P, BASE, OUT) do { unsigned a0 = cvt_pk_bf16(P[BASE + 0], P[BASE + 1]), a1 = cvt_pk_bf16(P[BASE + 2], P[BASE + 3]);   \
    unsigned b0 = cvt_pk_bf16(P[BASE + 4], P[BASE + 5]), b1 = cvt_pk_bf16(P[BASE + 6], P[BASE + 7]);                              \
    auto r0 = __builtin_amdgcn_permlane32_swap(a0, b0, false, false); auto r1 = __builtin_amdgcn_permlane32_swap(a1, b1, false, false); \
    u32x4 w = {r0[0], r1[0], r0[1], r1[1]}; OUT = __builtin_bit_cast(bf16x8, w); } while (0)
  PK4(p0, 0, pa0); PK4(p0, 8, pa1); PK4(p1, 0, pa2); PK4(p1, 8, pa3);
#undef PK4
}
__device__ __forceinline__ void qkt(f32x16& p0, f32x16& p1, const char* Ks, const bf16x8* qr, int r32, int hi, int cq) {
  p0 = f32x16{}; p1 = f32x16{};
#pragma unroll
  for (int d0 = 0; d0 < 4; ++d0) { const int cb = (cq * 64 + d0 * 16 + hi * 8) * 2;
    const bf16x8 b0 = *reinterpret_cast<const bf16x8*>(Ks + KSWZ(r32, cb));
    const bf16x8 b1 = *reinterpret_cast<const bf16x8*>(Ks + KSWZ(32 + r32, cb));
    p0 = __builtin_amdgcn_mfma_f32_32x32x16_bf16(b0, qr[d0], p0, 0, 0, 0);
    p1 = __builtin_amdgcn_mfma_f32_32x32x16_bf16(b1, qr[d0], p1, 0, 0, 0); }
}
__device__ __forceinline__ int v_st(int k, int c) { const int kk = (k & ~0xC) | ((k & 4) << 1) | ((k & 8) >> 1); return ((kk >> 3) * 4 + (c >> 5)) * 512 + ((kk & 7) * 32 + (c & 31)) * 2; }
__device__ __forceinline__ int v_rd_base(int lane) { return ((lane & 3) << 3) | (((lane >> 2) & 3) << 6) | (((lane >> 4) & 1) << 5) | (((lane >> 5) & 1) << 8); }
constexpr int v_rd_off(int d0, int ks, int half) { return d0 * 512 + ks * 4096 + half * 2048; }
template <int OFF> __device__ __forceinline__ s16x4 tr_read(int vb) {
  s16x4 r; asm volatile("ds_read_b64_tr_b16 %0, %1 offset:%2" : "=&v"(r) : "v"(vb), "i"(OFF) : "memory"); return r;
}
template <int D0> __device__ __forceinline__ void pv_one(f32x16& od, int vb, bf16x8 pa0, bf16x8 pa1, bf16x8 pa2, bf16x8 pa3) {
  const s16x4 l0 = tr_read<v_rd_off(D0, 0, 0)>(vb), h0 = tr_read<v_rd_off(D0, 0, 1)>(vb), l1 = tr_read<v_rd_off(D0, 1, 0)>(vb), h1 = tr_read<v_rd_off(D0, 1, 1)>(vb);
  const s16x4 l2 = tr_read<v_rd_off(D0, 2, 0)>(vb), h2 = tr_read<v_rd_off(D0, 2, 1)>(vb), l3 = tr_read<v_rd_off(D0, 3, 0)>(vb), h3 = tr_read<v_rd_off(D0, 3, 1)>(vb);
  asm volatile("s_waitcnt lgkmcnt(0)" ::: "memory"); SBAR();
#define PK(L, H) (bf16x8){L[0], L[1], L[2], L[3], H[0], H[1], H[2], H[3]}
  od = __builtin_amdgcn_mfma_f32_32x32x16_bf16(pa0, PK(l0, h0), od, 0, 0, 0);
  od = __builtin_amdgcn_mfma_f32_32x32x16_bf16(pa1, PK(l1, h1), od, 0, 0, 0);
  od = __builtin_amdgcn_mfma_f32_32x32x16_bf16(pa2, PK(l2, h2), od, 0, 0, 0);
  od = __builtin_amdgcn_mfma_f32_32x32x16_bf16(pa3, PK(l3, h3), od, 0, 0, 0);
#undef PK
}
__device__ __forceinline__ void pv_d0(f32x16* o, int vb, bf16x8 pa0, bf16x8 pa1, bf16x8 pa2, bf16x8 pa3) {
  pv_one<0>(o[0], vb, pa0, pa1, pa2, pa3); pv_one<1>(o[1], vb, pa0, pa1, pa2, pa3); pv_one<2>(o[2], vb, pa0, pa1, pa2, pa3); pv_one<3>(o[3], vb, pa0, pa1, pa2, pa3);
}

__device__ __forceinline__ void attn_unit(const bf16_t* __restrict__ Q, const bf16_t* __restrict__ Kb, const bf16_t* __restrict__ Vb, bf16_t* __restrict__ O,
                                          int qrow0, int kc0, int kl0, int NT, int h, float lam, const float* __restrict__ subg, char* lds, const int tid) {
  const int wid = __builtin_amdgcn_readfirstlane(tid >> 6), lane = tid & 63, r32 = lane & 31, hi = lane >> 5;
  const int cq = wid >> 2, wq = wid & 3;
  char* V_lds = lds; char* K_lds = lds + 2 * SHM_V;
  float* ws = (float*)(lds + LDS_WSF) + wid * 64; float* li_l = ws; float* al_l = ws + 32;
  float m_reg = -1e30f, l_reg = 0; f32x16 o[4] = {}; bf16x8 qr[4];
  const bf16_t* Qw = Q + (size_t)(qrow0 + wq * QBLK + r32) * DM + h * 128 + cq * 64 + hi * 8;
#pragma unroll
  for (int d0 = 0; d0 < 4; ++d0) qr[d0] = *reinterpret_cast<const bf16x8*>(Qw + d0 * 16);
  const int sr = tid >> 4, sc = (tid & 15) * 8, vst0 = v_st(sr, sc), vst1 = v_st(32 + sr, sc);
  const int vb0 = (int)(uintptr_t)V_lds + v_rd_base(lane);
  const bf16_t* Kh = Kb + h * 128 + sc; const bf16_t* Vh = Vb + h * 128 + sc;
  struct { bf16x8 vs0, vs1, ks0, ks1; } sr_[2];
#define KROW(j) ((j) < 4 ? kc0 + 64 * (j) : kl0 + 64 * ((j) - 4))
#define SLOAD(i, j) do { const size_t k0_ = (size_t)KROW(j); sr_[i].vs0 = *(const bf16x8*)(Vh + (k0_ + sr) * DM); sr_[i].vs1 = *(const bf16x8*)(Vh + (k0_ + 32 + sr) * DM); \
    sr_[i].ks0 = *(const bf16x8*)(Kh + (k0_ + sr) * DM); sr_[i].ks1 = *(const bf16x8*)(Kh + (k0_ + 32 + sr) * DM); } while (0)
#define SWRITE(b, i) do { *(bf16x8*)(V_lds + (b) * SHM_V + vst0) = sr_[i].vs0; *(bf16x8*)(V_lds + (b) * SHM_V + vst1) = sr_[i].vs1; const int kc = sc * 2; \
    *(bf16x8*)(K_lds + (b) * SHM_K + KSWZ(sr, kc)) = sr_[i].ks0; *(bf16x8*)(K_lds + (b) * SHM_K + KSWZ(32 + sr, kc)) = sr_[i].ks1; } while (0)
#define SWAIT() asm volatile("s_waitcnt vmcnt(4)" ::: "memory")
#define RESC(a) do { if (__any((a) < 1.f)) { if (hi == 0) al_l[r32] = (a); asm volatile("s_waitcnt lgkmcnt(0)" ::: "memory"); \
    _Pragma("unroll") for (int d = 0; d < 4; ++d) _Pragma("unroll") for (int r = 0; r < 16; ++r) o[d][r] *= al_l[crow(r, hi)]; } } while (0)
  f32x16 pA0, pA1, pB0, pB1; float mnA, mnB, alA, alB; bf16x8 pa0, pa1, pa2, pa3;
  constexpr int SE = 0, SO = 1;
  SLOAD(SE, 0); asm volatile("s_waitcnt vmcnt(0)" ::: "memory"); SWRITE(0, SE); __syncthreads();
  qkt(pA0, pA1, K_lds, qr, r32, hi, cq); partialSM(pA0, pA1, m_reg, mnA, alA);
  SLOAD(SO, 1); if (2 < NT) SLOAD(SE, 2);
  SWAIT(); SWRITE(1, SO); __syncthreads();
  for (int j = 1; j + 1 < NT; j += 2) {
    SBAR(); qkt(pB0, pB1, K_lds + SHM_K, qr, r32, hi, cq);
    finishSM(pA0, pA1, alA, l_reg, pa0, pa1, pa2, pa3); SBAR();
    SLOAD(SO, j + 2); SBAR();
    pv_d0(o, vb0, pa0, pa1, pa2, pa3); partialSM(pB0, pB1, m_reg, mnB, alB);
    __syncthreads(); SWAIT(); SWRITE(0, SE);
    RESC(alB); __syncthreads();
    SBAR(); qkt(pA0, pA1, K_lds, qr, r32, hi, cq);
    finishSM(pB0, pB1, alB, l_reg, pa0, pa1, pa2, pa3); SBAR();
    if (j + 3 < NT) SLOAD(SE, j + 3); SBAR();
    pv_d0(o, vb0 + SHM_V, pa0, pa1, pa2, pa3); partialSM(pA0, pA1, m_reg, mnA, alA);
    __syncthreads(); SWAIT(); SWRITE(1, SO);
    RESC(alA); __syncthreads();
  }
  SBAR(); qkt(pB0, pB1, K_lds + SHM_K, qr, r32, hi, cq);
  finishSM(pA0, pA1, alA, l_reg, pa0, pa1, pa2, pa3); SBAR();
  pv_d0(o, vb0, pa0, pa1, pa2, pa3); partialSM(pB0, pB1, m_reg, mnB, alB);
  __syncthreads(); RESC(alB);
  finishSM(pB0, pB1, alB, l_reg, pa0, pa1, pa2, pa3); SBAR();
  pv_d0(o, vb0 + SHM_V, pa0, pa1, pa2, pa3);
  if (hi == 0) li_l[r32] = l_reg; asm volatile("s_waitcnt lgkmcnt(0)" ::: "memory");
  float rli[16];
#pragma unroll
  for (int r = 0; r < 16; ++r) rli[r] = __builtin_amdgcn_rcpf(li_l[crow(r, hi)]);
  asm volatile("s_waitcnt vmcnt(0)" ::: "memory");
  __syncthreads();
  float* xb = (float*)lds + wq * (32 * 128);
  if (cq == 1) {
#pragma unroll
    for (int r = 0; r < 16; ++r)
#pragma unroll
      for (int d0 = 0; d0 < 4; ++d0) xb[crow(r, hi) * 128 + d0 * 32 + r32] = o[d0][r] * rli[r];
  }
  asm volatile("s_waitcnt lgkmcnt(0)" ::: "memory");
  __syncthreads();
  if (cq == 0) {
    float ss[16];
#pragma unroll
    for (int r = 0; r < 16; ++r) { float s = 0.f;
#pragma unroll
      for (int d0 = 0; d0 < 4; ++d0) { const float v = o[d0][r] * rli[r] - lam * xb[crow(r, hi) * 128 + d0 * 32 + r32]; o[d0][r] = v; s += v * v; }
      ss[r] = s; }
#pragma unroll
    for (int r = 0; r < 16; ++r) { float s = ss[r];
      s = half_sum32(s);
      ss[r] = __builtin_amdgcn_rsqf(s * (1.0f / 128.0f) + LN_EPS) * (1.0f - LAM_INIT); }
    float gsub[4];
#pragma unroll
    for (int d0 = 0; d0 < 4; ++d0) gsub[d0] = subg[d0 * 32 + r32];
    bf16_t* Ow = O + (size_t)(qrow0 + wq * QBLK) * DM + h * 128;
#pragma unroll
    for (int r = 0; r < 16; ++r) { const int orow = crow(r, hi);
#pragma unroll
      for (int d0 = 0; d0 < 4; ++d0) Ow[(size_t)orow * DM + d0 * 32 + r32] = (bf16_t)f2bf(o[d0][r] * ss[r] * gsub[d0]); }
  }
  asm volatile("s_waitcnt lgkmcnt(0)" ::: "memory");
  __syncthreads();
#undef KROW
#undef SLOAD
#undef SWRITE
#undef SWAIT
#undef RESC
}
#undef KSWZ
#undef SBAR
}

struct Args { const float* in[27]; float* out; unsigned char* ws; };
enum { IN_X = 0, IN_C, IN_CTX, IN_CCTX, IN_WMOD, IN_BMOD, IN_LNG, IN_LNB, IN_GWIN, IN_GLNG, IN_GLNB, IN_GWS, IN_GBS, IN_GWOUT, IN_DWQKV, IN_DLAM, IN_DSUBG, IN_DWO,
       IN_CWIN, IN_CW, IN_CWOUT, IN_MWR, IN_MBR, IN_MWGU, IN_MBGU, IN_MWDN, IN_MBDN };


__device__ __forceinline__ const float* inp_ptr(int k) {
    const __attribute__((address_space(4))) char* kp = (const __attribute__((address_space(4))) char*)__builtin_amdgcn_kernarg_segment_ptr();
    asm volatile("" : "+s"(kp));
    return (const float*)*(GAS const float* const __attribute__((address_space(4)))*)(kp + 8 * k);
}
#define INP(k) inp_ptr(k)

struct Frame {
    LAS unsigned char* lds; char* ldsg;
    int tid, lane, wave, G, gw, NGW, bid, wave0;
    float* out; unsigned char* ws; gu32* ctl;
};

__device__ __forceinline__ int drow_map(int kind, int n) {
    if (kind == 1) { if (n < 1024) return 256 * (n >> 7) + (n & 127); const int ff = n - 1024; return 256 * (ff >> 7) + 128 + (ff & 127); }
    if (kind == 2) { if (n < 1024) return 2048 + n; if (n < 2048) { const int ch = n - 1024; return 256 * (ch >> 7) + (ch & 127); } const int ch = n - 2048; return 256 * (ch >> 7) + 128 + (ch & 127); }
    return n;
}
template <bool FP8> __device__ __forceinline__ void p0_transpose_item(const float* W, int K, int N, bf16_t* WT, int kind, LAS float* scr, int item, int lane) {
    const int nblk = N / 32, kb = item / nblk, nb = item % nblk, k0 = 64 * kb, n0 = 32 * nb;
#pragma unroll 8
    for (int i = 0; i < 32; ++i) { const int kk = 2 * i + (lane >> 5); scr[kk * 33 + (lane & 31)] = W[(size_t)(k0 + kk) * N + n0 + (lane & 31)]; }
    LDS_WAIT(); asm volatile("" ::: "memory");
    const int c = lane & 7; const int d0 = drow_map(kind, n0);
#pragma unroll
    for (int j = 0; j < 4; ++j) { const int n = (lane >> 3) + 8 * j; const LAS float* s = scr + (8 * c) * 33 + n;
        if (FP8) { u32x2 o; o.x = cvt_fp8x4(s[0 * 33] * W8_SCALE, s[1 * 33] * W8_SCALE, s[2 * 33] * W8_SCALE, s[3 * 33] * W8_SCALE); o.y = cvt_fp8x4(s[4 * 33] * W8_SCALE, s[5 * 33] * W8_SCALE, s[6 * 33] * W8_SCALE, s[7 * 33] * W8_SCALE);
            *(GAS u32x2*)((unsigned char*)WT + (size_t)(d0 + n) * K + k0 + 8 * c) = o; }
        else { u32x4 o; o.x = pk2(s[0 * 33], s[1 * 33]); o.y = pk2(s[2 * 33], s[3 * 33]); o.z = pk2(s[4 * 33], s[5 * 33]); o.w = pk2(s[6 * 33], s[7 * 33]);
            *(GAS u32x4*)(WT + (size_t)(d0 + n) * K + k0 + 8 * c) = o; } }
    LDS_WAIT(); asm volatile("" ::: "memory");
}
template <bool FP8> __device__ __forceinline__ void p0_job(Frame& F, LAS float* scr, long& base, const float* src, int K, int N, int M, bf16_t* dst, int ND, int kind) {
    const int per = (K / 64) * (N / 32); const long tot = (long)per * M;
    long first = (long)F.gw - (base % F.NGW); if (first < 0) first += F.NGW;
    for (long it = first; it < tot; it += F.NGW) { const int mtx = (int)(it / per), loc = (int)(it % per);
        p0_transpose_item<FP8>(src + (size_t)mtx * K * N, K, N, (bf16_t*)((unsigned char*)dst + (size_t)mtx * ND * K * (FP8 ? 1 : 2)), kind, scr, loc, F.lane); }
    base += tot;
}
__device__ __forceinline__ void p0_weights(Frame& F) {
    LAS float* scr = (LAS float*)(F.lds + F.wave * 16384);
    long base = 0;
    p0_job<false>(F, scr, base, INP(IN_GWIN), 1024, 4096, 2, (bf16_t*)(F.ws + WS_WIN), 4096, 0);
    p0_job<false>(F, scr, base, INP(IN_GWOUT), 2048, 1024, 2, (bf16_t*)(F.ws + WS_WOUT), 1024, 0);
    p0_job<false>(F, scr, base, INP(IN_DWQKV), 1024, 3072, 1, (bf16_t*)(F.ws + WS_WQKV), 3072, 0);
    p0_job<false>(F, scr, base, INP(IN_DWO), 1024, 1024, 1, (bf16_t*)(F.ws + WS_WO), 1024, 0);
    p0_job<false>(F, scr, base, INP(IN_CWIN), 1024, 3072, 1, (bf16_t*)(F.ws + WS_CWIN), 3072, 2);
    p0_job<false>(F, scr, base, INP(IN_CWOUT), 1024, 1024, 1, (bf16_t*)(F.ws + WS_CWOUT), 1024, 0);
    p0_job<false>(F, scr, base, INP(IN_MWR), 1024, 32, 4, (bf16_t*)(F.ws + WS_WR), 256, 0);
    p0_job<true>(F, scr, base, INP(IN_MWGU), 1024, 2048, 128, (bf16_t*)(F.ws + WS_WGU), 2048, 1);
    p0_job<true>(F, scr, base, INP(IN_MWDN), 1024, 1024, 128, (bf16_t*)(F.ws + WS_WDN), 1024, 0);
    { const float* src = INP(IN_GWS); bf16_t* dst = (bf16_t*)(F.ws + WS_WS); const int n4 = 2 * 8 * 128 * 128 / 4;
      for (int i = F.gw * 64 + F.lane; i < n4; i += F.NGW * 64) { const f32x4 v = *(const f32x4*)(src + 4 * (size_t)i); u32x2 w; w.x = pk2(v[0], v[1]); w.y = pk2(v[2], v[3]); *(u32x2*)(dst + 4 * (size_t)i) = w; } }
}
__device__ __forceinline__ void p0_mod(Frame& F) {
    LAS float* cond = (LAS float*)(F.lds);
    LAS float* red = (LAS float*)(F.lds + 40960);
    const int nitem = 4 * 96;
    if (F.bid >= nitem) return;
    for (int i = F.tid; i < 9 * 1024; i += 512) { const int m = i >> 10, k = i & 1023; const float c = (m < 8) ? INP(IN_C)[m * 1024 + k] : INP(IN_CCTX)[k]; cond[i] = c / (1.0f + __expf(-c)); }
    __syncthreads();
    float* MOD = (float*)(F.ws + WS_MOD);
    for (int it = F.bid; it < nitem; it += F.G) {
        const int layer = it / 96, n0 = (it % 96) * 64;
        const float* W = INP(IN_WMOD) + (size_t)layer * 1024 * 6144 + n0 + F.lane;
        float acc[9];
#pragma unroll
        for (int m = 0; m < 9; ++m) acc[m] = 0.f;
        const int kb = F.wave * 128;
#pragma unroll 8
        for (int k = 0; k < 128; ++k) { const float w = W[(size_t)(kb + k) * 6144];
#pragma unroll
            for (int m = 0; m < 9; ++m) acc[m] += cond[m * 1024 + kb + k] * w; }
#pragma unroll
        for (int m = 0; m < 9; ++m) red[(F.wave * 9 + m) * 64 + F.lane] = acc[m];
        __syncthreads();
        for (int i = F.tid; i < 9 * 64; i += 512) { const int m = i >> 6, l = i & 63; float s = 0.f;
#pragma unroll
            for (int w = 0; w < 8; ++w) s += red[(w * 9 + m) * 64 + l];
            MOD[((size_t)layer * 9 + m) * 6144 + n0 + l] = s + INP(IN_BMOD)[layer * 6144 + n0 + l]; }
        __syncthreads();
    }
}
__device__ __forceinline__ void p0_misc(Frame& F) {
    const int gt = F.bid * 512 + F.tid;
    if (gt < 2048) { const int pos = gt >> 4, i = gt & 15; const float inv = powf(10000.0f, -(float)i / 16.0f); const float ang = (float)pos * inv; float s, c; sincosf(ang, &s, &c);
        ((float*)(F.ws + WS_ROPE))[gt] = c; ((float*)(F.ws + WS_ROPE))[2048 + gt] = s; }
    if (F.bid == F.G - 1) { bf16_t* H = (bf16_t*)(F.ws + WS_H); for (int i = F.tid; i < 1024; i += 512) H[(size_t)TALL * DM + i] = 0;
        unsigned* H8z = (unsigned*)(F.ws + WS_H8 + (size_t)TALL * DM); for (int i = F.tid; i < 256; i += 512) H8z[i] = 0u; }
}

__device__ __forceinline__ int mod_index(int row) { return row < NCTX ? 8 : ((row - NCTX) >> 13); }

template <int MODE>
__device__ __forceinline__ void row_pass(Frame& F, int layer, bool first_layer_x, bool final_out) {
    const float* MOD = (const float*)(F.ws + WS_MOD);
    float* X = (float*)(F.ws + WS_X); bf16_t* H = (bf16_t*)(F.ws + WS_H);
    const bf16_t* Y = (const bf16_t*)(F.ws + WS_Y); const bf16_t* YK = (const bf16_t*)(F.ws + WS_R1 + R1_YK);
    const int rpw = (TALL + F.NGW - 1) / F.NGW;
    const int r0 = F.gw * rpw, r1 = (r0 + rpw < TALL) ? r0 + rpw : TALL;
    const int sub = (MODE == 2) ? 1 : 0;
    const int gate_i = (MODE == 2) ? 5 : 2;
    const int nlayer = (MODE == 2) ? layer + 1 : layer;
    const int sh_i = (MODE == 1) ? 3 : 0, sc_i = (MODE == 1) ? 4 : 1;
    f32x4 lg[4], lb[4], gt[4], sh[4], sc[4];
    if (MODE != 0) {
#pragma unroll
        for (int j = 0; j < 4; ++j) { lg[j] = *(const f32x4*)(INP(IN_LNG) + (layer * 2 + sub) * 1024 + 4 * F.lane + 256 * j); lb[j] = *(const f32x4*)(INP(IN_LNB) + (layer * 2 + sub) * 1024 + 4 * F.lane + 256 * j); } }
    int curm = -1;
    for (int row = r0; row < r1; ++row) {
        const int mi = mod_index(row);
        if (mi != curm) { curm = mi;
#pragma unroll
            for (int j = 0; j < 4; ++j) { const int c = 4 * F.lane + 256 * j;
                if (MODE != 0) gt[j] = *(const f32x4*)(MOD + ((size_t)layer * 9 + mi) * 6144 + gate_i * 1024 + c);
                if (!final_out) { sh[j] = *(const f32x4*)(MOD + ((size_t)nlayer * 9 + mi) * 6144 + sh_i * 1024 + c); sc[j] = *(const f32x4*)(MOD + ((size_t)nlayer * 9 + mi) * 6144 + sc_i * 1024 + c); } } }
        const float* xr = first_layer_x ? (row < NCTX ? INP(IN_CTX) + (size_t)row * DM : INP(IN_X) + (size_t)(row - NCTX) * DM) : X + (size_t)row * DM;
        f32x4 v[4];
#pragma unroll
        for (int j = 0; j < 4; ++j) v[j] = *(const f32x4*)(xr + 4 * F.lane + 256 * j);
        if (MODE == 1) {
#pragma unroll
            for (int j = 0; j < 4; ++j) { const u32x2 w = *(const u32x2*)(Y + (size_t)row * DM + 4 * F.lane + 256 * j);
                const f32x4 y = (f32x4){bflo(w.x), bfhi(w.x), bflo(w.y), bfhi(w.y)}; v[j] = v[j] * DN_ALPHA + gt[j] * y; }
        } else if (MODE == 2) {
#pragma unroll
            for (int j = 0; j < 4; ++j) { f32x4 y = (f32x4){0.f, 0.f, 0.f, 0.f};
#pragma unroll
                for (int k = 0; k < 4; ++k) { const u32x2 w = *(const u32x2*)(YK + ((size_t)row * 4 + k) * DM + 4 * F.lane + 256 * j); y += (f32x4){bflo(w.x), bfhi(w.x), bflo(w.y), bfhi(w.y)}; }
                v[j] = v[j] * DN_ALPHA + gt[j] * y; }
        }
        if (MODE != 0) {
            float s = 0.f;
#pragma unroll
            for (int j = 0; j < 4; ++j) s += (v[j][0] + v[j][1]) + (v[j][2] + v[j][3]);
            const float mean = wave_sum(s) * (1.0f / DM); float q = 0.f;
#pragma unroll
            for (int j = 0; j < 4; ++j) { v[j] = v[j] - mean; q += (v[j][0] * v[j][0] + v[j][1] * v[j][1]) + (v[j][2] * v[j][2] + v[j][3] * v[j][3]); }
            const float rstd = 1.0f / sqrtf(wave_sum(q) * (1.0f / DM) + LN_EPS);
#pragma unroll
            for (int j = 0; j < 4; ++j) v[j] = v[j] * rstd * lg[j] + lb[j];
            if (final_out) { if (row >= NCTX) {
#pragma unroll
                for (int j = 0; j < 4; ++j) *(f32x4*)(F.out + (size_t)(row - NCTX) * DM + 4 * F.lane + 256 * j) = v[j]; } }
            else {
#pragma unroll
                for (int j = 0; j < 4; ++j) *(f32x4*)(X + (size_t)row * DM + 4 * F.lane + 256 * j) = v[j]; }
        }
        if (!final_out) {
#pragma unroll
            for (int j = 0; j < 4; ++j) { const f32x4 hv = v[j] * (sc[j] + 1.0f) + sh[j]; u32x2 w; w.x = pk2(hv[0], hv[1]); w.y = pk2(hv[2], hv[3]);
                *(u32x2*)(H + (size_t)row * DM + 4 * F.lane + 256 * j) = w;
                if (MODE == 1) *(unsigned*)(F.ws + WS_H8 + (size_t)row * DM + 4 * F.lane + 256 * j) = cvt_fp8x4(hv[0], hv[1], hv[2], hv[3]); }
        }
    }
}

__device__ __forceinline__ void gmlp_stats(Frame& F) {
    const bf16_t* Z = (const bf16_t*)(F.ws + WS_R1 + R1_Z); float* ST = (float*)(F.ws + WS_STAT);
    for (int row = F.gw; row < TALL; row += F.NGW) {
        float v[32]; float s = 0.f;
#pragma unroll
        for (int j = 0; j < 4; ++j) { const u32x4 w = *(const u32x4*)(Z + (size_t)row * 4096 + 2048 + 8 * F.lane + 512 * j);
#pragma unroll
            for (int e = 0; e < 4; ++e) { v[8 * j + 2 * e] = bflo(w[e]); v[8 * j + 2 * e + 1] = bfhi(w[e]); } }
#pragma unroll
        for (int i = 0; i < 32; ++i) s += v[i];
        const float mean = wave_sum(s) * (1.0f / 2048.0f); float q = 0.f;
#pragma unroll
        for (int i = 0; i < 32; ++i) { const float d = v[i] - mean; q += d * d; }
        const float rstd = 1.0f / sqrtf(wave_sum(q) * (1.0f / 2048.0f) + LN_EPS);
        if (F.lane == 0) { ST[2 * row] = mean; ST[2 * row + 1] = rstd; }
    }
}
__device__ __forceinline__ void gmlp_vt(Frame& F, int j) {
    const bf16_t* Z = (const bf16_t*)(F.ws + WS_R1 + R1_Z); const float* ST = (const float*)(F.ws + WS_STAT); bf16_t* VT = (bf16_t*)(F.ws + WS_R1 + R1_VT);
    const float* g = INP(IN_GLNG) + j * 2048; const float* b = INP(IN_GLNB) + j * 2048;
    const int nitem = (TALL / 128) * 32 * 16;
    const int per = (nitem + F.NGW - 1) / F.NGW;
    const int i0 = F.gw * per, i1 = (i0 + per < nitem) ? i0 + per : nitem;
    for (int it = i0; it < i1; ++it) {
        const int qo = it & 15, cb = (it >> 4) & 31, chunk = it >> 9;
        const int ch = cb * 64 + F.lane; const float gg = g[ch], bb = b[ch];
        float o[8];
#pragma unroll
        for (int qq = 0; qq < 8; ++qq) { const int row = chunk * 128 + qo * 8 + qq; const float x = bf2f(Z[(size_t)row * 4096 + 2048 + ch]);
            const float mean = ST[2 * row], rstd = ST[2 * row + 1]; o[qq] = (x - mean) * rstd * gg + bb; }
        u32x4 w; w.x = pk2(o[0], o[1]); w.y = pk2(o[2], o[3]); w.z = pk2(o[4], o[5]); w.w = pk2(o[6], o[7]);
        *(u32x4*)(VT + ((size_t)chunk * 2048 + ch) * 128 + qo * 8) = w;
    }
}
__device__ __forceinline__ void gmlp_spatial(Frame& F, int j) {
    const bf16_t* Z = (const bf16_t*)(F.ws + WS_R1 + R1_Z); const bf16_t* VT = (const bf16_t*)(F.ws + WS_R1 + R1_VT); bf16_t* T = (bf16_t*)(F.ws + WS_R1 + R1_T);
    const bf16_t* WSb = (const bf16_t*)(F.ws + WS_WS) + (size_t)j * 8 * 128 * 128; const float* bs = INP(IN_GBS) + j * 8 * 128;
    const int r32 = F.lane & 31, hi = F.lane >> 5;
    const int nunit = (TALL / 128) * 8;
    for (int u = F.bid; u < nunit; u += F.G) {
        const int chunk = u >> 3, g = u & 7, e0 = 32 * F.wave;
        const bf16_t* vt = VT + ((size_t)chunk * 2048 + 256 * g + e0 + r32) * 128 + 8 * hi;
        const bf16_t* wsp = WSb + (size_t)g * 128 * 128 + (size_t)r32 * 128 + 8 * hi;
        f32x16 acc[4];
#pragma unroll
        for (int mt = 0; mt < 4; ++mt) acc[mt] = f32x16{};
#pragma unroll
        for (int ks = 0; ks < 8; ++ks) { const bf16x8 bfrag = *(const bf16x8*)(vt + 16 * ks);
#pragma unroll
            for (int mt = 0; mt < 4; ++mt) { const bf16x8 afrag = *(const bf16x8*)(wsp + (size_t)(32 * mt) * 128 + 16 * ks); acc[mt] = __builtin_amdgcn_mfma_f32_32x32x16_bf16(afrag, bfrag, acc[mt], 0, 0, 0); } }
        const int ch = 256 * g + e0 + r32;
#pragma unroll
        for (int mt = 0; mt < 4; ++mt)
#pragma unroll
            for (int r = 0; r < 16; ++r) { const int p = 32 * mt + att::crow(r, hi); const size_t row = (size_t)chunk * 128 + p;
                const float o = acc[mt][r] + bs[g * 128 + p]; const float uv = bf2f(Z[row * 4096 + ch]); T[row * 2048 + ch] = (bf16_t)f2bf(uv * o); }
    }
}
__device__ __forceinline__ void conv_mix(Frame& F) {
    const bf16_t* P = (const bf16_t*)(F.ws + WS_R1 + R1_P); const bf16_t* BG = (const bf16_t*)(F.ws + WS_R1 + R1_BG); bf16_t* T2 = (bf16_t*)(F.ws + WS_R1 + R1_T2);
    const float* cw = INP(IN_CW);
    const long nitem = (long)TALL * 128;
    for (long it = (long)F.bid * 512 + F.tid; it < nitem; it += (long)F.G * 512) {
        const int row = (int)(it >> 7), c8 = (int)(it & 127) * 8;
        const bool first = row < NCTX ? ((row & 255) == 0) : (((row - NCTX) & (SEQ - 1)) == 0);
        const bool last = row < NCTX ? ((row & 255) == 255) : (((row - NCTX) & (SEQ - 1)) == SEQ - 1);
        const u32x4 zero = (u32x4){0u, 0u, 0u, 0u};
        const u32x4 pm = first ? zero : *(const u32x4*)(P + (size_t)(row - 1) * DM + c8);
        const u32x4 pc = *(const u32x4*)(P + (size_t)row * DM + c8);
        const u32x4 pp = last ? zero : *(const u32x4*)(P + (size_t)(row + 1) * DM + c8);
        const u32x4 bg = *(const u32x4*)(BG + (size_t)row * DM + c8);
        float o[8];
#pragma unroll
        for (int e = 0; e < 4; ++e) {
            const float w0a = cw[c8 + 2 * e], w0b = cw[c8 + 2 * e + 1], w1a = cw[1024 + c8 + 2 * e], w1b = cw[1024 + c8 + 2 * e + 1], w2a = cw[2048 + c8 + 2 * e], w2b = cw[2048 + c8 + 2 * e + 1];
            o[2 * e] = bflo(bg[e]) * (w0a * bflo(pm[e]) + w1a * bflo(pc[e]) + w2a * bflo(pp[e]));
            o[2 * e + 1] = bfhi(bg[e]) * (w0b * bfhi(pm[e]) + w1b * bfhi(pc[e]) + w2b * bfhi(pp[e])); }
        u32x4 w; w.x = pk2(o[0], o[1]); w.y = pk2(o[2], o[3]); w.z = pk2(o[4], o[5]); w.w = pk2(o[6], o[7]);
        *(u32x4*)(T2 + (size_t)row * DM + c8) = w;
    }
}

__device__ __forceinline__ void moe_topk(Frame& F, int layer) {
    const float* L = (const float*)(F.ws + WS_LOGIT); const float* br = INP(IN_MBR) + layer * 32;
    int* TE = (int*)(F.ws + WS_TOKE); float* TG = (float*)(F.ws + WS_TOKG);
    int* ST = (int*)(F.ws + WS_SLOTTOK); int* SD = (int*)(F.ws + WS_SLOTDST); float* SG = (float*)(F.ws + WS_SLOTGATE);
    for (int i = F.bid * 512 + F.tid; i < NSLOT_MAX; i += F.G * 512) { ST[i] = TALL; SD[i] = -1; SG[i] = 0.f; }
    gu32* cnt = F.ctl + CW_CNT + layer * 64;
    for (int t0 = F.gw * 64; t0 < TALL; t0 += F.NGW * 64) {
        const int tok = t0 + F.lane;
        float lg[32];
#pragma unroll
        for (int j = 0; j < 8; ++j) { const f32x4 v = *(const f32x4*)(L + (size_t)tok * 32 + 4 * j); const f32x4 b = *(const f32x4*)(br + 4 * j);
            lg[4 * j] = v[0] + b[0]; lg[4 * j + 1] = v[1] + b[1]; lg[4 * j + 2] = v[2] + b[2]; lg[4 * j + 3] = v[3] + b[3]; }
        int e[4]; float tv[4];
#pragma unroll
        for (int k = 0; k < 4; ++k) { float best = -INFINITY; int bi = 0;
#pragma unroll
            for (int i = 0; i < 32; ++i) { const bool take = lg[i] > best; best = take ? lg[i] : best; bi = take ? i : bi; }
            e[k] = bi; tv[k] = best;
#pragma unroll
            for (int i = 0; i < 32; ++i) lg[i] = (i == bi) ? -INFINITY : lg[i]; }
        const float e1 = __expf(tv[1] - tv[0]), e2 = __expf(tv[2] - tv[0]), e3 = __expf(tv[3] - tv[0]); const float inv = 1.0f / (1.0f + e1 + e2 + e3);
        *(int4*)(TE + (size_t)tok * 4) = make_int4(e[0], e[1], e[2], e[3]);
        *(f32x4*)(TG + (size_t)tok * 4) = (f32x4){inv, e1 * inv, e2 * inv, e3 * inv};
        unsigned mycnt = 0;
        for (int x = 0; x < 32; ++x) { unsigned c = 0;
#pragma unroll
            for (int k = 0; k < 4; ++k) c += __popcll(__ballot(e[k] == x));
            if (F.lane == x) mycnt = c; }
        if (F.lane < 32 && mycnt) __hip_atomic_fetch_add(cnt + F.lane, mycnt, RLX_AGENT);
    }
}
__device__ __forceinline__ void moe_scatter(Frame& F, int layer) {
    const int* TE = (const int*)(F.ws + WS_TOKE); const float* TG = (const float*)(F.ws + WS_TOKG);
    int* ST = (int*)(F.ws + WS_SLOTTOK); int* SD = (int*)(F.ws + WS_SLOTDST); float* SG = (float*)(F.ws + WS_SLOTGATE);
    gu32* cnt = F.ctl + CW_CNT + layer * 64; gu32* cur = F.ctl + CW_CUR + layer * 64;
    unsigned c = (F.lane < 32) ? __hip_atomic_load(cnt + F.lane, RLX_AGENT) : 0u;
    const unsigned padded = (c + 255u) & ~255u; unsigned incl = 0u, total = 0u;
    for (int x = 0; x < 32; ++x) { total += (unsigned)__builtin_amdgcn_readlane((int)padded, x); if (F.lane == x) incl = total; }
    const unsigned pstart = incl - padded;
    if (F.bid == 0 && F.wave == 0) {
        int* BE = (int*)(F.ws + WS_META);
        const unsigned nblk = total / 256u;
        for (unsigned b0 = 0; b0 < nblk; b0 += 64) { const unsigned blk = b0 + F.lane; int ex = 0;
            for (int x = 0; x < 32; ++x) { const unsigned ps = (unsigned)__builtin_amdgcn_readlane((int)pstart, x), pe = (unsigned)__builtin_amdgcn_readlane((int)incl, x); if (blk * 256u >= ps && blk * 256u < pe) ex = x; }
            if (blk < nblk) BE[blk] = ex; }
    }
    for (int t0 = F.gw * 64; t0 < TALL; t0 += F.NGW * 64) {
        const int tok = t0 + F.lane;
        const int4 ev = *(const int4*)(TE + (size_t)tok * 4); const f32x4 gv = *(const f32x4*)(TG + (size_t)tok * 4);
        const int e[4] = {ev.x, ev.y, ev.z, ev.w};
        unsigned mycnt = 0; unsigned rank[4] = {0u, 0u, 0u, 0u};
        const unsigned long long lt = (1ull << F.lane) - 1ull;
        for (int x = 0; x < 32; ++x) { unsigned run = 0;
#pragma unroll
            for (int k = 0; k < 4; ++k) { const unsigned long long m = __ballot(e[k] == x); if (e[k] == x) rank[k] = run + (unsigned)__popcll(m & lt); run += (unsigned)__popcll(m); }
            if (F.lane == x) mycnt = run; }
        unsigned base = 0;
        if (F.lane < 32 && mycnt) base = __hip_atomic_fetch_add(cur + F.lane, mycnt, RLX_AGENT);
        base += pstart;
#pragma unroll
        for (int k = 0; k < 4; ++k) { const unsigned slot = (unsigned)__builtin_amdgcn_ds_bpermute(e[k] << 2, (int)base) + rank[k];
            ST[slot] = tok; SD[slot] = tok * 4 + k; SG[slot] = gv[k]; }
    }
}

__device__ __forceinline__ void attn_phase(Frame& F) {
    const bf16_t* Q = (const bf16_t*)(F.ws + WS_R1 + R1_Q); const bf16_t* Kb = (const bf16_t*)(F.ws + WS_R1 + R1_K); const bf16_t* Vb = (const bf16_t*)(F.ws + WS_R1 + R1_V);
    bf16_t* O = (bf16_t*)(F.ws + WS_R1 + R1_O);
    float lam;
    { const float* lp = INP(IN_DLAM); const float a = wave_sum(lp[F.lane] * lp[64 + F.lane]), b = wave_sum(lp[128 + F.lane] * lp[192 + F.lane]); lam = expf(a) - expf(b) + LAM_INIT; }
    const float* subg = INP(IN_DSUBG);
    const int bx = F.bid; const int vcu = (F.G % 8 == 0) ? (bx % 8) * (F.G / 8) + bx / 8 : bx;
    for (int id = vcu; id < 4096 + 128; id += F.G) {
        if (id < 4096) { const int bh = id >> 6, qb = id & 63, b = bh >> 3, h = bh & 7;
            att::attn_unit(Q, Kb, Vb, O, NCTX + b * SEQ + qb * 128, b * CTXL, NCTX + b * SEQ, 4 + SEQ / 64, h, lam, subg, F.ldsg, F.tid); }
        else { const int c = id - 4096, bh = c >> 1, half = c & 1, b = bh >> 3, h = bh & 7;
            att::attn_unit(Q, Kb, Vb, O, b * CTXL + half * 128, b * CTXL, NCTX + b * SEQ, 4, h, lam, subg, F.ldsg, F.tid); }
    }
}

#ifndef NO_MAIN
__global__ void __launch_bounds__(NWAVES * 64, 2) fwd_kernel(Args args) {
    extern __shared__ __attribute__((aligned(16))) unsigned char lds[];
    Frame F;
    F.lds = (LAS unsigned char*)lds; F.ldsg = (char*)lds;
    F.wave0 = __builtin_amdgcn_readfirstlane((int)(threadIdx.x >> 6));
    F.tid = opaque_tid(F.wave0); F.lane = F.tid & 63; F.wave = F.wave0;
    F.G = gridDim.x; F.bid = blockIdx.x; F.gw = blockIdx.x * NWAVES + F.wave; F.NGW = F.G * NWAVES;
    F.out = args.out; F.ws = args.ws; F.ctl = (gu32*)(args.ws + WS_CTL);
    volatile LAS unsigned* MISC = (volatile LAS unsigned*)(F.lds + MISC_OFF);
    for (int u = F.tid; u < (LDS_BYTES - MISC_OFF) / 4; u += NWAVES * 64) MISC[u] = 0u;
    __syncthreads();
    XcdBarrier bar; bar.bar = (unsigned*)(F.ctl + CW_BAR); bar.x = 0; bar.st = MISC + 8;
    if (F.tid == 0) (void)xb_add(&bar.bar[XB_XCNT(xb_xcc_id())], 1u);
#define GRID_BAR() xcd_barrier(bar, F.tid == 0)
#define REFRESH() do { { int w_ = F.wave0; asm volatile("" : "+s"(w_)); F.wave = w_; } F.tid = opaque_tid(F.wave); F.lane = F.tid & 63; { int b_ = blockIdx.x, g_ = gridDim.x; asm volatile("" : "+s"(b_), "+s"(g_)); F.bid = b_; F.G = g_; F.NGW = g_ * NWAVES; } F.gw = F.bid * NWAVES + F.wave; \
    { GAS unsigned char* g_ = (GAS unsigned char*)F.ws; asm volatile("" : "+s"(g_)); unsigned char* w_ = (unsigned char*)g_; F.ws = w_; F.ctl = (gu32*)(w_ + WS_CTL); R1 = w_ + WS_R1; H = (bf16_t*)(w_ + WS_H); Y = (bf16_t*)(w_ + WS_Y); } } while (0)
    unsigned char* R1 = F.ws + WS_R1;
    bf16_t* H = (bf16_t*)(F.ws + WS_H); bf16_t* Y = (bf16_t*)(F.ws + WS_Y);

#ifndef NO_P0
    p0_weights(F); __syncthreads(); p0_mod(F); p0_misc(F);
#endif
    GRID_BAR(); REFRESH();
    row_pass<0>(F, 0, true, false);
    GRID_BAR(); REFRESH();

    for (int layer = 0; layer < DEPTH; ++layer) {
        const int kind = layer % 3, j = layer / 3;
        const bf16_t* yA; const bf16_t* yW; int yK;
        if (kind == 0) {
            { pg8::DenseSched S; S.o.init(TALL / 256, 4096 / 256, F.G, F.bid); S.K = 1024;
              pg8::EpiBf16<1> E{(bf16_t*)(R1 + R1_Z), 4096};
              pg8::gemm_phase<pg8::EpiBf16<1>, pg8::DenseSched, true>(F.lds, H, (const bf16_t*)(F.ws + WS_WIN) + (size_t)j * 4096 * 1024, 1024, S, E, F.tid); }
            GRID_BAR(); REFRESH();
            gmlp_stats(F);
            GRID_BAR(); REFRESH();
            gmlp_vt(F, j);
            GRID_BAR(); REFRESH();
#ifndef NO_SPAT
            gmlp_spatial(F, j);
#endif
            GRID_BAR(); REFRESH();
            yA = (const bf16_t*)(R1 + R1_T); yW = (const bf16_t*)(F.ws + WS_WOUT) + (size_t)j * 1024 * 2048; yK = 2048;
        } else if (kind == 1) {
            { pg8::DenseSched S; S.o.init(TALL / 256, 3072 / 256, F.G, F.bid); S.K = 1024;
              pg8::EpiQKV E{(bf16_t*)(R1 + R1_Q), (size_t)(R1_K - R1_Q) / 2, (const float*)(F.ws + WS_ROPE), (const float*)(F.ws + WS_ROPE) + 2048};
              pg8::gemm_phase<pg8::EpiQKV, pg8::DenseSched, true>(F.lds, H, (const bf16_t*)(F.ws + WS_WQKV), 1024, S, E, F.tid); }
            GRID_BAR(); REFRESH();
#ifndef NO_ATTN
            attn_phase(F);
#endif
            GRID_BAR(); REFRESH();
            yA = (const bf16_t*)(R1 + R1_O); yW = (const bf16_t*)(F.ws + WS_WO); yK = 1024;
        } else {
            { pg8::DenseSched S; S.o.init(TALL / 256, 3072 / 256, F.G, F.bid); S.K = 1024;
              pg8::EpiConvIn E{(bf16_t*)(R1 + R1_P), (bf16_t*)(R1 + R1_BG)};
              pg8::gemm_phase<pg8::EpiConvIn, pg8::DenseSched, true>(F.lds, H, (const bf16_t*)(F.ws + WS_CWIN), 1024, S, E, F.tid); }
            GRID_BAR(); REFRESH();
            conv_mix(F);
            GRID_BAR(); REFRESH();
            yA = (const bf16_t*)(R1 + R1_T2); yW = (const bf16_t*)(F.ws + WS_CWOUT); yK = 1024;
        }
        { pg8::DenseSched S; S.o.init(TALL / 256, 1024 / 256, F.G, F.bid); S.K = yK;
          pg8::EpiBf16<0> E{Y, 1024};
          pg8::gemm_phase<pg8::EpiBf16<0>, pg8::DenseSched, true>(F.lds, yA, yW, yK, S, E, F.tid); }
        GRID_BAR(); REFRESH();
        row_pass<1>(F, layer, layer == 0, false);
        GRID_BAR(); REFRESH();
        { pg8::DenseSched S; S.o.init(TALL / 256, 1, F.G, F.bid); S.K = 1024;
          pg8::EpiRouter E{(float*)(F.ws + WS_LOGIT)};
          pg8::gemm_phase<pg8::EpiRouter, pg8::DenseSched, true>(F.lds, H, (const bf16_t*)(F.ws + WS_WR) + (size_t)layer * 256 * 1024, 1024, S, E, F.tid); }
        GRID_BAR(); REFRESH();
#ifndef NO_TOPK
        moe_topk(F, layer);
#endif
        GRID_BAR(); REFRESH();
#ifndef NO_SCAT
        moe_scatter(F, layer);
#endif
        GRID_BAR(); REFRESH();
        int nblk;
        { unsigned c = (F.lane < 32) ? __hip_atomic_load(F.ctl + CW_CNT + layer * 64 + F.lane, RLX_AGENT) : 0u; unsigned nb = (c + 255u) >> 8;
          nb = wave_sum_u(nb);
          nblk = __builtin_amdgcn_readfirstlane((int)nb); }
        { pg8::MoeSched<true> S; S.o.init(nblk, 2048 / 256, F.G, F.bid); S.K = 512; S.N = 2048; S.block_e = (const int*)(F.ws + WS_META); S.slot_tok = (const int*)(F.ws + WS_SLOTTOK);
          pg8::EpiMoe1 E{(bf16_t*)(R1 + R1_ACT), INP(IN_MBGU) + (size_t)layer * 32 * 2048};
          pg8::gemm_phase<pg8::EpiMoe1, pg8::MoeSched<true>, true, true>(F.lds, (const bf16_t*)(F.ws + WS_H8), (const bf16_t*)(F.ws + WS_WGU + (size_t)layer * 32 * 2048 * 1024), 512, S, E, F.tid); }
        GRID_BAR(); REFRESH();
        { pg8::MoeSched<false> S; S.o.init(nblk, 1024 / 256, F.G, F.bid); S.K = 512; S.N = 1024; S.block_e = (const int*)(F.ws + WS_META); S.slot_tok = nullptr;
          pg8::EpiMoe2 E{(bf16_t*)(R1 + R1_YK), INP(IN_MBDN) + (size_t)layer * 32 * 1024, (const int*)(F.ws + WS_SLOTDST), (const float*)(F.ws + WS_SLOTGATE)};
          pg8::gemm_phase<pg8::EpiMoe2, pg8::MoeSched<false>, true, true>(F.lds, (const bf16_t*)(R1 + R1_ACT), (const bf16_t*)(F.ws + WS_WDN + (size_t)layer * 32 * 1024 * 1024), 512, S, E, F.tid); }
        GRID_BAR(); REFRESH();
        row_pass<2>(F, layer, false, layer == DEPTH - 1);
        if (layer != DEPTH - 1) GRID_BAR(); REFRESH();
    }
}

extern "C" void kernel_launch(void* const* d_in, const int* in_sizes, int n_in, void* d_out, int out_size, void* d_ws, size_t ws_size, hipStream_t stream) {
    static int grid = 0;
    if (grid == 0) {
        if (n_in != 27 || out_size != NLAT * DM || ws_size < WS_END) { fprintf(stderr, "kernel_launch: unexpected shapes (n_in %d, out %d, ws %zu < %zu)\n", n_in, out_size, ws_size, (size_t)WS_END); grid = -1; return; }
        int dev = 0, cus = 0, per_cu = 0;
        if (hipGetDevice(&dev) != hipSuccess || hipDeviceGetAttribute(&cus, hipDeviceAttributeMultiprocessorCount, dev) != hipSuccess) { grid = -1; return; }
        if (hipFuncSetAttribute((const void*)fwd_kernel, hipFuncAttributeMaxDynamicSharedMemorySize, LDS_BYTES) != hipSuccess) { fprintf(stderr, "kernel_launch: hipFuncSetAttribute failed\n"); grid = -1; return; }
        if (hipOccupancyMaxActiveBlocksPerMultiprocessor(&per_cu, (const void*)fwd_kernel, NWAVES * 64, LDS_BYTES) != hipSuccess || per_cu < 1) { fprintf(stderr, "kernel_launch: occupancy query reports %d\n", per_cu); }
        (void)hipGetLastError();
        grid = cus;
    }
    if (grid < 0) return;
    if (hipMemsetAsync((char*)d_ws + WS_CTL, 0, CTL_ZERO_BYTES, stream) != hipSuccess) return;
    Args a{};
    for (int i = 0; i < 27; ++i) a.in[i] = (const float*)d_in[i];
    a.out = (float*)d_out; a.ws = (unsigned char*)d_ws;
    hipLaunchKernelGGL(fwd_kernel, dim3(grid), dim3(NWAVES * 64), LDS_BYTES, stream, a);
}
#endif
```

```cpp
#include <hip/hip_runtime.h>
#include <hip/hip_bf16.h>
#include <cstdio>
#include <cstdint>
#include <cmath>

#define GAS __attribute__((address_space(1)))
#define LAS __attribute__((address_space(3)))
typedef unsigned short bf16_t;
typedef short bf16x8 __attribute__((ext_vector_type(8)));
typedef short s16x4 __attribute__((ext_vector_type(4)));
typedef float f32x4 __attribute__((ext_vector_type(4)));
typedef float f32x2 __attribute__((ext_vector_type(2)));
typedef float f32x16 __attribute__((ext_vector_type(16)));
typedef unsigned u32x4 __attribute__((ext_vector_type(4)));
typedef unsigned u32x2 __attribute__((ext_vector_type(2)));
typedef GAS unsigned gu32;
#define RLX_AGENT __ATOMIC_RELAXED, __HIP_MEMORY_SCOPE_AGENT

constexpr int DM = 1024, NB = 8, SEQ = 8192, CTXL = 256, DEPTH = 4;
constexpr int NCTX = NB * CTXL;
constexpr int NLAT = NB * SEQ;
constexpr int TALL = NCTX + NLAT;
constexpr int NEXP = 32, TOPK = 4;
constexpr int NBLK_MAX = TALL * TOPK / 256 + NEXP;
constexpr int NSLOT_MAX = NBLK_MAX * 256;
constexpr float LN_EPS = 1e-5f;
constexpr float DN_ALPHA = 1.681792830507429f;
constexpr float LAM_INIT = 0.35550906759096927f;
constexpr int NWAVES = 8;
constexpr float QK_PRESCALE = 0.125f * 1.4426950408889634f;

constexpr size_t MiB = 1u << 20;
constexpr size_t WS_CTL = 0, CTL_ZERO_BYTES = 1 * MiB;
constexpr size_t WS_MOD = 1 * MiB;
constexpr size_t WS_ROPE = 2 * MiB;
constexpr size_t WS_META = 2 * MiB + 64 * 1024;
constexpr size_t WS_STAT = 3 * MiB;
constexpr size_t WS_LOGIT = 4 * MiB;
constexpr size_t WS_TOKE = 13 * MiB;
constexpr size_t WS_TOKG = 15 * MiB;
constexpr size_t WS_SLOTTOK = 17 * MiB;
constexpr size_t WS_SLOTGATE = 19 * MiB;
constexpr size_t WS_SLOTDST = 21 * MiB;
constexpr size_t WS_WIN = 24 * MiB;
constexpr size_t WS_WOUT = 40 * MiB;
constexpr size_t WS_WS = 48 * MiB;
constexpr size_t WS_WQKV = 49 * MiB;
constexpr size_t WS_WO = 55 * MiB;
constexpr size_t WS_CWIN = 57 * MiB;
constexpr size_t WS_CWOUT = 63 * MiB;
constexpr size_t WS_WR = 65 * MiB;
constexpr size_t WS_WGU = 68 * MiB;
constexpr size_t WS_WDN = 580 * MiB;
constexpr size_t WS_X = 836 * MiB;
constexpr size_t WS_H = 1100 * MiB;
constexpr size_t WS_Y = 1234 * MiB;
constexpr size_t WS_R1 = 1368 * MiB;
constexpr size_t R1_Z = 0, R1_VT = 528 * MiB, R1_T = 792 * MiB;
constexpr size_t R1_Q = 0, R1_K = 132 * MiB, R1_V = 264 * MiB, R1_O = 396 * MiB, R1_V8 = 528 * MiB;
constexpr size_t R1_P = 0, R1_BG = 132 * MiB, R1_T2 = 264 * MiB;
constexpr size_t R1_ACT = 0, R1_YK = 288 * MiB;
static_assert(R1_V - R1_K == R1_K - R1_Q, "Q | K | V equally spaced");
constexpr size_t WS_H8 = WS_R1 + 1080 * MiB;
constexpr size_t WS_PART = WS_H8 + 68 * MiB;
constexpr size_t WS_END = WS_PART + 18 * MiB;
static_assert((size_t)TALL * 4096 * 2 <= 528 * MiB && (size_t)NSLOT_MAX * 1024 <= 288 * MiB && R1_YK + (size_t)NSLOT_MAX * 1024 * 2 <= 1080 * MiB, "R1 map");
static_assert((size_t)(TALL + 256) * 1024 * 2 <= 134 * MiB && (size_t)TALL * 1024 * 4 <= 264 * MiB, "X/H map");
constexpr int CW_TMO = 0;
constexpr int CW_CNT = 1024;
constexpr int CW_CUR = 2048;
constexpr int CW_BAR = 4096;

constexpr int RING_BYTES = 131072;
constexpr int MISC_OFF = RING_BYTES;
constexpr int LDS_BYTES = 147456;

#define LDS_WAIT() asm volatile("s_waitcnt lgkmcnt(0)" ::: "memory")
#define VM_WAIT() asm volatile("s_waitcnt vmcnt(0)" ::: "memory")

__device__ __forceinline__ unsigned f2bf(float f) { unsigned u = __builtin_bit_cast(unsigned, f); return (u + 0x7fffu + ((u >> 16) & 1u)) >> 16; }
__device__ __forceinline__ unsigned pk2(float lo, float hi) { return f2bf(lo) | (f2bf(hi) << 16); }
__device__ __forceinline__ float bf2f(unsigned short b) { return __builtin_bit_cast(float, (unsigned)b << 16); }
__device__ __forceinline__ float bflo(unsigned w) { return __builtin_bit_cast(float, w << 16); }
__device__ __forceinline__ float bfhi(unsigned w) { return __builtin_bit_cast(float, w & 0xffff0000u); }
__device__ __forceinline__ unsigned cvt_pk_bf16(float lo, float hi) { unsigned r; asm volatile("v_cvt_pk_bf16_f32 %0, %1, %2" : "=v"(r) : "v"(lo), "v"(hi)); return r; }
typedef int i32x8 __attribute__((ext_vector_type(8)));
__device__ __forceinline__ unsigned cvt_fp8x4(float a, float b, float c, float d) { int w = __builtin_amdgcn_cvt_pk_fp8_f32(a, b, 0, false); w = __builtin_amdgcn_cvt_pk_fp8_f32(c, d, w, true); return (unsigned)w; }
constexpr float YK8_SCALE = 16.0f;
__device__ __forceinline__ unsigned cvt_fp8x4_sat(float a, float b, float c, float d) { return cvt_fp8x4(__builtin_amdgcn_fmed3f(a, -448.f, 448.f), __builtin_amdgcn_fmed3f(b, -448.f, 448.f), __builtin_amdgcn_fmed3f(c, -448.f, 448.f), __builtin_amdgcn_fmed3f(d, -448.f, 448.f)); }
constexpr float W8_SCALE = 32.0f;
constexpr int W8_E8M0 = 0x7A7A7A7A, A8_E8M0 = 0x7F7F7F7F;
__device__ __forceinline__ int opaque_tid(int wave) { int l; asm volatile("v_mbcnt_lo_u32_b32 %0, -1, 0\n\tv_mbcnt_hi_u32_b32 %0, -1, %0" : "=v"(l)); return wave * 64 + l; }
template <int M> __device__ __forceinline__ int swz_xor_i(int v) { return __builtin_amdgcn_ds_swizzle(v, (M << 10) | 0x1f); }
template <int M> __device__ __forceinline__ float swz_xor_f(float v) { return __builtin_bit_cast(float, __builtin_amdgcn_ds_swizzle(__builtin_bit_cast(int, v), (M << 10) | 0x1f)); }
__device__ __forceinline__ float half_sum32(float v) { v += swz_xor_f<1>(v); v += swz_xor_f<2>(v); v += swz_xor_f<4>(v); v += swz_xor_f<8>(v); v += swz_xor_f<16>(v); return v; }
__device__ __forceinline__ float wave_sum(float v) {
    v = half_sum32(v);
    const auto rr = __builtin_amdgcn_permlane32_swap(__float_as_uint(v), __float_as_uint(v), false, false);
    return __uint_as_float(rr[0]) + __uint_as_float(rr[1]);
}
__device__ __forceinline__ unsigned wave_sum_u(unsigned v) {
    v += (unsigned)swz_xor_i<1>((int)v); v += (unsigned)swz_xor_i<2>((int)v); v += (unsigned)swz_xor_i<4>((int)v); v += (unsigned)swz_xor_i<8>((int)v); v += (unsigned)swz_xor_i<16>((int)v);
    const auto rr = __builtin_amdgcn_permlane32_swap(v, v, false, false);
    return rr[0] + rr[1];
}

#define XB_TMO      128
#define XB_XCNT(j)  (256  + 64 * (j))
#define XB_XSUB(j)  (1280 + 64 * (j))
#define XB_XGEN(j)  (2304 + 64 * (j))
#define XB_TOP      3328
#define XB_TOPGEN   3392
#define XCD_BAR_WORDS 3456
#define XB_SPIN_CAP (1u << 22)

__device__ __forceinline__ unsigned xb_ld(unsigned* p)              { return __hip_atomic_load(p, __ATOMIC_RELAXED, __HIP_MEMORY_SCOPE_AGENT); }
__device__ __forceinline__ unsigned xb_add(unsigned* p, unsigned v) { return __hip_atomic_fetch_add(p, v, __ATOMIC_RELAXED, __HIP_MEMORY_SCOPE_AGENT); }
__device__ __forceinline__ unsigned xb_xcc_id() { return (unsigned)__builtin_amdgcn_s_getreg((3 << 11) | 20) & 0xFu; }
#define XB_SPIN(cond, bar) do { unsigned _sp = 0; while (cond) { __builtin_amdgcn_s_sleep(1); \
    if ((++_sp & 255u) == 0u) { if (xb_ld(&(bar)[XB_TMO])) break; if (_sp > XB_SPIN_CAP) { atomicAdd(&(bar)[XB_TMO], 1u); break; } } } } while (0)

struct XcdBarrier { unsigned* bar; unsigned x; volatile LAS unsigned* st; };

__device__ __forceinline__ XcdBarrier xcd_barrier_post(unsigned* bar, volatile LAS unsigned* st) {
    XcdBarrier b; b.bar = bar; b.x = xb_xcc_id(); b.st = st;
    if (threadIdx.x == 0) (void)xb_add(&bar[XB_XCNT(b.x)], 1u);
    return b;
}
__device__ __forceinline__ void xcd_barrier_complete(unsigned* bar, unsigned x, unsigned& nloc, unsigned& nx) {
    const unsigned G = gridDim.x * gridDim.y * gridDim.z;
    unsigned sum, cnt, mine, sp = 0u;
    for (;;) {
        sum = 0u; cnt = 0u; mine = 0u;
#pragma unroll
        for (unsigned j = 0; j < 16; ++j) { const unsigned c = xb_ld(&bar[XB_XCNT(j)]); sum += c; cnt += (c > 0u) ? 1u : 0u; mine = (j == x) ? c : mine; }
        if (sum == G) break;
        __builtin_amdgcn_s_sleep(1);
        if ((++sp & 255u) == 0u) { if (xb_ld(&bar[XB_TMO])) break; if (sp > XB_SPIN_CAP) { atomicAdd(&bar[XB_TMO], 1u); break; } }
    }
    nloc = mine > 0u ? mine : 1u; nx = cnt > 0u ? cnt : 1u;
}
__device__ __forceinline__ void xcd_barrier(const XcdBarrier& b, const bool leader) {
    asm volatile("s_waitcnt vmcnt(0)" ::: "memory");
    __syncthreads();
    if (leader) {
        GAS unsigned* gbar_ = (GAS unsigned*)b.bar; asm volatile("" : "+s"(gbar_)); unsigned* bar = (unsigned*)gbar_; const unsigned bx_ = (unsigned)__builtin_amdgcn_readfirstlane((int)xb_xcc_id());
        __builtin_amdgcn_s_waitcnt(0);
        unsigned nloc = b.st[0], nx = b.st[1];
        if (nloc == 0u) { xcd_barrier_complete(bar, bx_, nloc, nx); b.st[0] = nloc; b.st[1] = nx; }
        const unsigned old = xb_add(&bar[XB_XSUB(bx_)], 1u);
        const unsigned gen = old / nloc;
        if (old + 1u == (gen + 1u) * nloc) {
            __builtin_amdgcn_fence(__ATOMIC_RELEASE, "agent");
            asm volatile("s_waitcnt vmcnt(0)" ::: "memory");
            const unsigned og = xb_add(&bar[XB_TOP], 1u);
            const unsigned tg = og / nx;
            if (og + 1u == (tg + 1u) * nx) xb_add(&bar[XB_TOPGEN], 1u);
            else XB_SPIN(xb_ld(&bar[XB_TOPGEN]) == tg, bar);
            __builtin_amdgcn_fence(__ATOMIC_ACQUIRE, "agent");
            xb_add(&bar[XB_XGEN(bx_)], 1u);
            asm volatile("s_waitcnt vmcnt(0)" ::: "memory");
        } else {
            XB_SPIN(xb_ld(&bar[XB_XGEN(bx_)]) == gen, bar);
            __builtin_amdgcn_fence(__ATOMIC_ACQUIRE, "agent");
            asm volatile("s_waitcnt vmcnt(0)" ::: "memory");
        }
    }
    __syncthreads();
}

namespace pg8 {
constexpr int BM = 256, BK = 64, HALF = 128, HTB = HALF * BK * 2, STAGE_BYTES = 8 * HTB, NXCD = 8, WGM = 8;
__host__ __device__ __forceinline__ int lds_byte(int r, int c) { const int st = (r >> 4) * 2 + (c >> 5), rr = r & 15, cc = c & 31, ob = rr * 64 + cc * 2; return st * 1024 + (ob ^ (((ob >> 9) & 1) << 5)); }
__host__ __device__ __forceinline__ void stage_rc(int b, int& R, int& C) { const int st = b / 1024, sb = b % 1024, swz = sb ^ (((sb >> 9) & 1) << 5); R = (st >> 1) * 16 + swz / 64; C = (st & 1) * 32 + (swz % 64) / 2; }
__host__ __device__ __forceinline__ int perm32(int rho) { const int n = rho >> 4, i = rho & 15; return 8 * (i >> 2) + 4 * n + (i & 3); }

struct Unit { int pm, pn, e; };
__device__ __forceinline__ void glds16_s(const char* gbase, unsigned voff, unsigned lds_dst);
constexpr int EPI_LDS_OFF = MISC_OFF + 8704, EPI_LDS_BUF = 3072;

struct TileOrder {
    int nM, nN, nwg, G, c, pm0;
    __device__ __forceinline__ void init(int nM_, int nN_, int G_, int c_, int pm0_ = 0) { nM = nM_; nN = nN_; nwg = nM * nN; G = G_; c = c_; pm0 = pm0_; }
    __device__ __forceinline__ bool tile(int i, int& pm, int& pn) const {
        const long L = (long)i * G + c; if (L >= nwg) return false;
        int wgid = (int)L; { const int q = nwg / NXCD, r = nwg % NXCD, xcd = wgid % NXCD, off = wgid / NXCD; wgid = (xcd < r ? xcd * (q + 1) : r * (q + 1) + (xcd - r) * q) + off; }
        const int nig = WGM * nN, gid = wgid / nig, fm = gid * WGM, gsz = (nM - fm) < WGM ? (nM - fm) : WGM;
        pm = pm0 + fm + ((wgid % nig) % gsz); pn = (wgid % nig) / gsz; return true;
    }
};
struct DenseSched {
    TileOrder o; int K;
    static constexpr bool ASYNC_ROWS = false;
    __device__ __forceinline__ bool next(int i, Unit& u) const { u.e = 0; return o.tile(i, u.pm, u.pn); }
    __device__ __forceinline__ unsigned a_row(const Unit& u, int r) const { return (unsigned)(u.pm * BM + r); }
    __device__ __forceinline__ unsigned a_row_async(const Unit& u, int r) const { return a_row(u, r); }
    __device__ __forceinline__ size_t b_off(const Unit& u) const { return (size_t)u.pn * BM * K; }
};
template <bool GATHER> struct MoeSched {
    TileOrder o; int K, N; const LAS int* block_e; const int* slot_tok;
    static constexpr bool ASYNC_ROWS = GATHER;
    __device__ __forceinline__ bool next(int i, Unit& u) const {
        if (!o.tile(i, u.pm, u.pn)) return false;
        u.e = __builtin_amdgcn_readfirstlane(block_e[u.pm]); return true; }
    __device__ __forceinline__ unsigned a_row(const Unit& u, int r) const { if (GATHER) return (unsigned)slot_tok[u.pm * BM + r]; else return (unsigned)(u.pm * BM + r); }
    __device__ __forceinline__ unsigned a_row_async(const Unit& u, int r) const {
        if (GATHER) { unsigned v; asm volatile("global_load_dword %0, %1, %2" : "=v"(v) : "v"((unsigned)(u.pm * BM + r) * 4u), "s"(slot_tok) : "memory"); return v; }
        else return (unsigned)(u.pm * BM + r); }
    __device__ __forceinline__ size_t b_off(const Unit& u) const { return ((size_t)u.e * N + (size_t)u.pn * BM) * K; }
};

__device__ __forceinline__ f32x2 gelu_pk(f32x2 v) {
    const f32x2 av = __builtin_elementwise_abs(v), d = av * 0.2316418882f + 1.0f;
    f32x2 t; t.x = __builtin_amdgcn_rcpf(d.x); t.y = __builtin_amdgcn_rcpf(d.y);
    f32x2 q = t * 0.5307027145f + (-0.7265760135f); q = q * t + 0.7107068705f; q = q * t + (-0.142248368f); q = q * t + 0.127414796f; q = q * t;
    const f32x2 s = (v * v) * (-0.72134752044f);
    f32x2 e; e.x = __builtin_amdgcn_exp2f(s.x); e.y = __builtin_amdgcn_exp2f(s.y);
    const f32x2 m = v * (q * e), r = v - m;
    f32x2 o; o.x = v.x < 0.f ? m.x : r.x; o.y = v.y < 0.f ? m.y : r.y; return o;
}
__device__ __forceinline__ u32x4 pack8(f32x4 v0, f32x4 v1) { u32x4 w; w.x = cvt_pk_bf16(v0[0], v0[1]); w.y = cvt_pk_bf16(v0[2], v0[3]); w.z = cvt_pk_bf16(v1[0], v1[1]); w.w = cvt_pk_bf16(v1[2], v1[3]); return w; }
__device__ __forceinline__ u32x2 pack4(f32x4 v) { u32x2 w; w.x = cvt_pk_bf16(v[0], v[1]); w.y = cvt_pk_bf16(v[2], v[3]); return w; }

template <int ACT> struct EpiBf16 {
    __device__ __forceinline__ void prefetch(const Unit&, unsigned, int, int) const {}
    static constexpr bool PERM = true;
    bf16_t* O; int ldc;
    __device__ __forceinline__ void operator()(const f32x4 (&acc)[2][2][4][2], const Unit& u, int wr, int wc, int fr, int fq, const LAS unsigned char* epl) const {
        const int row0 = u.pm * BM + wr * 64 + fr, col0 = u.pn * BM + wc * 32 + 8 * fq;
#pragma unroll
        for (int ai = 0; ai < 2; ++ai)
#pragma unroll
            for (int m = 0; m < 4; ++m) { bf16_t* rowp = O + (size_t)(row0 + ai * HALF + m * 16) * ldc + col0;
#pragma unroll
                for (int bj = 0; bj < 2; ++bj) { f32x4 v0 = acc[ai][bj][m][0], v1 = acc[ai][bj][m][1];
                    if (ACT == 1) { f32x2 a = gelu_pk((f32x2){v0[0], v0[1]}), b = gelu_pk((f32x2){v0[2], v0[3]}), c = gelu_pk((f32x2){v1[0], v1[1]}), d = gelu_pk((f32x2){v1[2], v1[3]});
                        v0 = (f32x4){a.x, a.y, b.x, b.y}; v1 = (f32x4){c.x, c.y, d.x, d.y}; }
                    *(u32x4*)(rowp + bj * HALF) = pack8(v0, v1); } }
    }
};
struct EpiGeluStats {
    static constexpr bool PERM = true;
    __device__ __forceinline__ void prefetch(const Unit&, unsigned, int, int) const {}
    bf16_t* O; float* part;
    __device__ __forceinline__ void operator()(const f32x4 (&acc)[2][2][4][2], const Unit& u, int wr, int wc, int fr, int fq, const LAS unsigned char*) const {
        const int row0 = u.pm * BM + wr * 64 + fr, col0 = u.pn * BM + wc * 32 + 8 * fq;
#pragma unroll
        for (int ai = 0; ai < 2; ++ai)
#pragma unroll
            for (int m = 0; m < 4; ++m) { const int row = row0 + ai * HALF + m * 16; bf16_t* rowp = O + (size_t)row * 4096 + col0; float sm = 0.f, sq = 0.f;
#pragma unroll
                for (int bj = 0; bj < 2; ++bj) { f32x4 v0 = acc[ai][bj][m][0], v1 = acc[ai][bj][m][1];
                    { f32x2 a = gelu_pk((f32x2){v0[0], v0[1]}), b = gelu_pk((f32x2){v0[2], v0[3]}), c = gelu_pk((f32x2){v1[0], v1[1]}), d = gelu_pk((f32x2){v1[2], v1[3]});
                      v0 = (f32x4){a.x, a.y, b.x, b.y}; v1 = (f32x4){c.x, c.y, d.x, d.y}; }
                    sm += ((v0[0] + v0[1]) + (v0[2] + v0[3])) + ((v1[0] + v1[1]) + (v1[2] + v1[3]));
                    sq += ((v0[0] * v0[0] + v0[1] * v0[1]) + (v0[2] * v0[2] + v0[3] * v0[3])) + ((v1[0] * v1[0] + v1[1] * v1[1]) + (v1[2] * v1[2] + v1[3] * v1[3]));
                    *(u32x4*)(rowp + bj * HALF) = pack8(v0, v1); }
                if (u.pn >= 8) {
                    sm += swz_xor_f<16>(sm); sq += swz_xor_f<16>(sq);
                    { const auto r1 = __builtin_amdgcn_permlane32_swap(__float_as_uint(sm), __float_as_uint(sm), false, false); sm = __uint_as_float(r1[0]) + __uint_as_float(r1[1]);
                      const auto r2 = __builtin_amdgcn_permlane32_swap(__float_as_uint(sq), __float_as_uint(sq), false, false); sq = __uint_as_float(r2[0]) + __uint_as_float(r2[1]); }
                    if (fq == 0) *(f32x2*)(part + ((size_t)row * 32 + (u.pn - 8) * 4 + wc) * 2) = (f32x2){sm, sq}; } }
    }
};
struct EpiQKV {
    __device__ __forceinline__ void prefetch(const Unit&, unsigned, int, int) const {}
    static constexpr bool PERM = false;
    bf16_t* Q; size_t qkv_stride; const float* ropec; const float* ropes; unsigned char* V8;
    __device__ __forceinline__ void operator()(const f32x4 (&acc)[2][2][4][2], const Unit& u, int wr, int wc, int fr, int fq, const LAS unsigned char* epl) const {
        const int t = u.pn >> 2, colt = (u.pn & 3) * BM;
        if (t == 2) {
#pragma unroll
            for (int ai = 0; ai < 2; ++ai) {
                const int g0 = u.pm * BM + ai * HALF + wr * 64;
                const int b = g0 < NCTX ? (g0 >> 8) : ((g0 - NCTX) >> 13), jt = g0 < NCTX ? ((g0 & 255) >> 6) : 4 + (((g0 - NCTX) & (SEQ - 1)) >> 6);
#pragma unroll
                for (int bj = 0; bj < 2; ++bj) { const int h = (u.pn & 3) * 2 + bj;
                    unsigned char* img = V8 + ((size_t)((b * 8 + h) * 132 + jt)) * 8192 + (wc * 32 + 4 * fq) * 64 + 4 * fr;
#pragma unroll
                    for (int n = 0; n < 2; ++n)
#pragma unroll
                        for (int j = 0; j < 4; ++j) *(unsigned*)(img + (16 * n + j) * 64) = cvt_fp8x4(acc[ai][bj][0][n][j], acc[ai][bj][1][n][j], acc[ai][bj][2][n][j], acc[ai][bj][3][n][j]); } }
            return;
        }
        bf16_t* base = Q + (size_t)t * qkv_stride;
#pragma unroll
        for (int ai = 0; ai < 2; ++ai)
#pragma unroll
            for (int m = 0; m < 4; ++m) {
                const int row = u.pm * BM + ai * HALF + wr * 64 + m * 16 + fr;
                f32x4 cs = (f32x4){1.f, 1.f, 1.f, 1.f}, sn = (f32x4){0.f, 0.f, 0.f, 0.f};
                if (row >= NCTX) { const int tp = (row - NCTX) & (SEQ - 1); const int pos = (wc & 1) ? (tp & 63) : (tp >> 6);
                    cs = *(const f32x4*)(ropec + pos * 16 + 4 * fq); sn = *(const f32x4*)(ropes + pos * 16 + 4 * fq); }
#pragma unroll
                for (int bj = 0; bj < 2; ++bj) { const f32x4 x1 = acc[ai][bj][m][0], x2 = acc[ai][bj][m][1];
                    f32x4 o1 = x1 * cs - x2 * sn, o2 = x1 * sn + x2 * cs;
                    if (t == 0) { o1 = o1 * QK_PRESCALE; o2 = o2 * QK_PRESCALE; }
                    { unsigned char* r8 = (unsigned char*)base + (size_t)row * DM + colt + wc * 32 + 4 * fq + bj * HALF;
                        *(unsigned*)r8 = cvt_fp8x4_sat(o1[0], o1[1], o1[2], o1[3]); *(unsigned*)(r8 + 16) = cvt_fp8x4_sat(o2[0], o2[1], o2[2], o2[3]); } } }
    }
};
struct EpiConvIn {
    __device__ __forceinline__ void prefetch(const Unit&, unsigned, int, int) const {}
    static constexpr bool PERM = true;
    bf16_t* P; bf16_t* BG;
    __device__ __forceinline__ void operator()(const f32x4 (&acc)[2][2][4][2], const Unit& u, int wr, int wc, int fr, int fq, const LAS unsigned char* epl) const {
        const int row0 = u.pm * BM + wr * 64 + fr;
#pragma unroll
        for (int ai = 0; ai < 2; ++ai)
#pragma unroll
            for (int m = 0; m < 4; ++m) { const size_t row = (size_t)(row0 + ai * HALF + m * 16);
                if (u.pn < 8) { *(u32x4*)(P + row * DM + u.pn * HALF + wc * 32 + 8 * fq) = pack8(acc[ai][0][m][0] * acc[ai][1][m][0], acc[ai][0][m][1] * acc[ai][1][m][1]); }
                else {
#pragma unroll
                    for (int bj = 0; bj < 2; ++bj) *(u32x4*)(BG + row * DM + (u.pn - 8) * BM + bj * HALF + wc * 32 + 8 * fq) = pack8(acc[ai][bj][m][0], acc[ai][bj][m][1]); } }
    }
};
struct EpiRouter {
    __device__ __forceinline__ void prefetch(const Unit&, unsigned, int, int) const {}
    static constexpr bool PERM = false;
    float* L;
    __device__ __forceinline__ void operator()(const f32x4 (&acc)[2][2][4][2], const Unit& u, int wr, int wc, int fr, int fq, const LAS unsigned char* epl) const {
        if (wc != 0) return;
#pragma unroll
        for (int ai = 0; ai < 2; ++ai)
#pragma unroll
            for (int m = 0; m < 4; ++m) { float* rowp = L + (size_t)(u.pm * BM + ai * HALF + wr * 64 + m * 16 + fr) * NEXP + 4 * fq;
                *(f32x4*)(rowp) = acc[ai][0][m][0]; *(f32x4*)(rowp + 16) = acc[ai][0][m][1]; }
    }
};
struct EpiMoe1 {
    static constexpr bool PERM = true;
    bf16_t* ACT; const float* bgu;
    __device__ __forceinline__ void prefetch(const Unit& u, unsigned lds_dst, int wid, int lane) const {
        if (wid == 0) { const unsigned off = (unsigned)((u.e * 2048 + (lane >> 5) * 1024 + u.pn * HALF) * 4 + (lane & 31) * 16); glds16_s((const char*)bgu, off, lds_dst); } }
    __device__ __forceinline__ void operator()(const f32x4 (&acc)[2][2][4][2], const Unit& u, int wr, int wc, int fr, int fq, const LAS unsigned char* epl) const {
        const int ff0 = u.pn * HALF + wc * 32 + 8 * fq;
        f32x4 bg[2], bu[2];
#pragma unroll
        for (int n = 0; n < 2; ++n) { bg[n] = *(const LAS f32x4*)(epl + (wc * 32 + 8 * fq + 4 * n) * 4); bu[n] = *(const LAS f32x4*)(epl + 512 + (wc * 32 + 8 * fq + 4 * n) * 4); }
#pragma unroll
        for (int ai = 0; ai < 2; ++ai)
#pragma unroll
            for (int m = 0; m < 4; ++m) { const size_t row = (size_t)(u.pm * BM + ai * HALF + wr * 64 + m * 16 + fr);
                f32x4 o[2];
#pragma unroll
                for (int n = 0; n < 2; ++n) { const f32x4 gv = acc[ai][0][m][n] + bg[n], uv = acc[ai][1][m][n] + bu[n];
#pragma unroll
                    for (int jj = 0; jj < 2; ++jj) { f32x2 g, up; g.x = fminf(gv[2 * jj], 7.0f); g.y = fminf(gv[2 * jj + 1], 7.0f);
                        up.x = __builtin_amdgcn_fmed3f(uv[2 * jj], -7.0f, 7.0f); up.y = __builtin_amdgcn_fmed3f(uv[2 * jj + 1], -7.0f, 7.0f);
                        const f32x2 ea = g * (-1.702f * 1.4426950408889634f); f32x2 e; e.x = __builtin_amdgcn_exp2f(ea.x); e.y = __builtin_amdgcn_exp2f(ea.y);
                        const f32x2 de = e + 1.0f; f32x2 sg; sg.x = __builtin_amdgcn_rcpf(de.x); sg.y = __builtin_amdgcn_rcpf(de.y);
                        const f32x2 r = (up + 1.0f) * (g * sg); o[n][2 * jj] = r.x; o[n][2 * jj + 1] = r.y; } }
                u32x2 w8; w8.x = cvt_fp8x4(o[0][0], o[0][1], o[0][2], o[0][3]); w8.y = cvt_fp8x4(o[1][0], o[1][1], o[1][2], o[1][3]);
                *(u32x2*)((unsigned char*)ACT + row * DM + ff0) = w8; }
    }
};
struct EpiMoe2 {
    static constexpr bool PERM = true;
    bf16_t* YK; const float* bdn; const float* slot_gate;
    __device__ __forceinline__ void prefetch(const Unit& u, unsigned lds_dst, int wid, int lane) const {
        if (wid == 0) glds16_s((const char*)bdn, (unsigned)((u.e * 1024 + u.pn * BM) * 4 + lane * 16), lds_dst);
        else if (wid == 2) glds16_s((const char*)slot_gate, (unsigned)(u.pm * BM * 4 + lane * 16), lds_dst + 2048u); }
    __device__ __forceinline__ void operator()(const f32x4 (&acc)[2][2][4][2], const Unit& u, int wr, int wc, int fr, int fq, const LAS unsigned char* epl) const {
        const int col0 = u.pn * BM + wc * 32 + 8 * fq;
        f32x4 bv[2][2];
#pragma unroll
        for (int bj = 0; bj < 2; ++bj)
#pragma unroll
            for (int n = 0; n < 2; ++n) bv[bj][n] = *(const LAS f32x4*)(epl + (wc * 32 + 8 * fq + bj * HALF + 4 * n) * 4);
#pragma unroll
        for (int ai = 0; ai < 2; ++ai)
#pragma unroll
            for (int m = 0; m < 4; ++m) { const int sl = ai * HALF + wr * 64 + m * 16 + fr;
                const float gate = *(const LAS float*)(epl + 2048 + sl * 4);
                unsigned char* rowp = (unsigned char*)YK + (size_t)(u.pm * BM + sl) * DM + col0;
                const float g8 = gate * YK8_SCALE;
#pragma unroll
                for (int bj = 0; bj < 2; ++bj) { const f32x4 a0 = (acc[ai][bj][m][0] + bv[bj][0]) * g8, a1 = (acc[ai][bj][m][1] + bv[bj][1]) * g8;
                    u32x2 w8; w8.x = cvt_fp8x4(a0[0], a0[1], a0[2], a0[3]); w8.y = cvt_fp8x4(a1[0], a1[1], a1[2], a1[3]); *(u32x2*)(rowp + bj * HALF) = w8; } }
    }
};

__device__ __forceinline__ void glds16_s(const char* gbase, unsigned voff, unsigned lds_dst) { unsigned keep;
    asm volatile("s_mov_b32 %0, m0\n\ts_mov_b32 m0, %3\n\ts_nop 0\n\tglobal_load_lds_dwordx4 %1, %2\n\ts_mov_b32 m0, %0" : "=&s"(keep) : "v"(voff), "s"(gbase), "s"(lds_dst) : "memory"); }
template <class Epi, class Sched, bool ALIGN_EPI, bool FP8 = false>
__device__ __forceinline__ void gemm_phase(LAS unsigned char* lds, const bf16_t* A, const bf16_t* Bt, const int K, const Sched& S, const Epi& E, const int wave_in) {
    const int tid = opaque_tid(wave_in); const int wid = __builtin_amdgcn_readfirstlane(tid >> 6), lane = tid & 63, wr = wid >> 2, wc = wid & 3, fr = lane & 15, fq = lane >> 4;
    const int nt = K / BK;
    int sR[2], sC[2]; unsigned voffB[2];
#pragma unroll
    for (int i = 0; i < 2; ++i) { stage_rc(tid * 16 + i * 8192, sR[i], sC[i]); const int Rb = Epi::PERM ? ((sR[i] & ~31) + perm32(sR[i] & 31)) : sR[i];
        voffB[i] = (unsigned)(Rb * K + sC[i]) * 2u; }
    const size_t kstep = (size_t)(BK * 2);
    const size_t hstep = (size_t)HALF * K * 2;
    const unsigned ldsw = (unsigned)wid * 1024u;
    const unsigned ldsbase = (unsigned)__builtin_amdgcn_readfirstlane((int)((unsigned)(uintptr_t)lds + ldsw));
    const int aoff = lds_byte(wr * 64 + fr, fq * 8), boff = lds_byte(wc * 32 + fr, fq * 8);
#define PG8_SA(b, h) (((b) * 2 + (h)) * HTB)
#define PG8_SB(b, h) ((4 + (b) * 2 + (h)) * HTB)
#define PG8_STAGE(bufoff, gbase, v0, v1) do { glds16_s((gbase), (v0), ldsbase + (unsigned)(bufoff)); glds16_s((gbase), (v1), ldsbase + (unsigned)(bufoff) + 8192u); } while (0)
#define PG8_LDA(dst, b, h) do { _Pragma("unroll") for (int m = 0; m < 4; ++m) _Pragma("unroll") for (int k = 0; k < 2; ++k) dst[m][k] = *(const LAS bf16x8*)(lds + PG8_SA(b, h) + aoff + m * 2048 + k * 1024); } while (0)
#define PG8_LDB(dst, b, h) do { _Pragma("unroll") for (int n = 0; n < 2; ++n) _Pragma("unroll") for (int k = 0; k < 2; ++k) dst[n][k] = *(const LAS bf16x8*)(lds + PG8_SB(b, h) + boff + n * 2048 + k * 1024); } while (0)
#define PG8_CAT(x, y) __builtin_bit_cast(i32x8, __builtin_shufflevector(x, y, 0, 1, 2, 3, 4, 5, 6, 7, 8, 9, 10, 11, 12, 13, 14, 15))
#define PG8_MMA(ai, bj, At, Bt_) do { __builtin_amdgcn_s_setprio(1); _Pragma("unroll") for (int m = 0; m < 4; ++m) _Pragma("unroll") for (int n = 0; n < 2; ++n) { \
        if constexpr (FP8) asm volatile("v_mfma_scale_f32_16x16x128_f8f6f4 %0, %1, %2, %0, %3, %4 op_sel_hi:[0,0,0]" : "+v"(acc[ai][bj][m][n]) : "v"(PG8_CAT(Bt_[n][0], Bt_[n][1])), "v"(PG8_CAT(At[m][0], At[m][1])), "v"(sclW), "v"(sclA)); \
        else { _Pragma("unroll") for (int k = 0; k < 2; ++k) acc[ai][bj][m][n] = __builtin_amdgcn_mfma_f32_16x16x32_bf16(Bt_[n][k], At[m][k], acc[ai][bj][m][n], 0, 0, 0); } } __builtin_amdgcn_s_setprio(0); } while (0)
#define PG8_WAIT_V(n) asm volatile("s_waitcnt vmcnt(" #n ")" ::: "memory")
#define PG8_WAIT_L(n) asm volatile("s_waitcnt lgkmcnt(" #n ")" ::: "memory")
#define PG8_BAR __builtin_amdgcn_s_barrier()
#define PG8_SCHED __builtin_amdgcn_sched_barrier(0)
#define PG8_AOFF(dst, u) do { _Pragma("unroll") for (int h = 0; h < 2; ++h) _Pragma("unroll") for (int i = 0; i < 2; ++i) dst[h][i] = (S.a_row(u, h * HALF + sR[i]) * (unsigned)K + (unsigned)sC[i]) * 2u; } while (0)
    Unit cur, nxt; int ui = 0;
    if (!S.next(0, cur)) return;
    f32x4 acc[2][2][4][2];
#pragma unroll
    for (int a = 0; a < 2; ++a)
#pragma unroll
        for (int b = 0; b < 2; ++b)
#pragma unroll
            for (int m = 0; m < 4; ++m)
#pragma unroll
                for (int n = 0; n < 2; ++n) acc[a][b][m][n] = (f32x4){0.f, 0.f, 0.f, 0.f};
    bf16x8 At[4][2], B0[2][2], B1[2][2];
    const int sclW = W8_E8M0, sclA = A8_E8M0;
    unsigned vA[2][2], vN[2][2];
    PG8_AOFF(vA, cur);
    const char* const cA = (const char*)A;
    const char* cB = (const char*)Bt + S.b_off(cur) * 2;
    PG8_STAGE(PG8_SB(0, 0), cB, voffB[0], voffB[1]); PG8_STAGE(PG8_SB(0, 1), cB + hstep, voffB[0], voffB[1]); PG8_STAGE(PG8_SA(0, 0), cA, vA[0][0], vA[0][1]); PG8_STAGE(PG8_SA(0, 1), cA, vA[1][0], vA[1][1]);
    if (wr == 1) PG8_BAR;
    PG8_WAIT_V(2); PG8_BAR;
    PG8_STAGE(PG8_SB(1, 0), cB + kstep, voffB[0], voffB[1]); PG8_STAGE(PG8_SA(1, 0), cA + kstep, vA[0][0], vA[0][1]); PG8_STAGE(PG8_SB(1, 1), cB + hstep + kstep, voffB[0], voffB[1]);
    PG8_WAIT_V(6); PG8_BAR;
    for (;;) {
        const bool has_next = S.next(ui + 1, nxt);
        const char* nB = cB;
        E.prefetch(cur, (unsigned)__builtin_amdgcn_readfirstlane((int)((unsigned)(uintptr_t)lds + (unsigned)(EPI_LDS_OFF - 0) + (unsigned)((ui & 1) * EPI_LDS_BUF))), wid, lane);
        if (has_next) { nB = (const char*)Bt + S.b_off(nxt) * 2;
#pragma unroll
            for (int h = 0; h < 2; ++h)
#pragma unroll
                for (int i = 0; i < 2; ++i) { if constexpr (Sched::ASYNC_ROWS) vN[h][i] = S.a_row_async(nxt, h * HALF + sR[i]);
                                              else vN[h][i] = (S.a_row(nxt, h * HALF + sR[i]) * (unsigned)K + (unsigned)sC[i]) * 2u; } }
        else {
#pragma unroll
            for (int h = 0; h < 2; ++h)
#pragma unroll
                for (int i = 0; i < 2; ++i) vN[h][i] = vA[h][i]; }
#pragma clang loop unroll(disable)
        for (int t = 0; t < nt; t += 2) {
            const bool last = (t == nt - 2);
            const char* a1 = cA + (size_t)(t + 1) * kstep;
            const char* a2 = last ? cA : cA + (size_t)(t + 2) * kstep; const char* b2 = last ? nB : cB + (size_t)(t + 2) * kstep;
            const char* a3 = a2 + kstep; const char* b3 = b2 + kstep;
            if constexpr (Sched::ASYNC_ROWS) { if (last && has_next) { asm volatile("" : "+v"(vN[0][0]), "+v"(vN[0][1]), "+v"(vN[1][0]), "+v"(vN[1][1]));
#pragma unroll
                for (int h = 0; h < 2; ++h)
#pragma unroll
                    for (int i = 0; i < 2; ++i) vN[h][i] = (vN[h][i] * (unsigned)K + (unsigned)sC[i]) * 2u; } }
            const unsigned w00 = last ? vN[0][0] : vA[0][0], w01 = last ? vN[0][1] : vA[0][1], w10 = last ? vN[1][0] : vA[1][0], w11 = last ? vN[1][1] : vA[1][1];
            PG8_LDB(B0, 0, 0); PG8_LDB(B1, 0, 1); PG8_SCHED; PG8_LDA(At, 0, 0); PG8_STAGE(PG8_SA(1, 1), a1, vA[1][0], vA[1][1]);
            PG8_WAIT_V(8); PG8_WAIT_L(0); PG8_BAR; PG8_MMA(0, 0, At, B0); PG8_MMA(0, 1, At, B1); PG8_BAR; PG8_SCHED;
            PG8_LDA(At, 0, 1); PG8_STAGE(PG8_SB(0, 0), b2, voffB[0], voffB[1]); PG8_STAGE(PG8_SB(0, 1), b2 + hstep, voffB[0], voffB[1]); PG8_STAGE(PG8_SA(0, 0), a2, w00, w01);
            PG8_WAIT_V(8); PG8_WAIT_L(0); PG8_BAR; PG8_MMA(1, 0, At, B0); PG8_MMA(1, 1, At, B1); PG8_BAR; PG8_SCHED;
            PG8_LDB(B0, 1, 0); PG8_LDB(B1, 1, 1); PG8_SCHED; PG8_LDA(At, 1, 0); PG8_STAGE(PG8_SA(0, 1), a2, w10, w11);
            PG8_WAIT_V(8); PG8_WAIT_L(0); PG8_BAR; PG8_MMA(0, 0, At, B0); PG8_MMA(0, 1, At, B1); PG8_BAR; PG8_SCHED;
            PG8_LDA(At, 1, 1); PG8_STAGE(PG8_SB(1, 0), b3, voffB[0], voffB[1]); PG8_STAGE(PG8_SB(1, 1), b3 + hstep, voffB[0], voffB[1]); PG8_STAGE(PG8_SA(1, 0), a3, w00, w01);
            PG8_WAIT_V(8); PG8_WAIT_L(0); PG8_BAR; PG8_MMA(1, 0, At, B0); PG8_MMA(1, 1, At, B1); PG8_BAR; PG8_SCHED;
        }
        if constexpr (FP8) asm volatile("s_nop 15\n\ts_nop 15" ::: "memory");
        if constexpr (ALIGN_EPI) { if (wr == 0) PG8_BAR; }
        { int fr_ = fr, fq_ = fq; asm volatile("" : "+v"(fr_), "+v"(fq_)); E(acc, cur, wr, wc, fr_, fq_, lds + EPI_LDS_OFF + (ui & 1) * EPI_LDS_BUF); }
        if (!has_next) break;
#pragma unroll
        for (int a = 0; a < 2; ++a)
#pragma unroll
            for (int b = 0; b < 2; ++b)
#pragma unroll
                for (int m = 0; m < 4; ++m)
#pragma unroll
                    for (int n = 0; n < 2; ++n) acc[a][b][m][n] = (f32x4){0.f, 0.f, 0.f, 0.f};
        cur = nxt; cB = nB; ++ui;
#pragma unroll
        for (int h = 0; h < 2; ++h)
#pragma unroll
            for (int i = 0; i < 2; ++i) vA[h][i] = vN[h][i];
        if constexpr (ALIGN_EPI) { if (wr == 1) PG8_BAR; }
    }
    PG8_WAIT_V(0);
    if constexpr (!ALIGN_EPI) { if (wr == 0) PG8_BAR; }
    PG8_BAR;
#undef PG8_SA
#undef PG8_SB
#undef PG8_STAGE
#undef PG8_LDA
#undef PG8_LDB
#undef PG8_MMA
#undef PG8_WAIT_V
#undef PG8_WAIT_L
#undef PG8_BAR
#undef PG8_SCHED
#undef PG8_AOFF
#undef PG8_CAT
}
}

namespace att {
constexpr int QBLK = 32, KVBLK = 64;
constexpr float SCALE = 0.125f;
constexpr float THR = 8.f;
constexpr int SHM_V = KVBLK * 128 * 2, SHM_K = KVBLK * 128 * 2;
constexpr int LDS_WSF = 2 * SHM_V + 2 * SHM_K;
#define KSWZ(row, colB) ((row) * 256 + ((colB) ^ (((row) & 7) << 4)))
#define SBAR() __builtin_amdgcn_sched_barrier(0)
__device__ __forceinline__ int crow(int r, int hi) { return (r & 3) + 8 * (r >> 2) + 4 * hi; }

__device__ __forceinline__ void qkt(f32x16& p0, f32x16& p1, const char* Ks, const bf16x8* qr, int r32, int hi, int cq) {
  p0 = f32x16{}; p1 = f32x16{};
#pragma unroll
  for (int d0 = 0; d0 < 4; ++d0) { const int cb = (cq * 64 + d0 * 16 + hi * 8) * 2;
    const bf16x8 b0 = *reinterpret_cast<const bf16x8*>(Ks + KSWZ(r32, cb));
    const bf16x8 b1 = *reinterpret_cast<const bf16x8*>(Ks + KSWZ(32 + r32, cb));
    p0 = __builtin_amdgcn_mfma_f32_32x32x16_bf16(b0, qr[d0], p0, 0, 0, 0);
    p1 = __builtin_amdgcn_mfma_f32_32x32x16_bf16(b1, qr[d0], p1, 0, 0, 0); }
}
__device__ __forceinline__ int v_st(int k, int c) { const int kk = (k & ~0xC) | ((k & 4) << 1) | ((k & 8) >> 1); return ((kk >> 3) * 4 + (c >> 5)) * 512 + ((kk & 7) * 32 + (c & 31)) * 2; }
__device__ __forceinline__ int v_rd_base(int lane) { return ((lane & 3) << 3) | (((lane >> 2) & 3) << 6) | (((lane >> 4) & 1) << 5) | (((lane >> 5) & 1) << 8); }
constexpr int v_rd_off(int d0, int ks, int half) { return d0 * 512 + ks * 4096 + half * 2048; }
template <int OFF> __device__ __forceinline__ s16x4 tr_read(int vb) {
  s16x4 r; asm volatile("ds_read_b64_tr_b16 %0, %1 offset:%2" : "=&v"(r) : "v"(vb), "i"(OFF) : "memory"); return r;
}
template <int D0> __device__ __forceinline__ void pv_one(f32x16& od, int vb, bf16x8 pa0, bf16x8 pa1, bf16x8 pa2, bf16x8 pa3) {
  const s16x4 l0 = tr_read<v_rd_off(D0, 0, 0)>(vb), h0 = tr_read<v_rd_off(D0, 0, 1)>(vb), l1 = tr_read<v_rd_off(D0, 1, 0)>(vb), h1 = tr_read<v_rd_off(D0, 1, 1)>(vb);
  const s16x4 l2 = tr_read<v_rd_off(D0, 2, 0)>(vb), h2 = tr_read<v_rd_off(D0, 2, 1)>(vb), l3 = tr_read<v_rd_off(D0, 3, 0)>(vb), h3 = tr_read<v_rd_off(D0, 3, 1)>(vb);
  asm volatile("s_waitcnt lgkmcnt(0)" ::: "memory"); SBAR();
#define PK(L, H) (bf16x8){L[0], L[1], L[2], L[3], H[0], H[1], H[2], H[3]}
  od = __builtin_amdgcn_mfma_f32_32x32x16_bf16(pa0, PK(l0, h0), od, 0, 0, 0);
  od = __builtin_amdgcn_mfma_f32_32x32x16_bf16(pa1, PK(l1, h1), od, 0, 0, 0);
  od = __builtin_amdgcn_mfma_f32_32x32x16_bf16(pa2, PK(l2, h2), od, 0, 0, 0);
  od = __builtin_amdgcn_mfma_f32_32x32x16_bf16(pa3, PK(l3, h3), od, 0, 0, 0);
#undef PK
}
__device__ __forceinline__ void pv_d0(f32x16* o, int vb, bf16x8 pa0, bf16x8 pa1, bf16x8 pa2, bf16x8 pa3) {
  pv_one<0>(o[0], vb, pa0, pa1, pa2, pa3); pv_one<1>(o[1], vb, pa0, pa1, pa2, pa3); pv_one<2>(o[2], vb, pa0, pa1, pa2, pa3); pv_one<3>(o[3], vb, pa0, pa1, pa2, pa3);
}


__device__ __forceinline__ void attn_unit_pp(const bf16_t* __restrict__ Q, const bf16_t* __restrict__ Kb, const bf16_t* __restrict__ Vb, bf16_t* __restrict__ O,
                                             int qrow0, int kc0, int kl0, int NT, int h, float lam, const float* __restrict__ subg, char* lds, const int wave_in) {
  const int tid = opaque_tid(wave_in);
  const int wid = __builtin_amdgcn_readfirstlane(tid >> 6), lane = tid & 63, r32 = lane & 31, hi = lane >> 5;
  const int cq = wid >> 2, wq = wid & 3;
  char* V_lds = lds; char* K_lds = lds + 3 * SHM_V;
  float* ws = (float*)(lds + 6 * SHM_V) + wid * 64; float* li_l = ws; float* al_l = ws + 32;
  float m_reg = -1e30f, l_reg = 0; f32x16 o[4] = {}; bf16x8 qr[4];
  const bf16_t* Qw = Q + (size_t)(qrow0 + wq * QBLK + r32) * DM + h * 128 + cq * 64 + hi * 8;
#pragma unroll
  for (int d0 = 0; d0 < 4; ++d0) qr[d0] = *reinterpret_cast<const bf16x8*>(Qw + d0 * 16);
  const int vb0 = (int)(uintptr_t)V_lds + v_rd_base(lane);
  unsigned koff[2], voff[2];
#pragma unroll
  for (int i = 0; i < 2; ++i) { const int pc = 2 * wid + i;
    { const int row = 4 * pc + (lane >> 4), cpos = (lane & 15) << 4, colB = cpos ^ ((row & 7) << 4); koff[i] = (unsigned)(row * (DM * 2) + colB); }
    { const int kg = pc >> 1, cb0 = (pc & 1) * 2, sub = lane >> 5, kr = (lane & 31) >> 2, chunk = lane & 3; const int kk = kg * 8 + kr, k = (kk & ~0xC) | ((kk & 4) << 1) | ((kk & 8) >> 1), c = (cb0 + sub) * 32 + chunk * 8;
      voff[i] = (unsigned)(k * (DM * 2) + c * 2); } }
  const unsigned ldsK = (unsigned)__builtin_amdgcn_readfirstlane((int)((unsigned)(uintptr_t)K_lds + (unsigned)wid * 2048u));
  const unsigned ldsV = (unsigned)__builtin_amdgcn_readfirstlane((int)((unsigned)(uintptr_t)V_lds + (unsigned)wid * 2048u));
  const char* Kh = (const char*)(Kb + h * 128); const char* Vh = (const char*)(Vb + h * 128);
#define KROWB(j) ((size_t)((j) < 4 ? kc0 + 64 * (j) : kl0 + 64 * ((j) - 4)) * (DM * 2))
#define ISSUE_P(t, so, i) do { if ((i) < 2) { if ((t) < NT) pg8::glds16_s(Kh + KROWB(t), koff[(i) & 1], ldsK + (unsigned)(so) + (unsigned)((i) & 1) * 1024u); } \
    else { if ((t) >= 1 && (t) <= NT) pg8::glds16_s(Vh + KROWB((t) - 1), voff[(i) & 1], ldsV + (unsigned)(so) + (unsigned)((i) & 1) * 1024u); } } while (0)
#define ISSUE_L(t, so) do { const unsigned so_ = (unsigned)(so); \
    if ((t) < NT) { const char* kb_ = Kh + KROWB(t); pg8::glds16_s(kb_, koff[0], ldsK + so_); pg8::glds16_s(kb_, koff[1], ldsK + so_ + 1024u); } \
    if ((t) >= 1) { const char* vb_ = Vh + KROWB((t) - 1); pg8::glds16_s(vb_, voff[0], ldsV + so_); pg8::glds16_s(vb_, voff[1], ldsV + so_ + 1024u); } } while (0)
#define PBAR() asm volatile("s_waitcnt lgkmcnt(0)\n\ts_barrier" ::: "memory")
#define PBAR_V0() asm volatile("s_waitcnt vmcnt(0) lgkmcnt(0)\n\ts_barrier" ::: "memory")
#define PBAR_V4() asm volatile("s_waitcnt vmcnt(4) lgkmcnt(0)\n\ts_barrier" ::: "memory")
#define NEXT3(x) (((x) == 32768) ? 0 : (x) + 16384)
#define RESC(a) do { if (__any((a) < 1.f)) { if (hi == 0) al_l[r32] = (a); asm volatile("s_waitcnt lgkmcnt(0)" ::: "memory"); \
    _Pragma("unroll") for (int d = 0; d < 4; ++d) _Pragma("unroll") for (int r = 0; r < 16; ++r) o[d][r] *= al_l[crow(r, hi)]; } } while (0)
  f32x16 p0, p1; bf16x8 pa0, pa1, pa2, pa3;
  f32x16 negm = f32x16{}; asm volatile("" : "+v"(negm));
  m_reg = 0.f;
#define VRD4(L, H, D0, vb_) do { _Pragma("unroll") for (int ks_ = 0; ks_ < 4; ++ks_) { \
      asm volatile("ds_read_b64_tr_b16 %0, %1 offset:%2" : "=&v"(L[ks_]) : "v"(vb_), "i"((D0) * 512 + ks_ * 4096) : "memory"); \
      asm volatile("ds_read_b64_tr_b16 %0, %1 offset:%2" : "=&v"(H[ks_]) : "v"(vb_), "i"((D0) * 512 + ks_ * 4096 + 2048) : "memory"); } } while (0)
#define PVB(L, H, D0) do { \
      o[D0] = __builtin_amdgcn_mfma_f32_32x32x16_bf16(pa0, (bf16x8){L[0][0], L[0][1], L[0][2], L[0][3], H[0][0], H[0][1], H[0][2], H[0][3]}, o[D0], 0, 0, 0); \
      o[D0] = __builtin_amdgcn_mfma_f32_32x32x16_bf16(pa1, (bf16x8){L[1][0], L[1][1], L[1][2], L[1][3], H[1][0], H[1][1], H[1][2], H[1][3]}, o[D0], 0, 0, 0); \
      o[D0] = __builtin_amdgcn_mfma_f32_32x32x16_bf16(pa2, (bf16x8){L[2][0], L[2][1], L[2][2], L[2][3], H[2][0], H[2][1], H[2][2], H[2][3]}, o[D0], 0, 0, 0); \
      o[D0] = __builtin_amdgcn_mfma_f32_32x32x16_bf16(pa3, (bf16x8){L[3][0], L[3][1], L[3][2], L[3][3], H[3][0], H[3][1], H[3][2], H[3][3]}, o[D0], 0, 0, 0); } while (0)
#define LGK(n) do { asm volatile("s_waitcnt lgkmcnt(" #n ")" ::: "memory"); SBAR(); } while (0)
#define XFULL(so, ti, si) do { const int so_ = (so); const int vb_ = vb0 + so_; s16x4 la[4], ha[4], lb[4], hb[4]; bf16x8 kf0[4], kf1[4]; const char* Ks_ = K_lds + so_; \
      _Pragma("unroll") for (int d0 = 0; d0 < 4; ++d0) { const int cb = (cq * 64 + d0 * 16 + hi * 8) * 2; kf0[d0] = *reinterpret_cast<const bf16x8*>(Ks_ + KSWZ(r32, cb)); kf1[d0] = *reinterpret_cast<const bf16x8*>(Ks_ + KSWZ(32 + r32, cb)); } \
      asm volatile("" ::: "memory"); VRD4(la, ha, 0, vb_); \
      LGK(8);                                                             \
      p0 = __builtin_amdgcn_mfma_f32_32x32x16_bf16(kf0[0], qr[0], negm, 0, 0, 0); p1 = __builtin_amdgcn_mfma_f32_32x32x16_bf16(kf1[0], qr[0], negm, 0, 0, 0); \
      _Pragma("unroll") for (int d0 = 1; d0 < 4; ++d0) { p0 = __builtin_amdgcn_mfma_f32_32x32x16_bf16(kf0[d0], qr[d0], p0, 0, 0, 0); p1 = __builtin_amdgcn_mfma_f32_32x32x16_bf16(kf1[d0], qr[d0], p1, 0, 0, 0); } \
      SBAR(); VRD4(lb, hb, 1, vb_); LGK(8); PVB(la, ha, 0); \
      SBAR(); VRD4(la, ha, 2, vb_); LGK(8); PVB(lb, hb, 1); \
      SBAR(); VRD4(lb, hb, 3, vb_); LGK(8); PVB(la, ha, 2); \
      LGK(0); PVB(lb, hb, 3); } while (0)
#define XFIRST() do { bf16x8 kf0[4], kf1[4]; \
      _Pragma("unroll") for (int d0 = 0; d0 < 4; ++d0) { const int cb = (cq * 64 + d0 * 16 + hi * 8) * 2; kf0[d0] = *reinterpret_cast<const bf16x8*>(K_lds + KSWZ(r32, cb)); kf1[d0] = *reinterpret_cast<const bf16x8*>(K_lds + KSWZ(32 + r32, cb)); } \
      p0 = __builtin_amdgcn_mfma_f32_32x32x16_bf16(kf0[0], qr[0], negm, 0, 0, 0); p1 = __builtin_amdgcn_mfma_f32_32x32x16_bf16(kf1[0], qr[0], negm, 0, 0, 0); \
      _Pragma("unroll") for (int d0 = 1; d0 < 4; ++d0) { p0 = __builtin_amdgcn_mfma_f32_32x32x16_bf16(kf0[d0], qr[d0], p0, 0, 0, 0); p1 = __builtin_amdgcn_mfma_f32_32x32x16_bf16(kf1[d0], qr[d0], p1, 0, 0, 0); } } while (0)
#define XLAST(so) do { pv_d0(o, vb0 + (so), pa0, pa1, pa2, pa3); } while (0)
#define MX3(a, b, c) __builtin_fmaxf(__builtin_fmaxf((a), (b)), (c))
#define PK4(P, BASE, OUT) do { unsigned a0 = cvt_pk_bf16(P[BASE + 0], P[BASE + 1]), a1 = cvt_pk_bf16(P[BASE + 2], P[BASE + 3]);   \
    unsigned b0 = cvt_pk_bf16(P[BASE + 4], P[BASE + 5]), b1 = cvt_pk_bf16(P[BASE + 6], P[BASE + 7]);                              \
    auto r0 = __builtin_amdgcn_permlane32_swap(a0, b0, false, false); auto r1 = __builtin_amdgcn_permlane32_swap(a1, b1, false, false); \
    u32x4 w = {r0[0], r1[0], r0[1], r1[1]}; OUT = __builtin_bit_cast(bf16x8, w); } while (0)
#define YSOFT(FIRST) do { \
    float a_ = MX3(p0[0], p0[1], p1[0]), b_ = MX3(p0[2], p0[3], p1[1]); a_ = MX3(a_, p1[2], p1[3]); \
    _Pragma("unroll") for (int r = 4; r < 16; r += 4) { a_ = MX3(a_, p0[r], p0[r + 1]); b_ = MX3(b_, p0[r + 2], p0[r + 3]); a_ = MX3(a_, p1[r], p1[r + 1]); b_ = MX3(b_, p1[r + 2], p1[r + 3]); } \
    float rm_ = __builtin_fmaxf(a_, b_); { auto rr = __builtin_amdgcn_permlane32_swap(__float_as_uint(rm_), __float_as_uint(rm_), false, false); rm_ = __builtin_fmaxf(__uint_as_float(rr[0]), __uint_as_float(rr[1])); } \
    if ((FIRST) || __any(rm_ > 8.0f)) { const float dl_ = (FIRST) ? rm_ : __builtin_fmaxf(rm_, 0.f); m_reg += dl_; \
      _Pragma("unroll") for (int r = 0; r < 16; ++r) { p0[r] -= dl_; p1[r] -= dl_; } \
      _Pragma("unroll") for (int r = 0; r < 16; ++r) negm[r] = -m_reg; asm volatile("" : "+v"(negm)); \
      if (!(FIRST)) { const float f_ = __builtin_amdgcn_exp2f(-dl_); l_reg *= f_; RESC(f_); } } \
    _Pragma("unroll") for (int r = 0; r < 16; ++r) p0[r] = __builtin_amdgcn_exp2f(p0[r]); \
    _Pragma("unroll") for (int r = 0; r < 16; ++r) p1[r] = __builtin_amdgcn_exp2f(p1[r]); \
    float s0_ = p0[0] + p0[1], s1_ = p0[2] + p0[3], s2_ = p1[0] + p1[1], s3_ = p1[2] + p1[3]; \
    _Pragma("unroll") for (int r = 4; r < 16; r += 4) { s0_ += p0[r] + p0[r + 1]; s1_ += p0[r + 2] + p0[r + 3]; s2_ += p1[r] + p1[r + 1]; s3_ += p1[r + 2] + p1[r + 3]; } \
    float ps_ = (s0_ + s1_) + (s2_ + s3_); { auto rr = __builtin_amdgcn_permlane32_swap(__float_as_uint(ps_), __float_as_uint(ps_), false, false); ps_ = __uint_as_float(rr[0]) + __uint_as_float(rr[1]); } \
    l_reg += ps_; \
    PK4(p0, 0, pa0); PK4(p0, 8, pa1); PK4(p1, 0, pa2); PK4(p1, 8, pa3); } while (0)
#define YPH() YSOFT(false)
  ISSUE_L(0, 0); ISSUE_L(1, 16384); PBAR_V4();
  int sx = 16384, si = 32768;
  if (cq == 0) {
    XFIRST(); PBAR();
    ISSUE_L(2, si); si = NEXT3(si); YSOFT(true); PBAR_V4();
    for (int t = 1; t < NT; ++t) {
      XFULL(sx, 0, 0); sx = NEXT3(sx); PBAR();
      if (t + 2 <= NT) { ISSUE_L(t + 2, si); si = NEXT3(si); }
      YPH(); if (t + 2 < NT) PBAR_V4(); else PBAR_V0();
    }
    XLAST(sx); PBAR();
    PBAR();
  } else {
    __builtin_amdgcn_s_setprio(1);
    ISSUE_L(2, si); si = NEXT3(si); PBAR();
    XFIRST(); PBAR_V4();
    ISSUE_L(3, si); si = NEXT3(si); YSOFT(true); PBAR();
    XFULL(sx, 0, 0); sx = NEXT3(sx); if (3 < NT) PBAR_V4(); else PBAR_V0();
    for (int t = 2; t < NT; ++t) {
      if (t + 2 <= NT) { ISSUE_L(t + 2, si); si = NEXT3(si); }
      YPH(); PBAR();
      XFULL(sx, 0, 0); sx = NEXT3(sx); if (t + 2 < NT) PBAR_V4(); else PBAR_V0();
    }
    YPH(); PBAR();
    XLAST(sx); PBAR();
    __builtin_amdgcn_s_setprio(0);
  }
#undef XFULL
#undef XFIRST
#undef XLAST
#undef YPH
#undef YSOFT
#undef MX3
#undef PK4
#undef VRD4
#undef PVB
#undef LGK
#undef ISSUE_L
#undef KROWB
  if (hi == 0) li_l[r32] = l_reg; asm volatile("s_waitcnt lgkmcnt(0)" ::: "memory");
  float rli[16];
#pragma unroll
  for (int r = 0; r < 16; ++r) rli[r] = __builtin_amdgcn_rcpf(li_l[crow(r, hi)]);
  PBAR_V0();
  float* xb = (float*)lds + wq * (32 * 128);
  if (cq == 1) {
#pragma unroll
    for (int r = 0; r < 16; ++r)
#pragma unroll
      for (int d0 = 0; d0 < 4; ++d0) xb[crow(r, hi) * 128 + d0 * 32 + r32] = o[d0][r] * rli[r];
  }
  PBAR();
  if (cq == 0) {
    float ss[16];
#pragma unroll
    for (int r = 0; r < 16; ++r) { float s = 0.f;
#pragma unroll
      for (int d0 = 0; d0 < 4; ++d0) { const float v = o[d0][r] * rli[r] - lam * xb[crow(r, hi) * 128 + d0 * 32 + r32]; o[d0][r] = v; s += v * v; }
      ss[r] = s; }
#pragma unroll
    for (int r = 0; r < 16; ++r) { float s = half_sum32(ss[r]); ss[r] = __builtin_amdgcn_rsqf(s * (1.0f / 128.0f) + LN_EPS) * (1.0f - LAM_INIT); }
    float gsub[4];
#pragma unroll
    for (int d0 = 0; d0 < 4; ++d0) gsub[d0] = subg[d0 * 32 + r32];
    bf16_t* Ow = O + (size_t)(qrow0 + wq * QBLK) * DM + h * 128;
#pragma unroll
    for (int r = 0; r < 16; ++r) { const int orow = crow(r, hi);
#pragma unroll
      for (int d0 = 0; d0 < 4; ++d0) Ow[(size_t)orow * DM + d0 * 32 + r32] = (bf16_t)f2bf(o[d0][r] * ss[r] * gsub[d0]); }
  }
  PBAR_V0();
#undef PBAR
#undef PBAR_V0
#undef PBAR_V4
#undef NEXT3
#undef ISSUE_P
#undef RESC
}

__device__ __forceinline__ void attn_unit_f8(const bf16_t* __restrict__ Q, const bf16_t* __restrict__ Kb, const unsigned char* __restrict__ V8, bf16_t* __restrict__ O,
                                             int qrow0, int kc0, int kl0, int NT, int h, float lam, const float* __restrict__ subg, char* lds, const int wave_in) {
  const int tid = opaque_tid(wave_in);
  const int wid = __builtin_amdgcn_readfirstlane(tid >> 6), lane = tid & 63, r32 = lane & 31, hi = lane >> 5;
  const int cq = wid >> 2, wq = wid & 3;
  char* V_lds = lds; char* K_lds = lds + 24576;
  float* ws = (float*)(lds + 49152) + wid * 64; float* li_l = ws; float* al_l = ws + 32;
  float m_reg = 0.f; f32x16 o[5] = {};
  i32x8 qf;
  { const unsigned char* Qw = (const unsigned char*)Q + (size_t)(qrow0 + wq * QBLK + r32) * DM + h * 128 + cq * 64 + hi * 32;
    const u32x4 qa = *reinterpret_cast<const u32x4*>(Qw), qb = *reinterpret_cast<const u32x4*>(Qw + 16); qf = (i32x8){(int)qa.x, (int)qa.y, (int)qa.z, (int)qa.w, (int)qb.x, (int)qb.y, (int)qb.z, (int)qb.w}; }
  unsigned koff, voff;
  { const int row = 8 * wid + (lane >> 3), cpos = lane & 7;
    const int key = 16 * (row & 3) + 8 * ((row >> 2) & 1) + ((row >> 3) & 3) + 4 * (row >> 5);
    koff = (unsigned)(key * DM + 16 * (cpos ^ ((row >> 1) & 7))); }
  { const int e = 16 * wid + (lane >> 2), cpos = lane & 3; voff = (unsigned)(e * 64 + 16 * (cpos ^ ((e >> 2) & 3))); }
  const unsigned ldsK = (unsigned)__builtin_amdgcn_readfirstlane((int)((unsigned)(uintptr_t)K_lds + (unsigned)wid * 1024u));
  const unsigned ldsV = (unsigned)__builtin_amdgcn_readfirstlane((int)((unsigned)(uintptr_t)V_lds + (unsigned)wid * 1024u));
  const char* Kh = (const char*)Kb + h * 128;
  const int fsw = (r32 >> 2) & 3;
  const char* vfa = V_lds + r32 * 64 + 16 * ((2 * hi) ^ fsw); const char* vfb = V_lds + r32 * 64 + 16 * ((2 * hi + 1) ^ fsw);
#define KROWB(j) ((size_t)((j) < 4 ? kc0 + 64 * (j) : kl0 + 64 * ((j) - 4)) * DM)
#define ISSUE_L(t, sl) do { \
    if ((t) < NT) pg8::glds16_s(Kh + KROWB(t), koff, ldsK + (unsigned)(sl) * 8192u); \
    if ((t) >= 1 && (t) <= NT) pg8::glds16_s((const char*)V8 + (size_t)((t) - 1) * 8192, voff, ldsV + (unsigned)(sl) * 8192u); } while (0)
#define PBAR() asm volatile("s_waitcnt lgkmcnt(0)\n\ts_barrier" ::: "memory")
#define PBAR_V0() asm volatile("s_waitcnt vmcnt(0) lgkmcnt(0)\n\ts_barrier" ::: "memory")
#define PBAR_V3() asm volatile("s_waitcnt vmcnt(2) lgkmcnt(0)\n\ts_barrier" ::: "memory")
#define NEXT3(x) (((x) == 2) ? 0 : (x) + 1)
#define RESC(a) do { if (__any((a) < 1.f)) { if (hi == 0) al_l[r32] = (a); asm volatile("s_waitcnt lgkmcnt(0)" ::: "memory"); \
    _Pragma("unroll") for (int d = 0; d < 5; ++d) _Pragma("unroll") for (int r = 0; r < 16; ++r) o[d][r] *= al_l[crow(r, hi)]; } } while (0)
  f32x16 p0, p1; i32x8 p8 = i32x8{};
  i32x8 onesf = (i32x8){0x38383838, 0x38383838, 0x38383838, 0x38383838, 0x38383838, 0x38383838, 0x38383838, 0x38383838}; asm volatile("" : "+v"(onesf));
  f32x16 negm = f32x16{}; asm volatile("" : "+v"(negm));
  const int scl1 = 0x7F7F7F7F;
#define QKT(sl) do { const char* Ks_ = K_lds + (sl) * 8192; const int c0_ = 4 * cq + 2 * hi; \
      const u32x4 ka0 = *reinterpret_cast<const u32x4*>(Ks_ + r32 * 128 + 16 * (c0_ ^ ((r32 >> 1) & 7))), ka1 = *reinterpret_cast<const u32x4*>(Ks_ + r32 * 128 + 16 * ((c0_ + 1) ^ ((r32 >> 1) & 7))); \
      const u32x4 kb0 = *reinterpret_cast<const u32x4*>(Ks_ + (32 + r32) * 128 + 16 * (c0_ ^ ((r32 >> 1) & 7))), kb1 = *reinterpret_cast<const u32x4*>(Ks_ + (32 + r32) * 128 + 16 * ((c0_ + 1) ^ ((r32 >> 1) & 7))); \
      const i32x8 kfa_ = (i32x8){(int)ka0.x, (int)ka0.y, (int)ka0.z, (int)ka0.w, (int)ka1.x, (int)ka1.y, (int)ka1.z, (int)ka1.w}, kfb_ = (i32x8){(int)kb0.x, (int)kb0.y, (int)kb0.z, (int)kb0.w, (int)kb1.x, (int)kb1.y, (int)kb1.z, (int)kb1.w}; \
      p0 = __builtin_amdgcn_mfma_scale_f32_32x32x64_f8f6f4(kfa_, qf, negm, 0, 0, 0, scl1, 0, scl1); p1 = __builtin_amdgcn_mfma_scale_f32_32x32x64_f8f6f4(kfb_, qf, negm, 0, 0, 0, scl1, 0, scl1); } while (0)
#define PV8(sl) do { u32x4 va_[4], vb_[4]; \
      _Pragma("unroll") for (int d0 = 0; d0 < 4; ++d0) { va_[d0] = *reinterpret_cast<const u32x4*>(vfa + (sl) * 8192 + d0 * 2048); vb_[d0] = *reinterpret_cast<const u32x4*>(vfb + (sl) * 8192 + d0 * 2048); } \
      _Pragma("unroll") for (int d0 = 0; d0 < 4; ++d0) { const i32x8 vf_ = (i32x8){(int)va_[d0].x, (int)va_[d0].y, (int)va_[d0].z, (int)va_[d0].w, (int)vb_[d0].x, (int)vb_[d0].y, (int)vb_[d0].z, (int)vb_[d0].w}; \
        o[d0] = __builtin_amdgcn_mfma_scale_f32_32x32x64_f8f6f4(p8, vf_, o[d0], 0, 0, 0, scl1, 0, scl1); } \
      o[4] = __builtin_amdgcn_mfma_scale_f32_32x32x64_f8f6f4(p8, onesf, o[4], 0, 0, 0, scl1, 0, scl1); } while (0)
#define MX3(a, b, c) __builtin_fmaxf(__builtin_fmaxf((a), (b)), (c))
#define YSOFT(FIRST) do { \
    float a_ = MX3(p0[0], p0[1], p1[0]), b_ = MX3(p0[2], p0[3], p1[1]); a_ = MX3(a_, p1[2], p1[3]); \
    _Pragma("unroll") for (int r = 4; r < 16; r += 4) { a_ = MX3(a_, p0[r], p0[r + 1]); b_ = MX3(b_, p0[r + 2], p0[r + 3]); a_ = MX3(a_, p1[r], p1[r + 1]); b_ = MX3(b_, p1[r + 2], p1[r + 3]); } \
    float rm_ = __builtin_fmaxf(a_, b_); { auto rr = __builtin_amdgcn_permlane32_swap(__float_as_uint(rm_), __float_as_uint(rm_), false, false); rm_ = __builtin_fmaxf(__uint_as_float(rr[0]), __uint_as_float(rr[1])); } \
    if ((FIRST) || __any(rm_ > 8.0f)) { const float dl_ = (FIRST) ? (rm_ - 6.0f) : __builtin_fmaxf(rm_ - 6.0f, 0.f); m_reg += dl_; \
      _Pragma("unroll") for (int r = 0; r < 16; ++r) { p0[r] -= dl_; p1[r] -= dl_; } \
      _Pragma("unroll") for (int r = 0; r < 16; ++r) negm[r] = -m_reg; asm volatile("" : "+v"(negm)); \
      if (!(FIRST)) { const float f_ = __builtin_amdgcn_exp2f(-dl_); RESC(f_); } } \
    _Pragma("unroll") for (int r = 0; r < 16; ++r) p0[r] = __builtin_amdgcn_exp2f(p0[r]); \
    _Pragma("unroll") for (int r = 0; r < 16; ++r) p1[r] = __builtin_amdgcn_exp2f(p1[r]); \
    _Pragma("unroll") for (int d = 0; d < 4; ++d) { p8[d] = __builtin_amdgcn_cvt_pk_fp8_f32(p0[4 * d], p0[4 * d + 1], p8[d], false); p8[d] = __builtin_amdgcn_cvt_pk_fp8_f32(p0[4 * d + 2], p0[4 * d + 3], p8[d], true); \
      p8[4 + d] = __builtin_amdgcn_cvt_pk_fp8_f32(p1[4 * d], p1[4 * d + 1], p8[4 + d], false); p8[4 + d] = __builtin_amdgcn_cvt_pk_fp8_f32(p1[4 * d + 2], p1[4 * d + 3], p8[4 + d], true); } } while (0)
#define YPH() YSOFT(false)
  ISSUE_L(0, 0); ISSUE_L(1, 1); PBAR_V3();
  int sx = 1, si = 2;
  if (cq == 0) {
    QKT(0); ISSUE_L(2, si); si = NEXT3(si); PBAR();
    YSOFT(true); PBAR_V3();
    for (int t = 1; t < NT; ++t) {
      __builtin_amdgcn_s_setprio(1); QKT(sx); PV8(sx); sx = NEXT3(sx);
      if (t + 2 <= NT) { ISSUE_L(t + 2, si); si = NEXT3(si); }
      __builtin_amdgcn_s_setprio(0);
      PBAR();
      YPH(); if (t + 2 < NT) PBAR_V3(); else PBAR_V0();
    }
    PV8(sx); PBAR();
    PBAR();
  } else {
    ISSUE_L(2, si); si = NEXT3(si); PBAR();
    QKT(0); PBAR_V3();
    YSOFT(true); PBAR();
    __builtin_amdgcn_s_setprio(1); QKT(sx); PV8(sx); sx = NEXT3(sx); __builtin_amdgcn_s_setprio(0);
    ISSUE_L(3, si); si = NEXT3(si); if (3 < NT) PBAR_V3(); else PBAR_V0();
    for (int t = 2; t < NT; ++t) {
      YPH(); PBAR();
      __builtin_amdgcn_s_setprio(1); QKT(sx); PV8(sx); sx = NEXT3(sx);
      if (t + 2 <= NT) { ISSUE_L(t + 2, si); si = NEXT3(si); }
      __builtin_amdgcn_s_setprio(0);
      if (t + 2 < NT) PBAR_V3(); else PBAR_V0();
    }
    YPH(); PBAR();
    PV8(sx); PBAR();
  }
#undef QKT
#undef PV8
#undef YPH
#undef YSOFT
#undef MX3
#undef ISSUE_L
#undef KROWB
  float rli[16];
#pragma unroll
  for (int r = 0; r < 16; ++r) rli[r] = __builtin_amdgcn_rcpf(o[4][r]);
  PBAR_V0();
  float* xb = (float*)lds + wq * (32 * 128);
  if (cq == 1) {
#pragma unroll
    for (int r = 0; r < 16; ++r)
#pragma unroll
      for (int d0 = 0; d0 < 4; ++d0) xb[crow(r, hi) * 128 + d0 * 32 + r32] = o[d0][r] * rli[r];
  }
  PBAR();
  if (cq == 0) {
    float ss[16];
#pragma unroll
    for (int r = 0; r < 16; ++r) { float s = 0.f;
#pragma unroll
      for (int d0 = 0; d0 < 4; ++d0) { const float v = o[d0][r] * rli[r] - lam * xb[crow(r, hi) * 128 + d0 * 32 + r32]; o[d0][r] = v; s += v * v; }
      ss[r] = s; }
#pragma unroll
    for (int r = 0; r < 16; ++r) { float s = half_sum32(ss[r]); ss[r] = __builtin_amdgcn_rsqf(s * (1.0f / 128.0f) + LN_EPS) * (1.0f - LAM_INIT); }
    float gsub[4];
#pragma unroll
    for (int d0 = 0; d0 < 4; ++d0) gsub[d0] = subg[d0 * 32 + r32];
    unsigned char* Ow = (unsigned char*)O + (size_t)(qrow0 + wq * QBLK) * DM + h * 128;
#pragma unroll
    for (int r = 0; r < 16; ++r) { const int orow = crow(r, hi);
#pragma unroll
      for (int d0 = 0; d0 < 4; ++d0) Ow[(size_t)orow * DM + d0 * 32 + r32] = (unsigned char)(cvt_fp8x4(o[d0][r] * ss[r] * gsub[d0], 0.f, 0.f, 0.f) & 0xffu); }
  }
  PBAR_V0();
#undef PBAR
#undef PBAR_V0
#undef PBAR_V3
#undef NEXT3
#undef RESC
}
#undef KSWZ
#undef SBAR
}

struct Args { const float* in[27]; float* out; unsigned char* ws; };
enum { IN_X = 0, IN_C, IN_CTX, IN_CCTX, IN_WMOD, IN_BMOD, IN_LNG, IN_LNB, IN_GWIN, IN_GLNG, IN_GLNB, IN_GWS, IN_GBS, IN_GWOUT, IN_DWQKV, IN_DLAM, IN_DSUBG, IN_DWO,
       IN_CWIN, IN_CW, IN_CWOUT, IN_MWR, IN_MBR, IN_MWGU, IN_MBGU, IN_MWDN, IN_MBDN };


__device__ __forceinline__ const float* inp_ptr(int k) {
    const __attribute__((address_space(4))) char* kp = (const __attribute__((address_space(4))) char*)__builtin_amdgcn_kernarg_segment_ptr();
    asm volatile("" : "+s"(kp));
    return (const float*)*(GAS const float* const __attribute__((address_space(4)))*)(kp + 8 * k);
}
#define INP(k) inp_ptr(k)

struct Frame {
    LAS unsigned char* lds; char* ldsg;
    int tid, lane, wave, G, gw, NGW, bid, wave0;
    float* out; unsigned char* ws; gu32* ctl;
};

__device__ __forceinline__ int drow_map(int kind, int n) {
    if (kind == 1) { if (n < 1024) return 256 * (n >> 7) + (n & 127); const int ff = n - 1024; return 256 * (ff >> 7) + 128 + (ff & 127); }
    if (kind == 2) { if (n < 1024) return 2048 + n; if (n < 2048) { const int ch = n - 1024; return 256 * (ch >> 7) + (ch & 127); } const int ch = n - 2048; return 256 * (ch >> 7) + 128 + (ch & 127); }
    return n;
}
template <bool FP8> __device__ __forceinline__ void p0_transpose_item(const float* W, int K, int N, bf16_t* WT, int kind, LAS float* scr, int item, int lane) {
    const int nblk = N / 32, kb = item / nblk, nb = item % nblk, k0 = 64 * kb, n0 = 32 * nb;
#pragma unroll 8
    for (int i = 0; i < 32; ++i) { const int kk = 2 * i + (lane >> 5); scr[kk * 33 + (lane & 31)] = W[(size_t)(k0 + kk) * N + n0 + (lane & 31)]; }
    LDS_WAIT(); asm volatile("" ::: "memory");
    const int c = lane & 7; const int d0 = drow_map(kind, n0);
#pragma unroll
    for (int j = 0; j < 4; ++j) { const int n = (lane >> 3) + 8 * j; const LAS float* s = scr + (8 * c) * 33 + n;
        if (FP8) { u32x2 o; o.x = cvt_fp8x4(s[0 * 33] * W8_SCALE, s[1 * 33] * W8_SCALE, s[2 * 33] * W8_SCALE, s[3 * 33] * W8_SCALE); o.y = cvt_fp8x4(s[4 * 33] * W8_SCALE, s[5 * 33] * W8_SCALE, s[6 * 33] * W8_SCALE, s[7 * 33] * W8_SCALE);
            *(GAS u32x2*)((unsigned char*)WT + (size_t)(d0 + n) * K + k0 + 8 * c) = o; }
        else { u32x4 o; o.x = pk2(s[0 * 33], s[1 * 33]); o.y = pk2(s[2 * 33], s[3 * 33]); o.z = pk2(s[4 * 33], s[5 * 33]); o.w = pk2(s[6 * 33], s[7 * 33]);
            *(GAS u32x4*)(WT + (size_t)(d0 + n) * K + k0 + 8 * c) = o; } }
    LDS_WAIT(); asm volatile("" ::: "memory");
}
template <bool FP8> __device__ __forceinline__ void p0_job(Frame& F, LAS float* scr, long& base, const float* src, int K, int N, int M, bf16_t* dst, int ND, int kind) {
    const int per = (K / 64) * (N / 32); const long tot = (long)per * M;
    long first = (long)F.gw - (base % F.NGW); if (first < 0) first += F.NGW;
    for (long it = first; it < tot; it += F.NGW) { const int mtx = (int)(it / per), loc = (int)(it % per);
        p0_transpose_item<FP8>(src + (size_t)mtx * K * N, K, N, (bf16_t*)((unsigned char*)dst + (size_t)mtx * ND * K * (FP8 ? 1 : 2)), kind, scr, loc, F.lane); }
    base += tot;
}
__device__ __forceinline__ void p0_weights(Frame& F) {
    LAS float* scr = (LAS float*)(F.lds + F.wave * 16384);
    long base = 0;
    p0_job<true>(F, scr, base, INP(IN_GWIN), 1024, 4096, 2, (bf16_t*)(F.ws + WS_WIN), 4096, 0);
    p0_job<false>(F, scr, base, INP(IN_GWOUT), 2048, 1024, 2, (bf16_t*)(F.ws + WS_WOUT), 1024, 0);
    p0_job<true>(F, scr, base, INP(IN_DWQKV), 1024, 3072, 1, (bf16_t*)(F.ws + WS_WQKV), 3072, 0);
    p0_job<true>(F, scr, base, INP(IN_DWO), 1024, 1024, 1, (bf16_t*)(F.ws + WS_WO), 1024, 0);
    p0_job<false>(F, scr, base, INP(IN_CWIN), 1024, 3072, 1, (bf16_t*)(F.ws + WS_CWIN), 3072, 2);
    p0_job<false>(F, scr, base, INP(IN_CWOUT), 1024, 1024, 1, (bf16_t*)(F.ws + WS_CWOUT), 1024, 0);
    p0_job<false>(F, scr, base, INP(IN_MWR), 1024, 32, 4, (bf16_t*)(F.ws + WS_WR), 256, 0);
    p0_job<true>(F, scr, base, INP(IN_MWGU), 1024, 2048, 128, (bf16_t*)(F.ws + WS_WGU), 2048, 1);
    p0_job<true>(F, scr, base, INP(IN_MWDN), 1024, 1024, 128, (bf16_t*)(F.ws + WS_WDN), 1024, 0);
    { const float* src = INP(IN_GWS); bf16_t* dst = (bf16_t*)(F.ws + WS_WS); const int n4 = 2 * 8 * 128 * 128 / 4;
      for (int i = F.gw * 64 + F.lane; i < n4; i += F.NGW * 64) { const f32x4 v = *(const f32x4*)(src + 4 * (size_t)i); u32x2 w; w.x = pk2(v[0], v[1]); w.y = pk2(v[2], v[3]); *(u32x2*)(dst + 4 * (size_t)i) = w; } }
}
__device__ __forceinline__ void p0_mod(Frame& F) {
    LAS float* cond = (LAS float*)(F.lds);
    LAS float* red = (LAS float*)(F.lds + 40960);
    const int nitem = 4 * 96;
    if (F.bid >= nitem) return;
    for (int i = F.tid; i < 9 * 1024; i += 512) { const int m = i >> 10, k = i & 1023; const float c = (m < 8) ? INP(IN_C)[m * 1024 + k] : INP(IN_CCTX)[k]; cond[i] = c / (1.0f + __expf(-c)); }
    __syncthreads();
    float* MOD = (float*)(F.ws + WS_MOD);
    for (int it = F.bid; it < nitem; it += F.G) {
        const int layer = it / 96, n0 = (it % 96) * 64;
        const float* W = INP(IN_WMOD) + (size_t)layer * 1024 * 6144 + n0 + F.lane;
        float acc[9];
#pragma unroll
        for (int m = 0; m < 9; ++m) acc[m] = 0.f;
        const int kb = F.wave * 128;
#pragma unroll 8
        for (int k = 0; k < 128; ++k) { const float w = W[(size_t)(kb + k) * 6144];
#pragma unroll
            for (int m = 0; m < 9; ++m) acc[m] += cond[m * 1024 + kb + k] * w; }
#pragma unroll
        for (int m = 0; m < 9; ++m) red[(F.wave * 9 + m) * 64 + F.lane] = acc[m];
        __syncthreads();
        for (int i = F.tid; i < 9 * 64; i += 512) { const int m = i >> 6, l = i & 63; float s = 0.f;
#pragma unroll
            for (int w = 0; w < 8; ++w) s += red[(w * 9 + m) * 64 + l];
            MOD[((size_t)layer * 9 + m) * 6144 + n0 + l] = s + INP(IN_BMOD)[layer * 6144 + n0 + l]; }
        __syncthreads();
    }
}
__device__ __forceinline__ void p0_misc(Frame& F) {
    const int gt = F.bid * 512 + F.tid;
    if (gt < 2048) { const int pos = gt >> 4, i = gt & 15; const float inv = powf(10000.0f, -(float)i / 16.0f); const float ang = (float)pos * inv; float s, c; sincosf(ang, &s, &c);
        ((float*)(F.ws + WS_ROPE))[gt] = c; ((float*)(F.ws + WS_ROPE))[2048 + gt] = s; }
    if (F.bid == F.G - 1) { bf16_t* H = (bf16_t*)(F.ws + WS_H); for (int i = F.tid; i < 1024; i += 512) H[(size_t)TALL * DM + i] = 0;
        unsigned* H8z = (unsigned*)(F.ws + WS_H8 + (size_t)TALL * DM); for (int i = F.tid; i < 256; i += 512) H8z[i] = 0u; }
}

__device__ __forceinline__ int mod_index(int row) { return row < NCTX ? 8 : ((row - NCTX) >> 13); }

template <int MODE, bool FIRSTX>
__device__ __forceinline__ void row_pass(Frame& F, int layer, bool final_out, int row0) {
    const float* MOD = (const float*)(F.ws + WS_MOD);
    bf16_t* X = (bf16_t*)(F.ws + WS_X); bf16_t* H = (bf16_t*)(F.ws + WS_H);
    const bf16_t* Y = (const bf16_t*)(F.ws + WS_Y); const bf16_t* YK = (const bf16_t*)(F.ws + WS_R1 + R1_YK); const int* TS = (const int*)(F.ws + WS_SLOTDST);
    const int rpw = (TALL - row0 + F.NGW - 1) / F.NGW;
    const int r0 = row0 + F.gw * rpw, r1 = (r0 + rpw < TALL) ? r0 + rpw : TALL;
    const int sub = (MODE == 2) ? 1 : 0;
    const int gate_i = (MODE == 2) ? 5 : 2;
    const int nlayer = (MODE == 2) ? layer + 1 : layer;
    const int sh_i = (MODE == 1) ? 3 : 0, sc_i = (MODE == 1) ? 4 : 1;
    const int lc = 8 * F.lane;
#define RP_COL(q) (lc + 512 * ((q) >> 1) + 4 * ((q) & 1))
    f32x4 lg[4], lb[4], gt[4], sh[4], sc[4];
    if (MODE != 0) {
#pragma unroll
        for (int q = 0; q < 4; ++q) { lg[q] = *(const f32x4*)(INP(IN_LNG) + (layer * 2 + sub) * 1024 + RP_COL(q)); lb[q] = *(const f32x4*)(INP(IN_LNB) + (layer * 2 + sub) * 1024 + RP_COL(q)); } }
    constexpr int NY = (MODE == 2) ? 4 : (MODE == 1 ? 1 : 0);
    f32x4 xf[4], xfn[4]; u32x4 xb[2], xbn[2]; u32x4 yb[NY ? NY : 1][2], ybn[NY ? NY : 1][2];
#define RP_LOAD(row_, XF, XB, YB) do { const int rw_ = (row_); \
        if (FIRSTX) { const float* xr_ = (rw_ < NCTX ? INP(IN_CTX) + (size_t)rw_ * DM : INP(IN_X) + (size_t)(rw_ - NCTX) * DM); _Pragma("unroll") for (int q = 0; q < 4; ++q) XF[q] = *(const f32x4*)(xr_ + RP_COL(q)); } \
        else { _Pragma("unroll") for (int j = 0; j < 2; ++j) XB[j] = *(const u32x4*)(X + (size_t)rw_ * DM + lc + 512 * j); } \
        if (MODE == 1) { _Pragma("unroll") for (int j = 0; j < 2; ++j) YB[0][j] = *(const u32x4*)(Y + (size_t)rw_ * DM + lc + 512 * j); } \
        if (MODE == 2) { const int4 sl_ = *(const int4*)(TS + (size_t)rw_ * 4); const int sk_[4] = {sl_.x, sl_.y, sl_.z, sl_.w}; \
            _Pragma("unroll") for (int k = 0; k < 4; ++k) _Pragma("unroll") for (int j = 0; j < 2; ++j) { const u32x2 t8_ = *(const u32x2*)((const unsigned char*)YK + (size_t)sk_[k] * DM + lc + 512 * j); YB[k][j] = (u32x4){t8_.x, t8_.y, 0u, 0u}; } } } while (0)
#define RP_UNPK(V_, H_) ((H_) ? (f32x4){bflo((V_)[2]), bfhi((V_)[2]), bflo((V_)[3]), bfhi((V_)[3])} : (f32x4){bflo((V_)[0]), bfhi((V_)[0]), bflo((V_)[1]), bfhi((V_)[1])})
    if (r0 < r1) RP_LOAD(r0, xf, xb, yb);
    int curm = -1;
    for (int row = r0; row < r1; ++row) {
        if (row + 1 < r1) RP_LOAD(row + 1, xfn, xbn, ybn);
        const int mi = mod_index(row);
        if (mi != curm) { curm = mi;
#pragma unroll
            for (int q = 0; q < 4; ++q) { const int c = RP_COL(q);
                if (MODE != 0) gt[q] = *(const f32x4*)(MOD + ((size_t)layer * 9 + mi) * 6144 + gate_i * 1024 + c);
                if (!final_out) { sh[q] = *(const f32x4*)(MOD + ((size_t)nlayer * 9 + mi) * 6144 + sh_i * 1024 + c); sc[q] = *(const f32x4*)(MOD + ((size_t)nlayer * 9 + mi) * 6144 + sc_i * 1024 + c); } } }
        f32x4 v[4];
#pragma unroll
        for (int q = 0; q < 4; ++q) v[q] = FIRSTX ? xf[q] : RP_UNPK(xb[q >> 1], q & 1);
        if (MODE != 0) {
#pragma unroll
            for (int q = 0; q < 4; ++q) { f32x4 y = (f32x4){0.f, 0.f, 0.f, 0.f};
#pragma unroll
                for (int k = 0; k < NY; ++k) { if (MODE == 2) { const unsigned w8 = yb[k][q >> 1][q & 1]; const f32x2 lo = __builtin_amdgcn_cvt_pk_f32_fp8((int)w8, false), hi = __builtin_amdgcn_cvt_pk_f32_fp8((int)w8, true); y += (f32x4){lo.x, lo.y, hi.x, hi.y}; }
                                                else y += RP_UNPK(yb[k][q >> 1], q & 1); }
                if (MODE == 2) y = y * (1.0f / YK8_SCALE);
                v[q] = v[q] * DN_ALPHA + gt[q] * y; }
            float s = 0.f;
#pragma unroll
            for (int q = 0; q < 4; ++q) s += (v[q][0] + v[q][1]) + (v[q][2] + v[q][3]);
            const float mean = wave_sum(s) * (1.0f / DM); float qq = 0.f;
#pragma unroll
            for (int q = 0; q < 4; ++q) { v[q] = v[q] - mean; qq += (v[q][0] * v[q][0] + v[q][1] * v[q][1]) + (v[q][2] * v[q][2] + v[q][3] * v[q][3]); }
            const float rstd = 1.0f / sqrtf(wave_sum(qq) * (1.0f / DM) + LN_EPS);
#pragma unroll
            for (int q = 0; q < 4; ++q) v[q] = v[q] * rstd * lg[q] + lb[q];
            if (final_out) { if (row >= NCTX) {
#pragma unroll
                for (int q = 0; q < 4; ++q) *(f32x4*)(F.out + (size_t)(row - NCTX) * DM + RP_COL(q)) = v[q]; } }
            else {
#pragma unroll
                for (int j = 0; j < 2; ++j) { u32x4 w; w.x = pk2(v[2 * j][0], v[2 * j][1]); w.y = pk2(v[2 * j][2], v[2 * j][3]); w.z = pk2(v[2 * j + 1][0], v[2 * j + 1][1]); w.w = pk2(v[2 * j + 1][2], v[2 * j + 1][3]);
                    *(u32x4*)(X + (size_t)row * DM + lc + 512 * j) = w; } }
        }
        if (!final_out) {
#pragma unroll
            for (int j = 0; j < 2; ++j) { const f32x4 h0 = v[2 * j] * (sc[2 * j] + 1.0f) + sh[2 * j], h1 = v[2 * j + 1] * (sc[2 * j + 1] + 1.0f) + sh[2 * j + 1];
                if (MODE == 1 || (nlayer % 3) == 2) { u32x4 w; w.x = pk2(h0[0], h0[1]); w.y = pk2(h0[2], h0[3]); w.z = pk2(h1[0], h1[1]); w.w = pk2(h1[2], h1[3]);
                    *(u32x4*)(H + (size_t)row * DM + lc + 512 * j) = w; }
                if (MODE == 1 || (nlayer % 3) != 2) {                                u32x2 w8; w8.x = cvt_fp8x4(h0[0], h0[1], h0[2], h0[3]); w8.y = cvt_fp8x4(h1[0], h1[1], h1[2], h1[3]); *(u32x2*)(F.ws + WS_H8 + (size_t)row * DM + lc + 512 * j) = w8; } }
        }
#pragma unroll
        for (int q = 0; q < 4; ++q) xf[q] = xfn[q];
#pragma unroll
        for (int j = 0; j < 2; ++j) { xb[j] = xbn[j];
#pragma unroll
            for (int k = 0; k < (NY ? NY : 1); ++k) yb[k][j] = ybn[k][j]; }
    }
#undef RP_LOAD
#undef RP_UNPK
#undef RP_COL
}


__device__ __forceinline__ void gmlp_spatial_fused(Frame& F, int j, int row0) {
    const bf16_t* Z = (const bf16_t*)(F.ws + WS_R1 + R1_Z); const float* PART = (const float*)(F.ws + WS_PART); bf16_t* T = (bf16_t*)(F.ws + WS_R1 + R1_T);
    LAS f32x2* stl = (LAS f32x2*)(F.lds + MISC_OFF + 1024);
    LAS float* bsl = (LAS float*)(F.lds + MISC_OFF + 2048);
    const bf16_t* WSb = (const bf16_t*)(F.ws + WS_WS) + (size_t)j * 8 * 128 * 128; const float* bs = INP(IN_GBS) + j * 8 * 128;
    const float* lng = INP(IN_GLNG) + j * 2048; const float* lnb = INP(IN_GLNB) + j * 2048;
    const int wave = F.wave;
    char* lds = F.ldsg; bf16_t* outl = (bf16_t*)lds; char* wl = lds + 65536;
    const int nunit = ((TALL - row0) / 128) * 8, ch0 = row0 / 128;
#define WSWZ(row, colB) ((row) * 256 + ((colB) ^ (((row) & 7) << 4)))
    const unsigned wlds = (unsigned)__builtin_amdgcn_readfirstlane((int)((unsigned)(uintptr_t)wl + (unsigned)wave * 4096u));
    const int ehalf = wave >> 2, d0 = wave & 3;
    u32x4 zin[8]; f32x4 pin[4];
    int u = F.bid;
#define SP_LANE() const int tid = opaque_tid(wave), lane = tid & 63, r32 = lane & 31, hi = lane >> 5, c8 = tid & 31, q0 = tid >> 5
#define SP_LOAD(uu) do { const int ch_ = ch0 + ((uu) >> 3), g_ = (uu) & 7; _Pragma("unroll") for (int i = 0; i < 8; ++i) zin[i] = *(const u32x4*)(Z + (size_t)(ch_ * 128 + q0 + 16 * i) * 4096 + 2048 + 256 * g_ + 8 * c8); \
        _Pragma("unroll") for (int i = 0; i < 4; ++i) pin[i] = *(const f32x4*)(PART + ((size_t)(ch_ * 128 + (tid >> 2)) * 32 + 8 * (tid & 3)) * 2 + 4 * i); } while (0)
    if (u < nunit) { SP_LANE(); SP_LOAD(u); }
    for (; u < nunit; u += F.G) {
        const int chunk = ch0 + (u >> 3), g = u & 7;
        SP_LANE();
        const int vb = (int)(uintptr_t)lds + ehalf * 16384 + d0 * 512 + att::v_rd_base(lane);
        unsigned woff[4];
#pragma unroll
        for (int i = 0; i < 4; ++i) { const int row = 4 * (4 * wave + i) + (lane >> 4), cpos = (lane & 15) << 4; woff[i] = (unsigned)(row * 256 + (cpos ^ ((row & 7) << 4))); }
        int sto[8];
#pragma unroll
        for (int i = 0; i < 8; ++i) { const int q = q0 + 16 * i, e = 8 * c8; sto[i] = ((q >> 6) * 2 + (e >> 7)) * 16384 + att::v_st(q & 63, e & 127); }
        if (tid < 128) bsl[tid] = bs[g * 128 + tid];
        { const char* wg = (const char*)(WSb + (size_t)g * 128 * 128);
#pragma unroll
          for (int i = 0; i < 4; ++i) pg8::glds16_s(wg, woff[i], wlds + (unsigned)i * 1024u); }
        { float sm = (pin[0][0] + pin[0][2]) + (pin[1][0] + pin[1][2]) + (pin[2][0] + pin[2][2]) + (pin[3][0] + pin[3][2]), sq = (pin[0][1] + pin[0][3]) + (pin[1][1] + pin[1][3]) + (pin[2][1] + pin[2][3]) + (pin[3][1] + pin[3][3]);
          sm += swz_xor_f<1>(sm); sq += swz_xor_f<1>(sq); sm += swz_xor_f<2>(sm); sq += swz_xor_f<2>(sq);
          const float mean = sm * (1.0f / 2048.0f), var = __builtin_fmaxf(sq * (1.0f / 2048.0f) - mean * mean, 0.f);
          if ((tid & 3) == 0) stl[tid >> 2] = (f32x2){mean, 1.0f / sqrtf(var + LN_EPS)}; }
        asm volatile("s_waitcnt lgkmcnt(0)" ::: "memory");
        __syncthreads();
        { const f32x4 ga = *(const f32x4*)(lng + 256 * g + 8 * c8), gb = *(const f32x4*)(lng + 256 * g + 8 * c8 + 4), ba = *(const f32x4*)(lnb + 256 * g + 8 * c8), bb = *(const f32x4*)(lnb + 256 * g + 8 * c8 + 4);
#pragma unroll
          for (int i = 0; i < 8; ++i) { const f32x2 st = stl[q0 + 16 * i]; const u32x4 w = zin[i];
              f32x4 x0 = (f32x4){bflo(w.x), bfhi(w.x), bflo(w.y), bfhi(w.y)}, x1 = (f32x4){bflo(w.z), bfhi(w.z), bflo(w.w), bfhi(w.w)};
              x0 = (x0 - st.x) * st.y * ga + ba; x1 = (x1 - st.x) * st.y * gb + bb;
              *(u32x4*)(lds + sto[i]) = pg8::pack8(x0, x1); } }
        asm volatile("s_waitcnt vmcnt(0) lgkmcnt(0)" ::: "memory");
        __syncthreads();
        const int un = u + F.G;
        u32x4 uin[8];
#pragma unroll
        for (int i = 0; i < 8; ++i) uin[i] = *(const u32x4*)(Z + ((size_t)chunk * 128 + q0 + 16 * i) * 4096 + 256 * g + 8 * c8);
        if (un < nunit) SP_LOAD(un);
        f32x16 acc[4];
#pragma unroll
        for (int mt = 0; mt < 4; ++mt) acc[mt] = f32x16{};
#define SP_KS(QH, KS) do { s16x4 l_, h_; \
            asm volatile("ds_read_b64_tr_b16 %0, %1 offset:%2" : "=&v"(l_) : "v"(vb), "i"((QH) * 32768 + (KS) * 4096) : "memory"); \
            asm volatile("ds_read_b64_tr_b16 %0, %1 offset:%2" : "=&v"(h_) : "v"(vb), "i"((QH) * 32768 + (KS) * 4096 + 2048) : "memory"); \
            bf16x8 af_[4]; _Pragma("unroll") for (int mt = 0; mt < 4; ++mt) af_[mt] = *(const bf16x8*)(wl + WSWZ(32 * mt + r32, (16 * ((QH) * 4 + (KS)) + 8 * hi) * 2)); \
            asm volatile("s_waitcnt lgkmcnt(0)" ::: "memory"); __builtin_amdgcn_sched_barrier(0); \
            const bf16x8 bf_ = (bf16x8){l_[0], l_[1], l_[2], l_[3], h_[0], h_[1], h_[2], h_[3]}; \
            _Pragma("unroll") for (int mt = 0; mt < 4; ++mt) acc[mt] = __builtin_amdgcn_mfma_f32_32x32x16_bf16(af_[mt], bf_, acc[mt], 0, 0, 0); } while (0)
        SP_KS(0, 0); SP_KS(0, 1); SP_KS(0, 2); SP_KS(0, 3); SP_KS(1, 0); SP_KS(1, 1); SP_KS(1, 2); SP_KS(1, 3);
#undef SP_KS
        asm volatile("s_waitcnt lgkmcnt(0)" ::: "memory");
        __syncthreads();
        { const int e = 32 * wave + r32;
#pragma unroll
          for (int mt = 0; mt < 4; ++mt)
#pragma unroll
            for (int r = 0; r < 16; ++r) { const int p = 32 * mt + att::crow(r, hi); outl[p * 256 + e] = (bf16_t)f2bf(acc[mt][r] + bsl[p]); } }
        asm volatile("s_waitcnt lgkmcnt(0)" ::: "memory");
        __syncthreads();
#pragma unroll
        for (int i = 0; i < 8; ++i) { const int p = q0 + 16 * i; const size_t row = (size_t)chunk * 128 + p;
            const u32x4 o = *(const u32x4*)(outl + p * 256 + 8 * c8); const u32x4 uu = uin[i];
            u32x4 t;
#pragma unroll
            for (int e = 0; e < 4; ++e) t[e] = pk2(bflo(o[e]) * bflo(uu[e]), bfhi(o[e]) * bfhi(uu[e]));
            *(u32x4*)(T + row * 2048 + 256 * g + 8 * c8) = t; }
    }
#undef SP_LOAD
#undef SP_LANE
#undef WSWZ
    asm volatile("s_waitcnt lgkmcnt(0)" ::: "memory");
    __syncthreads();
}
__device__ __forceinline__ void conv_mix(Frame& F, int row0) {
    const bf16_t* P = (const bf16_t*)(F.ws + WS_R1 + R1_P); const bf16_t* BG = (const bf16_t*)(F.ws + WS_R1 + R1_BG); bf16_t* T2 = (bf16_t*)(F.ws + WS_R1 + R1_T2);
    const float* cw = INP(IN_CW);
    const long nitem = (long)TALL * 128;
    for (long it = (long)row0 * 128 + (long)F.bid * 512 + F.tid; it < nitem; it += (long)F.G * 512) {
        const int row = (int)(it >> 7), c8 = (int)(it & 127) * 8;
        const bool first = row < NCTX ? ((row & 255) == 0) : (((row - NCTX) & (SEQ - 1)) == 0);
        const bool last = row < NCTX ? ((row & 255) == 255) : (((row - NCTX) & (SEQ - 1)) == SEQ - 1);
        const u32x4 zero = (u32x4){0u, 0u, 0u, 0u};
        const u32x4 pm = first ? zero : *(const u32x4*)(P + (size_t)(row - 1) * DM + c8);
        const u32x4 pc = *(const u32x4*)(P + (size_t)row * DM + c8);
        const u32x4 pp = last ? zero : *(const u32x4*)(P + (size_t)(row + 1) * DM + c8);
        const u32x4 bg = *(const u32x4*)(BG + (size_t)row * DM + c8);
        float o[8];
#pragma unroll
        for (int e = 0; e < 4; ++e) {
            const float w0a = cw[c8 + 2 * e], w0b = cw[c8 + 2 * e + 1], w1a = cw[1024 + c8 + 2 * e], w1b = cw[1024 + c8 + 2 * e + 1], w2a = cw[2048 + c8 + 2 * e], w2b = cw[2048 + c8 + 2 * e + 1];
            o[2 * e] = bflo(bg[e]) * (w0a * bflo(pm[e]) + w1a * bflo(pc[e]) + w2a * bflo(pp[e]));
            o[2 * e + 1] = bfhi(bg[e]) * (w0b * bfhi(pm[e]) + w1b * bfhi(pc[e]) + w2b * bfhi(pp[e])); }
        u32x4 w; w.x = pk2(o[0], o[1]); w.y = pk2(o[2], o[3]); w.z = pk2(o[4], o[5]); w.w = pk2(o[6], o[7]);
        *(u32x4*)(T2 + (size_t)row * DM + c8) = w;
    }
}

__device__ __forceinline__ void router_phase(Frame& F, const bf16_t* H, int layer, int row0) {
    constexpr int PITCH = 2064;
    char* wl = F.ldsg;
    { const bf16_t* Wr = (const bf16_t*)(F.ws + WS_WR) + (size_t)layer * 256 * 1024;
      for (int i = F.tid; i < 32 * 128; i += NWAVES * 64) { const int r = i >> 7, c = i & 127; *(u32x4*)(wl + r * PITCH + c * 16) = *(const u32x4*)(Wr + (size_t)r * 1024 + c * 8); } }
    asm volatile("s_waitcnt vmcnt(0) lgkmcnt(0)" ::: "memory");
    __syncthreads();
    float* L = (float*)(F.ws + WS_LOGIT);
    const int fr = F.lane & 15, fq = F.lane >> 4;
    const int ng = (TALL - row0) / 16;
    const char* wb = wl + fr * PITCH + fq * 16;
    for (int g = F.wave * F.G + F.bid; g < ng; g += F.NGW) {
        const int tok = row0 + g * 16 + fr;
        const char* hp = (const char*)(H + (size_t)tok * DM) + fq * 16;
        f32x4 acc0 = (f32x4){0.f, 0.f, 0.f, 0.f}, acc1 = (f32x4){0.f, 0.f, 0.f, 0.f};
#pragma clang loop unroll(disable)
        for (int half = 0; half < 2; ++half) {
            u32x4 a[16];
#pragma unroll
            for (int s_ = 0; s_ < 16; ++s_) a[s_] = *(const u32x4*)(hp + half * 1024 + s_ * 64);
#pragma unroll
            for (int s_ = 0; s_ < 16; ++s_) {
                const bf16x8 w0 = *(const bf16x8*)(wb + half * 1024 + s_ * 64), w1 = *(const bf16x8*)(wb + 16 * PITCH + half * 1024 + s_ * 64);
                const bf16x8 hf = __builtin_bit_cast(bf16x8, a[s_]);
                acc0 = __builtin_amdgcn_mfma_f32_16x16x32_bf16(w0, hf, acc0, 0, 0, 0);
                acc1 = __builtin_amdgcn_mfma_f32_16x16x32_bf16(w1, hf, acc1, 0, 0, 0); } }
        *(f32x4*)(L + (size_t)tok * NEXP + 4 * fq) = acc0; *(f32x4*)(L + (size_t)tok * NEXP + 16 + 4 * fq) = acc1;
    }
    asm volatile("s_waitcnt lgkmcnt(0)" ::: "memory");
    __syncthreads();
}

__device__ __forceinline__ void moe_topk(Frame& F, int layer, int row0) {
    const float* L = (const float*)(F.ws + WS_LOGIT); const float* br = INP(IN_MBR) + layer * 32;
    int* TE = (int*)(F.ws + WS_TOKE); float* TG = (float*)(F.ws + WS_TOKG);
    int* ST = (int*)(F.ws + WS_SLOTTOK); int* SD = (int*)(F.ws + WS_SLOTDST); float* SG = (float*)(F.ws + WS_SLOTGATE);
    for (int i = F.bid * 512 + F.tid; i < NSLOT_MAX; i += F.G * 512) { ST[i] = TALL; SG[i] = 0.f; }
    gu32* cnt = F.ctl + CW_CNT + layer * 64;
    for (int g = F.wave * F.G + F.bid; g < (TALL - row0) / 64; g += F.NGW) {
        const int tok = row0 + g * 64 + F.lane;
        float lg[32];
#pragma unroll
        for (int j = 0; j < 8; ++j) { const f32x4 v = *(const f32x4*)(L + (size_t)tok * 32 + 4 * j); const f32x4 b = *(const f32x4*)(br + 4 * j);
            lg[4 * j] = v[0] + b[0]; lg[4 * j + 1] = v[1] + b[1]; lg[4 * j + 2] = v[2] + b[2]; lg[4 * j + 3] = v[3] + b[3]; }
        int e[4]; float tv[4];
#pragma unroll
        for (int k = 0; k < 4; ++k) { float best = -INFINITY; int bi = 0;
#pragma unroll
            for (int i = 0; i < 32; ++i) { const bool take = lg[i] > best; best = take ? lg[i] : best; bi = take ? i : bi; }
            e[k] = bi; tv[k] = best;
#pragma unroll
            for (int i = 0; i < 32; ++i) lg[i] = (i == bi) ? -INFINITY : lg[i]; }
        const float e1 = __expf(tv[1] - tv[0]), e2 = __expf(tv[2] - tv[0]), e3 = __expf(tv[3] - tv[0]); const float inv = 1.0f / (1.0f + e1 + e2 + e3);
        *(int4*)(TE + (size_t)tok * 4) = make_int4(e[0], e[1], e[2], e[3]);
        *(f32x4*)(TG + (size_t)tok * 4) = (f32x4){inv, e1 * inv, e2 * inv, e3 * inv};
        unsigned mycnt = 0;
        for (int x = 0; x < 32; ++x) { unsigned c = 0;
#pragma unroll
            for (int k = 0; k < 4; ++k) c += __popcll(__ballot(e[k] == x));
            if (F.lane == x) mycnt = c; }
        if (F.lane < 32 && mycnt) __hip_atomic_fetch_add(cnt + F.lane, mycnt, RLX_AGENT);
    }
}
__device__ __forceinline__ void moe_scatter(Frame& F, int layer, int row0) {
    const int* TE = (const int*)(F.ws + WS_TOKE); const float* TG = (const float*)(F.ws + WS_TOKG);
    int* ST = (int*)(F.ws + WS_SLOTTOK); int* SD = (int*)(F.ws + WS_SLOTDST); float* SG = (float*)(F.ws + WS_SLOTGATE);
    gu32* cnt = F.ctl + CW_CNT + layer * 64; gu32* cur = F.ctl + CW_CUR + layer * 64;
    unsigned c = (F.lane < 32) ? __hip_atomic_load(cnt + F.lane, RLX_AGENT) : 0u;
    const unsigned padded = (c + 255u) & ~255u; unsigned incl = 0u, total = 0u;
    for (int x = 0; x < 32; ++x) { total += (unsigned)__builtin_amdgcn_readlane((int)padded, x); if (F.lane == x) incl = total; }
    const unsigned pstart = incl - padded;
    {
        int* BE = (int*)(F.ws + WS_META);
        const unsigned nblk = total / 256u;
        for (unsigned b0 = (unsigned)F.gw * 64u; b0 < nblk; b0 += (unsigned)F.NGW * 64u) { const unsigned blk = b0 + F.lane; int ex = 0;
            for (int x = 0; x < 32; ++x) { const unsigned ps = (unsigned)__builtin_amdgcn_readlane((int)pstart, x), pe = (unsigned)__builtin_amdgcn_readlane((int)incl, x); if (blk * 256u >= ps && blk * 256u < pe) ex = x; }
            if (blk < nblk) BE[blk] = ex; }
    }
    for (int g = F.wave * F.G + F.bid; g < (TALL - row0) / 64; g += F.NGW) {
        const int tok = row0 + g * 64 + F.lane;
        const int4 ev = *(const int4*)(TE + (size_t)tok * 4); const f32x4 gv = *(const f32x4*)(TG + (size_t)tok * 4);
        const int e[4] = {ev.x, ev.y, ev.z, ev.w};
        unsigned mycnt = 0; unsigned rank[4] = {0u, 0u, 0u, 0u};
        const unsigned long long lt = (1ull << F.lane) - 1ull;
        for (int x = 0; x < 32; ++x) { unsigned run = 0;
#pragma unroll
            for (int k = 0; k < 4; ++k) { const unsigned long long m = __ballot(e[k] == x); if (e[k] == x) rank[k] = run + (unsigned)__popcll(m & lt); run += (unsigned)__popcll(m); }
            if (F.lane == x) mycnt = run; }
        unsigned base = 0;
        if (F.lane < 32 && mycnt) base = __hip_atomic_fetch_add(cur + F.lane, mycnt, RLX_AGENT);
        base += pstart;
#pragma unroll
        for (int k = 0; k < 4; ++k) { const unsigned slot = (unsigned)__builtin_amdgcn_ds_bpermute(e[k] << 2, (int)base) + rank[k];
            ST[slot] = tok; SG[slot] = gv[k]; SD[tok * 4 + k] = (int)slot; }
    }
}


__device__ __forceinline__ void attn_phase(Frame& F) {
    const bf16_t* Q = (const bf16_t*)(F.ws + WS_R1 + R1_Q); const bf16_t* Kb = (const bf16_t*)(F.ws + WS_R1 + R1_K); const bf16_t* Vb = (const bf16_t*)(F.ws + WS_R1 + R1_V);
    bf16_t* O = (bf16_t*)(F.ws + WS_R1 + R1_O); const unsigned char* V8 = F.ws + WS_R1 + R1_V8;
    float lam;
    { const float* lp = INP(IN_DLAM); const float a = wave_sum(lp[F.lane] * lp[64 + F.lane]), b = wave_sum(lp[128 + F.lane] * lp[192 + F.lane]); lam = expf(a) - expf(b) + LAM_INIT; }
    const float* subg = INP(IN_DSUBG);
    const int bx = F.bid; const int vcu = (F.G % 8 == 0) ? (bx % 8) * (F.G / 8) + bx / 8 : bx;
    for (int id = vcu; id < 4096; id += F.G) {
        { const int bh = id >> 6, qb = id & 63, b = bh >> 3, h = bh & 7;
            att::attn_unit_f8(Q, Kb, V8 + (size_t)bh * 132 * 8192, O, NCTX + b * SEQ + qb * 128, b * CTXL, NCTX + b * SEQ, 4 + SEQ / 64, h, lam, subg, F.ldsg, F.wave0); }
    }
}

__global__ void __launch_bounds__(NWAVES * 64, 2) fwd_kernel(Args args) {
    extern __shared__ __attribute__((aligned(16))) unsigned char lds[];
    Frame F;
    F.lds = (LAS unsigned char*)lds; F.ldsg = (char*)lds;
    F.wave0 = __builtin_amdgcn_readfirstlane((int)(threadIdx.x >> 6));
    F.tid = opaque_tid(F.wave0); F.lane = F.tid & 63; F.wave = F.wave0;
    F.G = gridDim.x; F.bid = blockIdx.x; F.gw = blockIdx.x * NWAVES + F.wave; F.NGW = F.G * NWAVES;
    F.out = args.out; F.ws = args.ws; F.ctl = (gu32*)(args.ws + WS_CTL);
    volatile LAS unsigned* MISC = (volatile LAS unsigned*)(F.lds + MISC_OFF);
    for (int u = F.tid; u < (LDS_BYTES - MISC_OFF) / 4; u += NWAVES * 64) MISC[u] = 0u;
    __syncthreads();
    XcdBarrier bar; bar.bar = (unsigned*)(F.ctl + CW_BAR); bar.x = 0; bar.st = MISC + 8;
    if (F.tid == 0) (void)xb_add(&bar.bar[XB_XCNT(xb_xcc_id())], 1u);
#define GRID_BAR() xcd_barrier(bar, opaque_tid(F.wave0) == 0)
#ifndef PROBE_CLASS
#define PROBE_CLASS 0
#endif
#define PROBE_MULT 4
#if PROBE_CLASS
    unsigned long long pr_t0 = __builtin_amdgcn_s_memrealtime(), pr_acc = 0ull;
#define MARK(c) do { const unsigned long long t_ = __builtin_amdgcn_s_memrealtime(); if ((c) == PROBE_CLASS) pr_acc += t_ - pr_t0; pr_t0 = t_; } while (0)
#else
#define MARK(c) do { } while (0)
#endif
#define REFRESH() do { { int w_ = F.wave0; asm volatile("" : "+s"(w_)); F.wave = w_; } F.tid = opaque_tid(F.wave); F.lane = F.tid & 63; { int b_ = blockIdx.x, g_ = gridDim.x; asm volatile("" : "+s"(b_), "+s"(g_)); F.bid = b_; F.G = g_; F.NGW = g_ * NWAVES; } F.gw = F.bid * NWAVES + F.wave; \
    { GAS unsigned char* g_ = (GAS unsigned char*)F.ws; asm volatile("" : "+s"(g_)); unsigned char* w_ = (unsigned char*)g_; F.ws = w_; F.ctl = (gu32*)(w_ + WS_CTL); R1 = w_ + WS_R1; H = (bf16_t*)(w_ + WS_H); Y = (bf16_t*)(w_ + WS_Y); } } while (0)
    unsigned char* R1 = F.ws + WS_R1;
    bf16_t* H = (bf16_t*)(F.ws + WS_H); bf16_t* Y = (bf16_t*)(F.ws + WS_Y);

    p0_weights(F); __syncthreads(); p0_mod(F); p0_misc(F);
    GRID_BAR(); REFRESH(); MARK(1);
    row_pass<0, true>(F, 0, false, 0);
    GRID_BAR(); REFRESH(); MARK(4);

    for (int layer = 0; layer < DEPTH; ++layer) {
        const int kind = layer % 3, j = layer / 3;
        const int row0i = (layer >= 2) ? NCTX : 0, row0 = (layer >= 1) ? NCTX : 0;
        const int nPanI = (TALL - row0i) / 256, pan0I = row0i / 256, nPan = (TALL - row0) / 256, pan0 = row0 / 256;
        const bf16_t* yA; const bf16_t* yW; int yK;
        if (kind == 0) {
            { pg8::DenseSched S; S.o.init(nPanI, 4096 / 256, F.G, F.bid, pan0I); S.K = 512;
              pg8::EpiGeluStats E{(bf16_t*)(R1 + R1_Z), (float*)(F.ws + WS_PART)};
              pg8::gemm_phase<pg8::EpiGeluStats, pg8::DenseSched, true, true>(F.lds, (const bf16_t*)(F.ws + WS_H8), (const bf16_t*)(F.ws + WS_WIN + (size_t)j * 4096 * 1024), 512, S, E, F.wave0); }
            GRID_BAR(); REFRESH(); MARK(7);
            gmlp_spatial_fused(F, j, row0i);
            GRID_BAR(); REFRESH(); MARK(2);
            yA = (const bf16_t*)(R1 + R1_T); yW = (const bf16_t*)(F.ws + WS_WOUT) + (size_t)j * 1024 * 2048; yK = 2048;
        } else if (kind == 1) {
            { pg8::DenseSched S; S.o.init(nPanI, 3072 / 256, F.G, F.bid, pan0I); S.K = 512;
              pg8::EpiQKV E{(bf16_t*)(R1 + R1_Q), (size_t)(R1_K - R1_Q) / 2, (const float*)(F.ws + WS_ROPE), (const float*)(F.ws + WS_ROPE) + 2048, R1 + R1_V8};
              pg8::gemm_phase<pg8::EpiQKV, pg8::DenseSched, true, true>(F.lds, (const bf16_t*)(F.ws + WS_H8), (const bf16_t*)(F.ws + WS_WQKV), 512, S, E, F.wave0); }
            GRID_BAR(); REFRESH(); MARK(7);
            attn_phase(F);
            GRID_BAR(); REFRESH(); MARK(3);
            yA = (const bf16_t*)(R1 + R1_O); yW = (const bf16_t*)(F.ws + WS_WO); yK = 512;
        } else {
            { pg8::DenseSched S; S.o.init(nPanI, 3072 / 256, F.G, F.bid, pan0I); S.K = 1024;
              pg8::EpiConvIn E{(bf16_t*)(R1 + R1_P), (bf16_t*)(R1 + R1_BG)};
              pg8::gemm_phase<pg8::EpiConvIn, pg8::DenseSched, true>(F.lds, H, (const bf16_t*)(F.ws + WS_CWIN), 1024, S, E, F.wave0); }
            GRID_BAR(); REFRESH(); MARK(7);
            conv_mix(F, row0i);
            GRID_BAR(); REFRESH(); MARK(8);
            yA = (const bf16_t*)(R1 + R1_T2); yW = (const bf16_t*)(F.ws + WS_CWOUT); yK = 1024;
        }
        { pg8::DenseSched S; S.o.init(nPan, 1024 / 256, F.G, F.bid, pan0); S.K = yK;
          pg8::EpiBf16<0> E{Y, 1024};
          if (kind == 1) pg8::gemm_phase<pg8::EpiBf16<0>, pg8::DenseSched, true, true>(F.lds, yA, yW, yK, S, E, F.wave0);
          else pg8::gemm_phase<pg8::EpiBf16<0>, pg8::DenseSched, true>(F.lds, yA, yW, yK, S, E, F.wave0); }
        GRID_BAR(); REFRESH(); MARK(7);
        if (layer == 0) row_pass<1, true>(F, layer, false, row0); else row_pass<1, false>(F, layer, false, row0);
        GRID_BAR(); REFRESH(); MARK(4);
        router_phase(F, H, layer, row0);
        GRID_BAR(); REFRESH(); MARK(5);
        moe_topk(F, layer, row0);
        GRID_BAR(); REFRESH(); MARK(5);
        moe_scatter(F, layer, row0);
        GRID_BAR(); REFRESH(); MARK(5);
        int nblk;
        { unsigned c = (F.lane < 32) ? __hip_atomic_load(F.ctl + CW_CNT + layer * 64 + F.lane, RLX_AGENT) : 0u; unsigned nb = (c + 255u) >> 8;
          nb = wave_sum_u(nb);
          nblk = __builtin_amdgcn_readfirstlane((int)nb); }
        LAS int* lds_be = (LAS int*)(F.lds + MISC_OFF + 4096);
        { const int* BE = (const int*)(F.ws + WS_META); for (int i = F.tid; i < nblk; i += NWAVES * 64) lds_be[i] = BE[i]; }
        __syncthreads();
        { pg8::MoeSched<true> S; S.o.init(nblk, 2048 / 256, F.G, F.bid); S.K = 512; S.N = 2048; S.block_e = lds_be; S.slot_tok = (const int*)(F.ws + WS_SLOTTOK);
          pg8::EpiMoe1 E{(bf16_t*)(R1 + R1_ACT), INP(IN_MBGU) + (size_t)layer * 32 * 2048};
          pg8::gemm_phase<pg8::EpiMoe1, pg8::MoeSched<true>, true, true>(F.lds, (const bf16_t*)(F.ws + WS_H8), (const bf16_t*)(F.ws + WS_WGU + (size_t)layer * 32 * 2048 * 1024), 512, S, E, F.wave0); }
        GRID_BAR(); REFRESH(); MARK(6);
        { pg8::MoeSched<false> S; S.o.init(nblk, 1024 / 256, F.G, F.bid); S.K = 512; S.N = 1024; S.block_e = lds_be; S.slot_tok = nullptr;
          pg8::EpiMoe2 E{(bf16_t*)(R1 + R1_YK), INP(IN_MBDN) + (size_t)layer * 32 * 1024, (const float*)(F.ws + WS_SLOTGATE)};
          pg8::gemm_phase<pg8::EpiMoe2, pg8::MoeSched<false>, true, true>(F.lds, (const bf16_t*)(R1 + R1_ACT), (const bf16_t*)(F.ws + WS_WDN + (size_t)layer * 32 * 1024 * 1024), 512, S, E, F.wave0); }
        GRID_BAR(); REFRESH(); MARK(6);
        row_pass<2, false>(F, layer, layer == DEPTH - 1, row0);
        if (layer != DEPTH - 1) { GRID_BAR(); REFRESH(); MARK(4); }
    }
#if PROBE_CLASS
    GRID_BAR(); MARK(4);
    if (F.bid == 0 && F.tid == 0) { const unsigned long long tend = __builtin_amdgcn_s_memrealtime() + PROBE_MULT * pr_acc; while (__builtin_amdgcn_s_memrealtime() < tend) __builtin_amdgcn_s_sleep(8); }
#endif
}

extern "C" void kernel_launch(void* const* d_in, const int* in_sizes, int n_in, void* d_out, int out_size, void* d_ws, size_t ws_size, hipStream_t stream) {
    static int grid = 0;
    if (grid == 0) {
        if (n_in != 27 || out_size != NLAT * DM || ws_size < WS_END) { fprintf(stderr, "kernel_launch: unexpected shapes (n_in %d, out %d, ws %zu < %zu)\n", n_in, out_size, ws_size, (size_t)WS_END); grid = -1; return; }
        int dev = 0, cus = 0, per_cu = 0;
        if (hipGetDevice(&dev) != hipSuccess || hipDeviceGetAttribute(&cus, hipDeviceAttributeMultiprocessorCount, dev) != hipSuccess) { grid = -1; return; }
        if (hipFuncSetAttribute((const void*)fwd_kernel, hipFuncAttributeMaxDynamicSharedMemorySize, LDS_BYTES) != hipSuccess) { fprintf(stderr, "kernel_launch: hipFuncSetAttribute failed\n"); grid = -1; return; }
        if (hipOccupancyMaxActiveBlocksPerMultiprocessor(&per_cu, (const void*)fwd_kernel, NWAVES * 64, LDS_BYTES) != hipSuccess || per_cu < 1) { fprintf(stderr, "kernel_launch: occupancy query reports %d\n", per_cu); }
        (void)hipGetLastError();
        grid = cus;
    }
    if (grid < 0) return;
    if (hipMemsetAsync((char*)d_ws + WS_CTL, 0, CTL_ZERO_BYTES, stream) != hipSuccess) return;
    Args a{};
    for (int i = 0; i < 27; ++i) a.in[i] = (const float*)d_in[i];
    a.out = (float*)d_out; a.ws = (unsigned char*)d_ws;
    hipLaunchKernelGGL(fwd_kernel, dim3(grid), dim3(NWAVES * 64), LDS_BYTES, stream, a);
}
```

```cpp
#include <hip/hip_runtime.h>
#include <hip/hip_bf16.h>
#include <cstdio>
#include <cstdint>
#include <cmath>

#define GAS __attribute__((address_space(1)))
#define LAS __attribute__((address_space(3)))
typedef unsigned short bf16_t;
typedef short bf16x8 __attribute__((ext_vector_type(8)));
typedef short s16x4 __attribute__((ext_vector_type(4)));
typedef float f32x4 __attribute__((ext_vector_type(4)));
typedef float f32x2 __attribute__((ext_vector_type(2)));
typedef float f32x16 __attribute__((ext_vector_type(16)));
typedef unsigned u32x4 __attribute__((ext_vector_type(4)));
typedef unsigned u32x2 __attribute__((ext_vector_type(2)));
typedef GAS unsigned gu32;
#define RLX_AGENT __ATOMIC_RELAXED, __HIP_MEMORY_SCOPE_AGENT

constexpr int DM = 1024, NB = 8, SEQ = 8192, CTXL = 256, DEPTH = 4;
constexpr int NCTX = NB * CTXL;
constexpr int NLAT = NB * SEQ;
constexpr int TALL = NCTX + NLAT;
constexpr int NEXP = 32, TOPK = 4;
constexpr int NBLK_MAX = TALL * TOPK / 256 + NEXP;
constexpr int NSLOT_MAX = NBLK_MAX * 256;
constexpr float LN_EPS = 1e-5f;
constexpr float DN_ALPHA = 1.681792830507429f;
constexpr float LAM_INIT = 0.35550906759096927f;
constexpr int NWAVES = 8;
constexpr float QK_PRESCALE = 0.125f * 1.4426950408889634f;

constexpr size_t MiB = 1u << 20;
constexpr size_t WS_CTL = 0, CTL_ZERO_BYTES = 1 * MiB;
constexpr size_t WS_MOD = 1 * MiB;
constexpr size_t WS_ROPE = 2 * MiB;
constexpr size_t WS_META = 2 * MiB + 64 * 1024;
constexpr size_t WS_STAT = 3 * MiB;
constexpr size_t WS_LOGIT = 4 * MiB;
constexpr size_t WS_TOKE = 13 * MiB;
constexpr size_t WS_TOKG = 15 * MiB;
constexpr size_t WS_SLOTTOK = 17 * MiB;
constexpr size_t WS_SLOTGATE = 19 * MiB;
constexpr size_t WS_SLOTDST = 21 * MiB;
constexpr size_t WS_WIN = 24 * MiB;
constexpr size_t WS_WOUT = 40 * MiB;
constexpr size_t WS_WS = 48 * MiB;
constexpr size_t WS_WQKV = 49 * MiB;
constexpr size_t WS_WO = 55 * MiB;
constexpr size_t WS_CWIN = 57 * MiB;
constexpr size_t WS_CWOUT = 63 * MiB;
constexpr size_t WS_WR = 65 * MiB;
constexpr size_t WS_WGU = 68 * MiB;
constexpr size_t WS_WDN = 580 * MiB;
constexpr size_t WS_X = 836 * MiB;
constexpr size_t WS_H = 1100 * MiB;
constexpr size_t WS_Y = 1234 * MiB;
constexpr size_t WS_R1 = 1368 * MiB;
constexpr size_t R1_Z = 0, R1_VT = 528 * MiB, R1_T = 792 * MiB;
constexpr size_t R1_Q = 0, R1_K = 132 * MiB, R1_V = 264 * MiB, R1_O = 396 * MiB, R1_V8 = 528 * MiB;
constexpr size_t R1_P = 0, R1_BG = 132 * MiB, R1_T2 = 264 * MiB;
constexpr size_t R1_ACT = 0, R1_YK = 288 * MiB;
static_assert(R1_V - R1_K == R1_K - R1_Q, "Q | K | V equally spaced");
constexpr size_t WS_H8 = WS_R1 + 1080 * MiB;
constexpr size_t WS_PART = WS_H8 + 68 * MiB;
constexpr size_t WS_END = WS_PART + 18 * MiB;
static_assert((size_t)TALL * 4096 * 2 <= 528 * MiB && (size_t)NSLOT_MAX * 1024 <= 288 * MiB && R1_YK + (size_t)NSLOT_MAX * 1024 * 2 <= 1080 * MiB, "R1 map");
static_assert((size_t)(TALL + 256) * 1024 * 2 <= 134 * MiB && (size_t)TALL * 1024 * 4 <= 264 * MiB, "X/H map");
constexpr int CW_TMO = 0;
constexpr int CW_CNT = 1024;
constexpr int CW_CUR = 2048;
constexpr int CW_BAR = 4096;

constexpr int RING_BYTES = 131072;
constexpr int MISC_OFF = RING_BYTES;
constexpr int LDS_BYTES = 147456;

#define LDS_WAIT() asm volatile("s_waitcnt lgkmcnt(0)" ::: "memory")
#define VM_WAIT() asm volatile("s_waitcnt vmcnt(0)" ::: "memory")

__device__ __forceinline__ unsigned f2bf(float f) { unsigned u = __builtin_bit_cast(unsigned, f); return (u + 0x7fffu + ((u >> 16) & 1u)) >> 16; }
__device__ __forceinline__ unsigned pk2(float lo, float hi) { return f2bf(lo) | (f2bf(hi) << 16); }
__device__ __forceinline__ float bf2f(unsigned short b) { return __builtin_bit_cast(float, (unsigned)b << 16); }
__device__ __forceinline__ float bflo(unsigned w) { return __builtin_bit_cast(float, w << 16); }
__device__ __forceinline__ float bfhi(unsigned w) { return __builtin_bit_cast(float, w & 0xffff0000u); }
__device__ __forceinline__ unsigned cvt_pk_bf16(float lo, float hi) { unsigned r; asm volatile("v_cvt_pk_bf16_f32 %0, %1, %2" : "=v"(r) : "v"(lo), "v"(hi)); return r; }
typedef int i32x8 __attribute__((ext_vector_type(8)));
__device__ __forceinline__ unsigned cvt_fp8x4(float a, float b, float c, float d) { int w = __builtin_amdgcn_cvt_pk_fp8_f32(a, b, 0, false); w = __builtin_amdgcn_cvt_pk_fp8_f32(c, d, w, true); return (unsigned)w; }
constexpr float YK8_SCALE = 16.0f;
__device__ __forceinline__ unsigned cvt_fp8x4_sat(float a, float b, float c, float d) { return cvt_fp8x4(__builtin_amdgcn_fmed3f(a, -448.f, 448.f), __builtin_amdgcn_fmed3f(b, -448.f, 448.f), __builtin_amdgcn_fmed3f(c, -448.f, 448.f), __builtin_amdgcn_fmed3f(d, -448.f, 448.f)); }
constexpr float W8_SCALE = 32.0f;
constexpr int W8_E8M0 = 0x7A7A7A7A, A8_E8M0 = 0x7F7F7F7F;
__device__ __forceinline__ int opaque_tid(int wave) { int l; asm volatile("v_mbcnt_lo_u32_b32 %0, -1, 0\n\tv_mbcnt_hi_u32_b32 %0, -1, %0" : "=v"(l)); return wave * 64 + l; }
template <int M> __device__ __forceinline__ int swz_xor_i(int v) { return __builtin_amdgcn_ds_swizzle(v, (M << 10) | 0x1f); }
template <int M> __device__ __forceinline__ float swz_xor_f(float v) { return __builtin_bit_cast(float, __builtin_amdgcn_ds_swizzle(__builtin_bit_cast(int, v), (M << 10) | 0x1f)); }
__device__ __forceinline__ float half_sum32(float v) { v += swz_xor_f<1>(v); v += swz_xor_f<2>(v); v += swz_xor_f<4>(v); v += swz_xor_f<8>(v); v += swz_xor_f<16>(v); return v; }
__device__ __forceinline__ float wave_sum(float v) {
    v = half_sum32(v);
    const auto rr = __builtin_amdgcn_permlane32_swap(__float_as_uint(v), __float_as_uint(v), false, false);
    return __uint_as_float(rr[0]) + __uint_as_float(rr[1]);
}
__device__ __forceinline__ unsigned wave_sum_u(unsigned v) {
    v += (unsigned)swz_xor_i<1>((int)v); v += (unsigned)swz_xor_i<2>((int)v); v += (unsigned)swz_xor_i<4>((int)v); v += (unsigned)swz_xor_i<8>((int)v); v += (unsigned)swz_xor_i<16>((int)v);
    const auto rr = __builtin_amdgcn_permlane32_swap(v, v, false, false);
    return rr[0] + rr[1];
}

#define XB_TMO      128
#define XB_XCNT(j)  (256  + 64 * (j))
#define XB_XSUB(j)  (1280 + 64 * (j))
#define XB_XGEN(j)  (2304 + 64 * (j))
#define XB_TOP      3328
#define XB_TOPGEN   3392
#define XCD_BAR_WORDS 3456
#define XB_SPIN_CAP (1u << 22)

__device__ __forceinline__ unsigned xb_ld(unsigned* p)              { return __hip_atomic_load(p, __ATOMIC_RELAXED, __HIP_MEMORY_SCOPE_AGENT); }
__device__ __forceinline__ unsigned xb_add(unsigned* p, unsigned v) { return __hip_atomic_fetch_add(p, v, __ATOMIC_RELAXED, __HIP_MEMORY_SCOPE_AGENT); }
__device__ __forceinline__ unsigned xb_xcc_id() { return (unsigned)__builtin_amdgcn_s_getreg((3 << 11) | 20) & 0xFu; }
#define XB_SPIN(cond, bar) do { unsigned _sp = 0; while (cond) { __builtin_amdgcn_s_sleep(1); \
    if ((++_sp & 255u) == 0u) { if (xb_ld(&(bar)[XB_TMO])) break; if (_sp > XB_SPIN_CAP) { atomicAdd(&(bar)[XB_TMO], 1u); break; } } } } while (0)

struct XcdBarrier { unsigned* bar; unsigned x; volatile LAS unsigned* st; };

__device__ __forceinline__ XcdBarrier xcd_barrier_post(unsigned* bar, volatile LAS unsigned* st) {
    XcdBarrier b; b.bar = bar; b.x = xb_xcc_id(); b.st = st;
    if (threadIdx.x == 0) (void)xb_add(&bar[XB_XCNT(b.x)], 1u);
    return b;
}
__device__ __forceinline__ void xcd_barrier_complete(unsigned* bar, unsigned x, unsigned& nloc, unsigned& nx) {
    const unsigned G = gridDim.x * gridDim.y * gridDim.z;
    unsigned sum, cnt, mine, sp = 0u;
    for (;;) {
        sum = 0u; cnt = 0u; mine = 0u;
#pragma unroll
        for (unsigned j = 0; j < 16; ++j) { const unsigned c = xb_ld(&bar[XB_XCNT(j)]); sum += c; cnt += (c > 0u) ? 1u : 0u; mine = (j == x) ? c : mine; }
        if (sum == G) break;
        __builtin_amdgcn_s_sleep(1);
        if ((++sp & 255u) == 0u) { if (xb_ld(&bar[XB_TMO])) break; if (sp > XB_SPIN_CAP) { atomicAdd(&bar[XB_TMO], 1u); break; } }
    }
    nloc = mine > 0u ? mine : 1u; nx = cnt > 0u ? cnt : 1u;
}
__device__ __forceinline__ void xcd_barrier(const XcdBarrier& b, const bool leader) {
    asm volatile("s_waitcnt vmcnt(0)" ::: "memory");
    __syncthreads();
    if (leader) {
        GAS unsigned* gbar_ = (GAS unsigned*)b.bar; asm volatile("" : "+s"(gbar_)); unsigned* bar = (unsigned*)gbar_; const unsigned bx_ = (unsigned)__builtin_amdgcn_readfirstlane((int)xb_xcc_id());
        __builtin_amdgcn_s_waitcnt(0);
        unsigned nloc = b.st[0], nx = b.st[1];
        if (nloc == 0u) { xcd_barrier_complete(bar, bx_, nloc, nx); b.st[0] = nloc; b.st[1] = nx; }
        const unsigned old = xb_add(&bar[XB_XSUB(bx_)], 1u);
        const unsigned gen = old / nloc;
        if (old + 1u == (gen + 1u) * nloc) {
            __builtin_amdgcn_fence(__ATOMIC_RELEASE, "agent");
            asm volatile("s_waitcnt vmcnt(0)" ::: "memory");
            const unsigned og = xb_add(&bar[XB_TOP], 1u);
            const unsigned tg = og / nx;
            if (og + 1u == (tg + 1u) * nx) xb_add(&bar[XB_TOPGEN], 1u);
            else XB_SPIN(xb_ld(&bar[XB_TOPGEN]) == tg, bar);
            __builtin_amdgcn_fence(__ATOMIC_ACQUIRE, "agent");
            xb_add(&bar[XB_XGEN(bx_)], 1u);
            asm volatile("s_waitcnt vmcnt(0)" ::: "memory");
        } else {
            XB_SPIN(xb_ld(&bar[XB_XGEN(bx_)]) == gen, bar);
            __builtin_amdgcn_fence(__ATOMIC_ACQUIRE, "agent");
            asm volatile("s_waitcnt vmcnt(0)" ::: "memory");
        }
    }
    __syncthreads();
}

namespace pg8 {
constexpr int BM = 256, BK = 64, HALF = 128, HTB = HALF * BK * 2, STAGE_BYTES = 8 * HTB, NXCD = 8, WGM = 8;
__host__ __device__ __forceinline__ int lds_byte(int r, int c) { const int st = (r >> 4) * 2 + (c >> 5), rr = r & 15, cc = c & 31, ob = rr * 64 + cc * 2; return st * 1024 + (ob ^ (((ob >> 9) & 1) << 5)); }
__host__ __device__ __forceinline__ void stage_rc(int b, int& R, int& C) { const int st = b / 1024, sb = b % 1024, swz = sb ^ (((sb >> 9) & 1) << 5); R = (st >> 1) * 16 + swz / 64; C = (st & 1) * 32 + (swz % 64) / 2; }
__host__ __device__ __forceinline__ int perm32(int rho) { const int n = rho >> 4, i = rho & 15; return 8 * (i >> 2) + 4 * n + (i & 3); }

struct Unit { int pm, pn, e; };
__device__ __forceinline__ void glds16_s(const char* gbase, unsigned voff, unsigned lds_dst);
constexpr int EPI_LDS_OFF = MISC_OFF + 8704, EPI_LDS_BUF = 3072;

struct TileOrder {
    int nM, nN, nwg, G, c, pm0;
    __device__ __forceinline__ void init(int nM_, int nN_, int G_, int c_, int pm0_ = 0) { nM = nM_; nN = nN_; nwg = nM * nN; G = G_; c = c_; pm0 = pm0_; }
    __device__ __forceinline__ bool tile(int i, int& pm, int& pn) const {
        const long L = (long)i * G + c; if (L >= nwg) return false;
        int wgid = (int)L; { const int q = nwg / NXCD, r = nwg % NXCD, xcd = wgid % NXCD, off = wgid / NXCD; wgid = (xcd < r ? xcd * (q + 1) : r * (q + 1) + (xcd - r) * q) + off; }
        const int nig = WGM * nN, gid = wgid / nig, fm = gid * WGM, gsz = (nM - fm) < WGM ? (nM - fm) : WGM;
        pm = pm0 + fm + ((wgid % nig) % gsz); pn = (wgid % nig) / gsz; return true;
    }
};
struct DenseSched {
    TileOrder o; int K;
    static constexpr bool ASYNC_ROWS = false;
    __device__ __forceinline__ bool next(int i, Unit& u) const { u.e = 0; return o.tile(i, u.pm, u.pn); }
    __device__ __forceinline__ unsigned a_row(const Unit& u, int r) const { return (unsigned)(u.pm * BM + r); }
    __device__ __forceinline__ unsigned a_row_async(const Unit& u, int r) const { return a_row(u, r); }
    __device__ __forceinline__ size_t b_off(const Unit& u) const { return (size_t)u.pn * BM * K; }
};
template <bool GATHER> struct MoeSched {
    TileOrder o; int K, N; const LAS int* block_e; const int* slot_tok;
    static constexpr bool ASYNC_ROWS = GATHER;
    __device__ __forceinline__ bool next(int i, Unit& u) const {
        if (!o.tile(i, u.pm, u.pn)) return false;
        u.e = __builtin_amdgcn_readfirstlane(block_e[u.pm]); return true; }
    __device__ __forceinline__ unsigned a_row(const Unit& u, int r) const { if (GATHER) return (unsigned)slot_tok[u.pm * BM + r]; else return (unsigned)(u.pm * BM + r); }
    __device__ __forceinline__ unsigned a_row_async(const Unit& u, int r) const {
        if (GATHER) { unsigned v; asm volatile("global_load_dword %0, %1, %2" : "=v"(v) : "v"((unsigned)(u.pm * BM + r) * 4u), "s"(slot_tok) : "memory"); return v; }
        else return (unsigned)(u.pm * BM + r); }
    __device__ __forceinline__ size_t b_off(const Unit& u) const { return ((size_t)u.e * N + (size_t)u.pn * BM) * K; }
};

__device__ __forceinline__ f32x2 gelu_pk(f32x2 v) {
    const f32x2 av = __builtin_elementwise_abs(v), d = av * 0.2316418882f + 1.0f;
    f32x2 t; t.x = __builtin_amdgcn_rcpf(d.x); t.y = __builtin_amdgcn_rcpf(d.y);
    f32x2 q = t * 0.5307027145f + (-0.7265760135f); q = q * t + 0.7107068705f; q = q * t + (-0.142248368f); q = q * t + 0.127414796f; q = q * t;
    const f32x2 s = (v * v) * (-0.72134752044f);
    f32x2 e; e.x = __builtin_amdgcn_exp2f(s.x); e.y = __builtin_amdgcn_exp2f(s.y);
    const f32x2 m = v * (q * e), r = v - m;
    f32x2 o; o.x = v.x < 0.f ? m.x : r.x; o.y = v.y < 0.f ? m.y : r.y; return o;
}
__device__ __forceinline__ u32x4 pack8(f32x4 v0, f32x4 v1) { u32x4 w; w.x = cvt_pk_bf16(v0[0], v0[1]); w.y = cvt_pk_bf16(v0[2], v0[3]); w.z = cvt_pk_bf16(v1[0], v1[1]); w.w = cvt_pk_bf16(v1[2], v1[3]); return w; }
__device__ __forceinline__ u32x2 pack4(f32x4 v) { u32x2 w; w.x = cvt_pk_bf16(v[0], v[1]); w.y = cvt_pk_bf16(v[2], v[3]); return w; }

template <int ACT> struct EpiBf16 {
    __device__ __forceinline__ void prefetch(const Unit&, unsigned, int, int) const {}
    static constexpr bool PERM = true;
    bf16_t* O; int ldc;
    __device__ __forceinline__ void operator()(const f32x4 (&acc)[2][2][4][2], const Unit& u, int wr, int wc, int fr, int fq, const LAS unsigned char* epl) const {
        const int row0 = u.pm * BM + wr * 64 + fr, col0 = u.pn * BM + wc * 32 + 8 * fq;
#pragma unroll
        for (int ai = 0; ai < 2; ++ai)
#pragma unroll
            for (int m = 0; m < 4; ++m) { bf16_t* rowp = O + (size_t)(row0 + ai * HALF + m * 16) * ldc + col0;
#pragma unroll
                for (int bj = 0; bj < 2; ++bj) { f32x4 v0 = acc[ai][bj][m][0], v1 = acc[ai][bj][m][1];
                    if (ACT == 1) { f32x2 a = gelu_pk((f32x2){v0[0], v0[1]}), b = gelu_pk((f32x2){v0[2], v0[3]}), c = gelu_pk((f32x2){v1[0], v1[1]}), d = gelu_pk((f32x2){v1[2], v1[3]});
                        v0 = (f32x4){a.x, a.y, b.x, b.y}; v1 = (f32x4){c.x, c.y, d.x, d.y}; }
                    *(u32x4*)(rowp + bj * HALF) = pack8(v0, v1); } }
    }
};
struct EpiGeluStats {
    static constexpr bool PERM = true;
    __device__ __forceinline__ void prefetch(const Unit&, unsigned, int, int) const {}
    bf16_t* O; float* part;
    __device__ __forceinline__ void operator()(const f32x4 (&acc)[2][2][4][2], const Unit& u, int wr, int wc, int fr, int fq, const LAS unsigned char*) const {
        const int row0 = u.pm * BM + wr * 64 + fr, col0 = u.pn * BM + wc * 32 + 8 * fq;
#pragma unroll
        for (int ai = 0; ai < 2; ++ai)
#pragma unroll
            for (int m = 0; m < 4; ++m) { const int row = row0 + ai * HALF + m * 16; bf16_t* rowp = O + (size_t)row * 4096 + col0; float sm = 0.f, sq = 0.f;
#pragma unroll
                for (int bj = 0; bj < 2; ++bj) { f32x4 v0 = acc[ai][bj][m][0], v1 = acc[ai][bj][m][1];
                    { f32x2 a = gelu_pk((f32x2){v0[0], v0[1]}), b = gelu_pk((f32x2){v0[2], v0[3]}), c = gelu_pk((f32x2){v1[0], v1[1]}), d = gelu_pk((f32x2){v1[2], v1[3]});
                      v0 = (f32x4){a.x, a.y, b.x, b.y}; v1 = (f32x4){c.x, c.y, d.x, d.y}; }
                    sm += ((v0[0] + v0[1]) + (v0[2] + v0[3])) + ((v1[0] + v1[1]) + (v1[2] + v1[3]));
                    sq += ((v0[0] * v0[0] + v0[1] * v0[1]) + (v0[2] * v0[2] + v0[3] * v0[3])) + ((v1[0] * v1[0] + v1[1] * v1[1]) + (v1[2] * v1[2] + v1[3] * v1[3]));
                    *(u32x4*)(rowp + bj * HALF) = pack8(v0, v1); }
                if (u.pn >= 8) {
                    sm += swz_xor_f<16>(sm); sq += swz_xor_f<16>(sq);
                    { const auto r1 = __builtin_amdgcn_permlane32_swap(__float_as_uint(sm), __float_as_uint(sm), false, false); sm = __uint_as_float(r1[0]) + __uint_as_float(r1[1]);
                      const auto r2 = __builtin_amdgcn_permlane32_swap(__float_as_uint(sq), __float_as_uint(sq), false, false); sq = __uint_as_float(r2[0]) + __uint_as_float(r2[1]); }
                    if (fq == 0) *(f32x2*)(part + ((size_t)row * 32 + (u.pn - 8) * 4 + wc) * 2) = (f32x2){sm, sq}; } }
    }
};
struct EpiQKV {
    __device__ __forceinline__ void prefetch(const Unit&, unsigned, int, int) const {}
    static constexpr bool PERM = false;
    bf16_t* Q; size_t qkv_stride; const float* ropec; const float* ropes; unsigned char* V8;
    __device__ __forceinline__ void operator()(const f32x4 (&acc)[2][2][4][2], const Unit& u, int wr, int wc, int fr, int fq, const LAS unsigned char* epl) const {
        const int t = u.pn >> 2, colt = (u.pn & 3) * BM;
        if (t == 2) {
#pragma unroll
            for (int ai = 0; ai < 2; ++ai) {
                const int g0 = u.pm * BM + ai * HALF + wr * 64;
                const int b = g0 < NCTX ? (g0 >> 8) : ((g0 - NCTX) >> 13), jt = g0 < NCTX ? ((g0 & 255) >> 6) : 4 + (((g0 - NCTX) & (SEQ - 1)) >> 6);
#pragma unroll
                for (int bj = 0; bj < 2; ++bj) { const int h = (u.pn & 3) * 2 + bj;
                    unsigned char* img = V8 + ((size_t)((b * 8 + h) * 132 + jt)) * 8192 + (wc * 32 + 4 * fq) * 64 + 4 * fr;
#pragma unroll
                    for (int n = 0; n < 2; ++n)
#pragma unroll
                        for (int j = 0; j < 4; ++j) *(unsigned*)(img + (16 * n + j) * 64) = cvt_fp8x4(acc[ai][bj][0][n][j], acc[ai][bj][1][n][j], acc[ai][bj][2][n][j], acc[ai][bj][3][n][j]); } }
            return;
        }
        bf16_t* base = Q + (size_t)t * qkv_stride;
#pragma unroll
        for (int ai = 0; ai < 2; ++ai)
#pragma unroll
            for (int m = 0; m < 4; ++m) {
                const int row = u.pm * BM + ai * HALF + wr * 64 + m * 16 + fr;
                f32x4 cs = (f32x4){1.f, 1.f, 1.f, 1.f}, sn = (f32x4){0.f, 0.f, 0.f, 0.f};
                if (row >= NCTX) { const int tp = (row - NCTX) & (SEQ - 1); const int pos = (wc & 1) ? (tp & 63) : (tp >> 6);
                    cs = *(const f32x4*)(ropec + pos * 16 + 4 * fq); sn = *(const f32x4*)(ropes + pos * 16 + 4 * fq); }
#pragma unroll
                for (int bj = 0; bj < 2; ++bj) { const f32x4 x1 = acc[ai][bj][m][0], x2 = acc[ai][bj][m][1];
                    f32x4 o1 = x1 * cs - x2 * sn, o2 = x1 * sn + x2 * cs;
                    if (t == 0) { o1 = o1 * QK_PRESCALE; o2 = o2 * QK_PRESCALE; }
                    { unsigned char* r8 = (unsigned char*)base + (size_t)row * DM + colt + wc * 32 + 4 * fq + bj * HALF;
                        *(unsigned*)r8 = cvt_fp8x4_sat(o1[0], o1[1], o1[2], o1[3]); *(unsigned*)(r8 + 16) = cvt_fp8x4_sat(o2[0], o2[1], o2[2], o2[3]); } } }
    }
};
struct EpiConvIn {
    __device__ __forceinline__ void prefetch(const Unit&, unsigned, int, int) const {}
    static constexpr bool PERM = true;
    bf16_t* P; bf16_t* BG;
    __device__ __forceinline__ void operator()(const f32x4 (&acc)[2][2][4][2], const Unit& u, int wr, int wc, int fr, int fq, const LAS unsigned char* epl) const {
        const int row0 = u.pm * BM + wr * 64 + fr;
#pragma unroll
        for (int ai = 0; ai < 2; ++ai)
#pragma unroll
            for (int m = 0; m < 4; ++m) { const size_t row = (size_t)(row0 + ai * HALF + m * 16);
                if (u.pn < 8) { *(u32x4*)(P + row * DM + u.pn * HALF + wc * 32 + 8 * fq) = pack8(acc[ai][0][m][0] * acc[ai][1][m][0], acc[ai][0][m][1] * acc[ai][1][m][1]); }
                else {
#pragma unroll
                    for (int bj = 0; bj < 2; ++bj) *(u32x4*)(BG + row * DM + (u.pn - 8) * BM + bj * HALF + wc * 32 + 8 * fq) = pack8(acc[ai][bj][m][0], acc[ai][bj][m][1]); } }
    }
};
struct EpiRouter {
    __device__ __forceinline__ void prefetch(const Unit&, unsigned, int, int) const {}
    static constexpr bool PERM = false;
    float* L;
    __device__ __forceinline__ void operator()(const f32x4 (&acc)[2][2][4][2], const Unit& u, int wr, int wc, int fr, int fq, const LAS unsigned char* epl) const {
        if (wc != 0) return;
#pragma unroll
        for (int ai = 0; ai < 2; ++ai)
#pragma unroll
            for (int m = 0; m < 4; ++m) { float* rowp = L + (size_t)(u.pm * BM + ai * HALF + wr * 64 + m * 16 + fr) * NEXP + 4 * fq;
                *(f32x4*)(rowp) = acc[ai][0][m][0]; *(f32x4*)(rowp + 16) = acc[ai][0][m][1]; }
    }
};
struct EpiMoe1 {
    static constexpr bool PERM = true;
    bf16_t* ACT; const float* bgu;
    __device__ __forceinline__ void prefetch(const Unit& u, unsigned lds_dst, int wid, int lane) const {
        if (wid == 0) { const unsigned off = (unsigned)((u.e * 2048 + (lane >> 5) * 1024 + u.pn * HALF) * 4 + (lane & 31) * 16); glds16_s((const char*)bgu, off, lds_dst); } }
    __device__ __forceinline__ void operator()(const f32x4 (&acc)[2][2][4][2], const Unit& u, int wr, int wc, int fr, int fq, const LAS unsigned char* epl) const {
        const int ff0 = u.pn * HALF + wc * 32 + 8 * fq;
        f32x4 bg[2], bu[2];
#pragma unroll
        for (int n = 0; n < 2; ++n) { bg[n] = *(const LAS f32x4*)(epl + (wc * 32 + 8 * fq + 4 * n) * 4); bu[n] = *(const LAS f32x4*)(epl + 512 + (wc * 32 + 8 * fq + 4 * n) * 4); }
#pragma unroll
        for (int ai = 0; ai < 2; ++ai)
#pragma unroll
            for (int m = 0; m < 4; ++m) { const size_t row = (size_t)(u.pm * BM + ai * HALF + wr * 64 + m * 16 + fr);
                f32x4 o[2];
#pragma unroll
                for (int n = 0; n < 2; ++n) { const f32x4 gv = acc[ai][0][m][n] + bg[n], uv = acc[ai][1][m][n] + bu[n];
#pragma unroll
                    for (int jj = 0; jj < 2; ++jj) { f32x2 g, up; g.x = fminf(gv[2 * jj], 7.0f); g.y = fminf(gv[2 * jj + 1], 7.0f);
                        up.x = __builtin_amdgcn_fmed3f(uv[2 * jj], -7.0f, 7.0f); up.y = __builtin_amdgcn_fmed3f(uv[2 * jj + 1], -7.0f, 7.0f);
                        const f32x2 ea = g * (-1.702f * 1.4426950408889634f); f32x2 e; e.x = __builtin_amdgcn_exp2f(ea.x); e.y = __builtin_amdgcn_exp2f(ea.y);
                        const f32x2 de = e + 1.0f; f32x2 sg; sg.x = __builtin_amdgcn_rcpf(de.x); sg.y = __builtin_amdgcn_rcpf(de.y);
                        const f32x2 r = (up + 1.0f) * (g * sg); o[n][2 * jj] = r.x; o[n][2 * jj + 1] = r.y; } }
                u32x2 w8; w8.x = cvt_fp8x4(o[0][0], o[0][1], o[0][2], o[0][3]); w8.y = cvt_fp8x4(o[1][0], o[1][1], o[1][2], o[1][3]);
                *(u32x2*)((unsigned char*)ACT + row * DM + ff0) = w8; }
    }
};
struct EpiMoe2 {
    static constexpr bool PERM = true;
    bf16_t* YK; const float* bdn; const float* slot_gate;
    __device__ __forceinline__ void prefetch(const Unit& u, unsigned lds_dst, int wid, int lane) const {
        if (wid == 0) glds16_s((const char*)bdn, (unsigned)((u.e * 1024 + u.pn * BM) * 4 + lane * 16), lds_dst);
        else if (wid == 2) glds16_s((const char*)slot_gate, (unsigned)(u.pm * BM * 4 + lane * 16), lds_dst + 2048u); }
    __device__ __forceinline__ void operator()(const f32x4 (&acc)[2][2][4][2], const Unit& u, int wr, int wc, int fr, int fq, const LAS unsigned char* epl) const {
        const int col0 = u.pn * BM + wc * 32 + 8 * fq;
        f32x4 bv[2][2];
#pragma unroll
        for (int bj = 0; bj < 2; ++bj)
#pragma unroll
            for (int n = 0; n < 2; ++n) bv[bj][n] = *(const LAS f32x4*)(epl + (wc * 32 + 8 * fq + bj * HALF + 4 * n) * 4);
#pragma unroll
        for (int ai = 0; ai < 2; ++ai)
#pragma unroll
            for (int m = 0; m < 4; ++m) { const int sl = ai * HALF + wr * 64 + m * 16 + fr;
                const float gate = *(const LAS float*)(epl + 2048 + sl * 4);
                unsigned char* rowp = (unsigned char*)YK + (size_t)(u.pm * BM + sl) * DM + col0;
                const float g8 = gate * YK8_SCALE;
#pragma unroll
                for (int bj = 0; bj < 2; ++bj) { const f32x4 a0 = (acc[ai][bj][m][0] + bv[bj][0]) * g8, a1 = (acc[ai][bj][m][1] + bv[bj][1]) * g8;
                    u32x2 w8; w8.x = cvt_fp8x4(a0[0], a0[1], a0[2], a0[3]); w8.y = cvt_fp8x4(a1[0], a1[1], a1[2], a1[3]); *(u32x2*)(rowp + bj * HALF) = w8; } }
    }
};

__device__ __forceinline__ void glds16_s(const char* gbase, unsigned voff, unsigned lds_dst) { unsigned keep;
    asm volatile("s_mov_b32 %0, m0\n\ts_mov_b32 m0, %3\n\ts_nop 0\n\tglobal_load_lds_dwordx4 %1, %2\n\ts_mov_b32 m0, %0" : "=&s"(keep) : "v"(voff), "s"(gbase), "s"(lds_dst) : "memory"); }
template <class Epi, class Sched, bool ALIGN_EPI, bool FP8 = false>
__device__ __forceinline__ void gemm_phase(LAS unsigned char* lds, const bf16_t* A, const bf16_t* Bt, const int K, const Sched& S, const Epi& E, const int wave_in) {
    const int tid = opaque_tid(wave_in); const int wid = __builtin_amdgcn_readfirstlane(tid >> 6), lane = tid & 63, wr = wid >> 2, wc = wid & 3, fr = lane & 15, fq = lane >> 4;
    const int nt = K / BK;
    int sR[2], sC[2]; unsigned voffB[2];
#pragma unroll
    for (int i = 0; i < 2; ++i) { stage_rc(tid * 16 + i * 8192, sR[i], sC[i]); const int Rb = Epi::PERM ? ((sR[i] & ~31) + perm32(sR[i] & 31)) : sR[i];
        voffB[i] = (unsigned)(Rb * K + sC[i]) * 2u; }
    const size_t kstep = (size_t)(BK * 2);
    const size_t hstep = (size_t)HALF * K * 2;
    const unsigned ldsw = (unsigned)wid * 1024u;
    const unsigned ldsbase = (unsigned)__builtin_amdgcn_readfirstlane((int)((unsigned)(uintptr_t)lds + ldsw));
    const int aoff = lds_byte(wr * 64 + fr, fq * 8), boff = lds_byte(wc * 32 + fr, fq * 8);
#define PG8_SA(b, h) (((b) * 2 + (h)) * HTB)
#define PG8_SB(b, h) ((4 + (b) * 2 + (h)) * HTB)
#define PG8_STAGE(bufoff, gbase, v0, v1) do { glds16_s((gbase), (v0), ldsbase + (unsigned)(bufoff)); glds16_s((gbase), (v1), ldsbase + (unsigned)(bufoff) + 8192u); } while (0)
#define PG8_LDA(dst, b, h) do { _Pragma("unroll") for (int m = 0; m < 4; ++m) _Pragma("unroll") for (int k = 0; k < 2; ++k) dst[m][k] = *(const LAS bf16x8*)(lds + PG8_SA(b, h) + aoff + m * 2048 + k * 1024); } while (0)
#define PG8_LDB(dst, b, h) do { _Pragma("unroll") for (int n = 0; n < 2; ++n) _Pragma("unroll") for (int k = 0; k < 2; ++k) dst[n][k] = *(const LAS bf16x8*)(lds + PG8_SB(b, h) + boff + n * 2048 + k * 1024); } while (0)
#define PG8_CAT(x, y) __builtin_bit_cast(i32x8, __builtin_shufflevector(x, y, 0, 1, 2, 3, 4, 5, 6, 7, 8, 9, 10, 11, 12, 13, 14, 15))
#define PG8_MMA(ai, bj, At, Bt_) do { __builtin_amdgcn_s_setprio(1); _Pragma("unroll") for (int m = 0; m < 4; ++m) _Pragma("unroll") for (int n = 0; n < 2; ++n) { \
        if constexpr (FP8) asm volatile("v_mfma_scale_f32_16x16x128_f8f6f4 %0, %1, %2, %0, %3, %4 op_sel_hi:[0,0,0]" : "+v"(acc[ai][bj][m][n]) : "v"(PG8_CAT(Bt_[n][0], Bt_[n][1])), "v"(PG8_CAT(At[m][0], At[m][1])), "v"(sclW), "v"(sclA)); \
        else { _Pragma("unroll") for (int k = 0; k < 2; ++k) acc[ai][bj][m][n] = __builtin_amdgcn_mfma_f32_16x16x32_bf16(Bt_[n][k], At[m][k], acc[ai][bj][m][n], 0, 0, 0); } } __builtin_amdgcn_s_setprio(0); } while (0)
#define PG8_WAIT_V(n) asm volatile("s_waitcnt vmcnt(" #n ")" ::: "memory")
#define PG8_WAIT_L(n) asm volatile("s_waitcnt lgkmcnt(" #n ")" ::: "memory")
#define PG8_BAR __builtin_amdgcn_s_barrier()
#define PG8_SCHED __builtin_amdgcn_sched_barrier(0)
#define PG8_AOFF(dst, u) do { _Pragma("unroll") for (int h = 0; h < 2; ++h) _Pragma("unroll") for (int i = 0; i < 2; ++i) dst[h][i] = (S.a_row(u, h * HALF + sR[i]) * (unsigned)K + (unsigned)sC[i]) * 2u; } while (0)
    Unit cur, nxt; int ui = 0;
    if (!S.next(0, cur)) return;
    f32x4 acc[2][2][4][2];
#pragma unroll
    for (int a = 0; a < 2; ++a)
#pragma unroll
        for (int b = 0; b < 2; ++b)
#pragma unroll
            for (int m = 0; m < 4; ++m)
#pragma unroll
                for (int n = 0; n < 2; ++n) acc[a][b][m][n] = (f32x4){0.f, 0.f, 0.f, 0.f};
    bf16x8 At[4][2], B0[2][2], B1[2][2];
    const int sclW = W8_E8M0, sclA = A8_E8M0;
    unsigned vA[2][2], vN[2][2];
    PG8_AOFF(vA, cur);
    const char* const cA = (const char*)A;
    const char* cB = (const char*)Bt + S.b_off(cur) * 2;
    PG8_STAGE(PG8_SB(0, 0), cB, voffB[0], voffB[1]); PG8_STAGE(PG8_SB(0, 1), cB + hstep, voffB[0], voffB[1]); PG8_STAGE(PG8_SA(0, 0), cA, vA[0][0], vA[0][1]); PG8_STAGE(PG8_SA(0, 1), cA, vA[1][0], vA[1][1]);
    if (wr == 1) PG8_BAR;
    PG8_WAIT_V(2); PG8_BAR;
    PG8_STAGE(PG8_SB(1, 0), cB + kstep, voffB[0], voffB[1]); PG8_STAGE(PG8_SA(1, 0), cA + kstep, vA[0][0], vA[0][1]); PG8_STAGE(PG8_SB(1, 1), cB + hstep + kstep, voffB[0], voffB[1]);
    PG8_WAIT_V(6); PG8_BAR;
    for (;;) {
        const bool has_next = S.next(ui + 1, nxt);
        const char* nB = cB;
        E.prefetch(cur, (unsigned)__builtin_amdgcn_readfirstlane((int)((unsigned)(uintptr_t)lds + (unsigned)(EPI_LDS_OFF - 0) + (unsigned)((ui & 1) * EPI_LDS_BUF))), wid, lane);
        if (has_next) { nB = (const char*)Bt + S.b_off(nxt) * 2;
#pragma unroll
            for (int h = 0; h < 2; ++h)
#pragma unroll
                for (int i = 0; i < 2; ++i) { if constexpr (Sched::ASYNC_ROWS) vN[h][i] = S.a_row_async(nxt, h * HALF + sR[i]);
                                              else vN[h][i] = (S.a_row(nxt, h * HALF + sR[i]) * (unsigned)K + (unsigned)sC[i]) * 2u; } }
        else {
#pragma unroll
            for (int h = 0; h < 2; ++h)
#pragma unroll
                for (int i = 0; i < 2; ++i) vN[h][i] = vA[h][i]; }
#pragma clang loop unroll(disable)
        for (int t = 0; t < nt; t += 2) {
            const bool last = (t == nt - 2);
            const char* a1 = cA + (size_t)(t + 1) * kstep;
            const char* a2 = last ? cA : cA + (size_t)(t + 2) * kstep; const char* b2 = last ? nB : cB + (size_t)(t + 2) * kstep;
            const char* a3 = a2 + kstep; const char* b3 = b2 + kstep;
            if constexpr (Sched::ASYNC_ROWS) { if (last && has_next) { asm volatile("" : "+v"(vN[0][0]), "+v"(vN[0][1]), "+v"(vN[1][0]), "+v"(vN[1][1]));
#pragma unroll
                for (int h = 0; h < 2; ++h)
#pragma unroll
                    for (int i = 0; i < 2; ++i) vN[h][i] = (vN[h][i] * (unsigned)K + (unsigned)sC[i]) * 2u; } }
            const unsigned w00 = last ? vN[0][0] : vA[0][0], w01 = last ? vN[0][1] : vA[0][1], w10 = last ? vN[1][0] : vA[1][0], w11 = last ? vN[1][1] : vA[1][1];
            PG8_LDB(B0, 0, 0); PG8_LDB(B1, 0, 1); PG8_SCHED; PG8_LDA(At, 0, 0); PG8_STAGE(PG8_SA(1, 1), a1, vA[1][0], vA[1][1]);
            PG8_WAIT_V(8); PG8_WAIT_L(0); PG8_BAR; PG8_MMA(0, 0, At, B0); PG8_MMA(0, 1, At, B1); PG8_BAR; PG8_SCHED;
            PG8_LDA(At, 0, 1); PG8_STAGE(PG8_SB(0, 0), b2, voffB[0], voffB[1]); PG8_STAGE(PG8_SB(0, 1), b2 + hstep, voffB[0], voffB[1]); PG8_STAGE(PG8_SA(0, 0), a2, w00, w01);
            PG8_WAIT_V(8); PG8_WAIT_L(0); PG8_BAR; PG8_MMA(1, 0, At, B0); PG8_MMA(1, 1, At, B1); PG8_BAR; PG8_SCHED;
            PG8_LDB(B0, 1, 0); PG8_LDB(B1, 1, 1); PG8_SCHED; PG8_LDA(At, 1, 0); PG8_STAGE(PG8_SA(0, 1), a2, w10, w11);
            PG8_WAIT_V(8); PG8_WAIT_L(0); PG8_BAR; PG8_MMA(0, 0, At, B0); PG8_MMA(0, 1, At, B1); PG8_BAR; PG8_SCHED;
            PG8_LDA(At, 1, 1); PG8_STAGE(PG8_SB(1, 0), b3, voffB[0], voffB[1]); PG8_STAGE(PG8_SB(1, 1), b3 + hstep, voffB[0], voffB[1]); PG8_STAGE(PG8_SA(1, 0), a3, w00, w01);
            PG8_WAIT_V(8); PG8_WAIT_L(0); PG8_BAR; PG8_MMA(1, 0, At, B0); PG8_MMA(1, 1, At, B1); PG8_BAR; PG8_SCHED;
        }
        if constexpr (FP8) asm volatile("s_nop 15\n\ts_nop 15" ::: "memory");
        if constexpr (ALIGN_EPI) { if (wr == 0) PG8_BAR; }
        { int fr_ = fr, fq_ = fq; asm volatile("" : "+v"(fr_), "+v"(fq_)); E(acc, cur, wr, wc, fr_, fq_, lds + EPI_LDS_OFF + (ui & 1) * EPI_LDS_BUF); }
        if (!has_next) break;
#pragma unroll
        for (int a = 0; a < 2; ++a)
#pragma unroll
            for (int b = 0; b < 2; ++b)
#pragma unroll
                for (int m = 0; m < 4; ++m)
#pragma unroll
                    for (int n = 0; n < 2; ++n) acc[a][b][m][n] = (f32x4){0.f, 0.f, 0.f, 0.f};
        cur = nxt; cB = nB; ++ui;
#pragma unroll
        for (int h = 0; h < 2; ++h)
#pragma unroll
            for (int i = 0; i < 2; ++i) vA[h][i] = vN[h][i];
        if constexpr (ALIGN_EPI) { if (wr == 1) PG8_BAR; }
    }
    PG8_WAIT_V(0);
    if constexpr (!ALIGN_EPI) { if (wr == 0) PG8_BAR; }
    PG8_BAR;
#undef PG8_SA
#undef PG8_SB
#undef PG8_STAGE
#undef PG8_LDA
#undef PG8_LDB
#undef PG8_MMA
#undef PG8_WAIT_V
#undef PG8_WAIT_L
#undef PG8_BAR
#undef PG8_SCHED
#undef PG8_AOFF
#undef PG8_CAT
}
}

namespace att {
constexpr int QBLK = 32, KVBLK = 64;
constexpr float SCALE = 0.125f;
constexpr float THR = 8.f;
constexpr int SHM_V = KVBLK * 128 * 2, SHM_K = KVBLK * 128 * 2;
constexpr int LDS_WSF = 2 * SHM_V + 2 * SHM_K;
#define KSWZ(row, colB) ((row) * 256 + ((colB) ^ (((row) & 7) << 4)))
#define SBAR() __builtin_amdgcn_sched_barrier(0)
__device__ __forceinline__ int crow(int r, int hi) { return (r & 3) + 8 * (r >> 2) + 4 * hi; }

__device__ __forceinline__ void qkt(f32x16& p0, f32x16& p1, const char* Ks, const bf16x8* qr, int r32, int hi, int cq) {
  p0 = f32x16{}; p1 = f32x16{};
#pragma unroll
  for (int d0 = 0; d0 < 4; ++d0) { const int cb = (cq * 64 + d0 * 16 + hi * 8) * 2;
    const bf16x8 b0 = *reinterpret_cast<const bf16x8*>(Ks + KSWZ(r32, cb));
    const bf16x8 b1 = *reinterpret_cast<const bf16x8*>(Ks + KSWZ(32 + r32, cb));
    p0 = __builtin_amdgcn_mfma_f32_32x32x16_bf16(b0, qr[d0], p0, 0, 0, 0);
    p1 = __builtin_amdgcn_mfma_f32_32x32x16_bf16(b1, qr[d0], p1, 0, 0, 0); }
}
__device__ __forceinline__ int v_st(int k, int c) { const int kk = (k & ~0xC) | ((k & 4) << 1) | ((k & 8) >> 1); return ((kk >> 3) * 4 + (c >> 5)) * 512 + ((kk & 7) * 32 + (c & 31)) * 2; }
__device__ __forceinline__ int v_rd_base(int lane) { return ((lane & 3) << 3) | (((lane >> 2) & 3) << 6) | (((lane >> 4) & 1) << 5) | (((lane >> 5) & 1) << 8); }
constexpr int v_rd_off(int d0, int ks, int half) { return d0 * 512 + ks * 4096 + half * 2048; }
template <int OFF> __device__ __forceinline__ s16x4 tr_read(int vb) {
  s16x4 r; asm volatile("ds_read_b64_tr_b16 %0, %1 offset:%2" : "=&v"(r) : "v"(vb), "i"(OFF) : "memory"); return r;
}
template <int D0> __device__ __forceinline__ void pv_one(f32x16& od, int vb, bf16x8 pa0, bf16x8 pa1, bf16x8 pa2, bf16x8 pa3) {
  const s16x4 l0 = tr_read<v_rd_off(D0, 0, 0)>(vb), h0 = tr_read<v_rd_off(D0, 0, 1)>(vb), l1 = tr_read<v_rd_off(D0, 1, 0)>(vb), h1 = tr_read<v_rd_off(D0, 1, 1)>(vb);
  const s16x4 l2 = tr_read<v_rd_off(D0, 2, 0)>(vb), h2 = tr_read<v_rd_off(D0, 2, 1)>(vb), l3 = tr_read<v_rd_off(D0, 3, 0)>(vb), h3 = tr_read<v_rd_off(D0, 3, 1)>(vb);
  asm volatile("s_waitcnt lgkmcnt(0)" ::: "memory"); SBAR();
#define PK(L, H) (bf16x8){L[0], L[1], L[2], L[3], H[0], H[1], H[2], H[3]}
  od = __builtin_amdgcn_mfma_f32_32x32x16_bf16(pa0, PK(l0, h0), od, 0, 0, 0);
  od = __builtin_amdgcn_mfma_f32_32x32x16_bf16(pa1, PK(l1, h1), od, 0, 0, 0);
  od = __builtin_amdgcn_mfma_f32_32x32x16_bf16(pa2, PK(l2, h2), od, 0, 0, 0);
  od = __builtin_amdgcn_mfma_f32_32x32x16_bf16(pa3, PK(l3, h3), od, 0, 0, 0);
#undef PK
}
__device__ __forceinline__ void pv_d0(f32x16* o, int vb, bf16x8 pa0, bf16x8 pa1, bf16x8 pa2, bf16x8 pa3) {
  pv_one<0>(o[0], vb, pa0, pa1, pa2, pa3); pv_one<1>(o[1], vb, pa0, pa1, pa2, pa3); pv_one<2>(o[2], vb, pa0, pa1, pa2, pa3); pv_one<3>(o[3], vb, pa0, pa1, pa2, pa3);
}


__device__ __forceinline__ void attn_unit_pp(const bf16_t* __restrict__ Q, const bf16_t* __restrict__ Kb, const bf16_t* __restrict__ Vb, bf16_t* __restrict__ O,
                                             int qrow0, int kc0, int kl0, int NT, int h, float lam, const float* __restrict__ subg, char* lds, const int wave_in) {
  const int tid = opaque_tid(wave_in);
  const int wid = __builtin_amdgcn_readfirstlane(tid >> 6), lane = tid & 63, r32 = lane & 31, hi = lane >> 5;
  const int cq = wid >> 2, wq = wid & 3;
  char* V_lds = lds; char* K_lds = lds + 3 * SHM_V;
  float* ws = (float*)(lds + 6 * SHM_V) + wid * 64; float* li_l = ws; float* al_l = ws + 32;
  float m_reg = -1e30f, l_reg = 0; f32x16 o[4] = {}; bf16x8 qr[4];
  const bf16_t* Qw = Q + (size_t)(qrow0 + wq * QBLK + r32) * DM + h * 128 + cq * 64 + hi * 8;
#pragma unroll
  for (int d0 = 0; d0 < 4; ++d0) qr[d0] = *reinterpret_cast<const bf16x8*>(Qw + d0 * 16);
  const int vb0 = (int)(uintptr_t)V_lds + v_rd_base(lane);
  unsigned koff[2], voff[2];
#pragma unroll
  for (int i = 0; i < 2; ++i) { const int pc = 2 * wid + i;
    { const int row = 4 * pc + (lane >> 4), cpos = (lane & 15) << 4, colB = cpos ^ ((row & 7) << 4); koff[i] = (unsigned)(row * (DM * 2) + colB); }
    { const int kg = pc >> 1, cb0 = (pc & 1) * 2, sub = lane >> 5, kr = (lane & 31) >> 2, chunk = lane & 3; const int kk = kg * 8 + kr, k = (kk & ~0xC) | ((kk & 4) << 1) | ((kk & 8) >> 1), c = (cb0 + sub) * 32 + chunk * 8;
      voff[i] = (unsigned)(k * (DM * 2) + c * 2); } }
  const unsigned ldsK = (unsigned)__builtin_amdgcn_readfirstlane((int)((unsigned)(uintptr_t)K_lds + (unsigned)wid * 2048u));
  const unsigned ldsV = (unsigned)__builtin_amdgcn_readfirstlane((int)((unsigned)(uintptr_t)V_lds + (unsigned)wid * 2048u));
  const char* Kh = (const char*)(Kb + h * 128); const char* Vh = (const char*)(Vb + h * 128);
#define KROWB(j) ((size_t)((j) < 4 ? kc0 + 64 * (j) : kl0 + 64 * ((j) - 4)) * (DM * 2))
#define ISSUE_P(t, so, i) do { if ((i) < 2) { if ((t) < NT) pg8::glds16_s(Kh + KROWB(t), koff[(i) & 1], ldsK + (unsigned)(so) + (unsigned)((i) & 1) * 1024u); } \
    else { if ((t) >= 1 && (t) <= NT) pg8::glds16_s(Vh + KROWB((t) - 1), voff[(i) & 1], ldsV + (unsigned)(so) + (unsigned)((i) & 1) * 1024u); } } while (0)
#define ISSUE_L(t, so) do { const unsigned so_ = (unsigned)(so); \
    if ((t) < NT) { const char* kb_ = Kh + KROWB(t); pg8::glds16_s(kb_, koff[0], ldsK + so_); pg8::glds16_s(kb_, koff[1], ldsK + so_ + 1024u); } \
    if ((t) >= 1) { const char* vb_ = Vh + KROWB((t) - 1); pg8::glds16_s(vb_, voff[0], ldsV + so_); pg8::glds16_s(vb_, voff[1], ldsV + so_ + 1024u); } } while (0)
#define PBAR() asm volatile("s_waitcnt lgkmcnt(0)\n\ts_barrier" ::: "memory")
#define PBAR_V0() asm volatile("s_waitcnt vmcnt(0) lgkmcnt(0)\n\ts_barrier" ::: "memory")
#define PBAR_V4() asm volatile("s_waitcnt vmcnt(4) lgkmcnt(0)\n\ts_barrier" ::: "memory")
#define NEXT3(x) (((x) == 32768) ? 0 : (x) + 16384)
#define RESC(a) do { if (__any((a) < 1.f)) { if (hi == 0) al_l[r32] = (a); asm volatile("s_waitcnt lgkmcnt(0)" ::: "memory"); \
    _Pragma("unroll") for (int d = 0; d < 4; ++d) _Pragma("unroll") for (int r = 0; r < 16; ++r) o[d][r] *= al_l[crow(r, hi)]; } } while (0)
  f32x16 p0, p1; bf16x8 pa0, pa1, pa2, pa3;
  f32x16 negm = f32x16{}; asm volatile("" : "+v"(negm));
  m_reg = 0.f;
#define VRD4(L, H, D0, vb_) do { _Pragma("unroll") for (int ks_ = 0; ks_ < 4; ++ks_) { \
      asm volatile("ds_read_b64_tr_b16 %0, %1 offset:%2" : "=&v"(L[ks_]) : "v"(vb_), "i"((D0) * 512 + ks_ * 4096) : "memory"); \
      asm volatile("ds_read_b64_tr_b16 %0, %1 offset:%2" : "=&v"(H[ks_]) : "v"(vb_), "i"((D0) * 512 + ks_ * 4096 + 2048) : "memory"); } } while (0)
#define PVB(L, H, D0) do { \
      o[D0] = __builtin_amdgcn_mfma_f32_32x32x16_bf16(pa0, (bf16x8){L[0][0], L[0][1], L[0][2], L[0][3], H[0][0], H[0][1], H[0][2], H[0][3]}, o[D0], 0, 0, 0); \
      o[D0] = __builtin_amdgcn_mfma_f32_32x32x16_bf16(pa1, (bf16x8){L[1][0], L[1][1], L[1][2], L[1][3], H[1][0], H[1][1], H[1][2], H[1][3]}, o[D0], 0, 0, 0); \
      o[D0] = __builtin_amdgcn_mfma_f32_32x32x16_bf16(pa2, (bf16x8){L[2][0], L[2][1], L[2][2], L[2][3], H[2][0], H[2][1], H[2][2], H[2][3]}, o[D0], 0, 0, 0); \
      o[D0] = __builtin_amdgcn_mfma_f32_32x32x16_bf16(pa3, (bf16x8){L[3][0], L[3][1], L[3][2], L[3][3], H[3][0], H[3][1], H[3][2], H[3][3]}, o[D0], 0, 0, 0); } while (0)
#define LGK(n) do { asm volatile("s_waitcnt lgkmcnt(" #n ")" ::: "memory"); SBAR(); } while (0)
#define XFULL(so, ti, si) do { const int so_ = (so); const int vb_ = vb0 + so_; s16x4 la[4], ha[4], lb[4], hb[4]; bf16x8 kf0[4], kf1[4]; const char* Ks_ = K_lds + so_; \
      _Pragma("unroll") for (int d0 = 0; d0 < 4; ++d0) { const int cb = (cq * 64 + d0 * 16 + hi * 8) * 2; kf0[d0] = *reinterpret_cast<const bf16x8*>(Ks_ + KSWZ(r32, cb)); kf1[d0] = *reinterpret_cast<const bf16x8*>(Ks_ + KSWZ(32 + r32, cb)); } \
      asm volatile("" ::: "memory"); VRD4(la, ha, 0, vb_); \
      LGK(8);                                                             \
      p0 = __builtin_amdgcn_mfma_f32_32x32x16_bf16(kf0[0], qr[0], negm, 0, 0, 0); p1 = __builtin_amdgcn_mfma_f32_32x32x16_bf16(kf1[0], qr[0], negm, 0, 0, 0); \
      _Pragma("unroll") for (int d0 = 1; d0 < 4; ++d0) { p0 = __builtin_amdgcn_mfma_f32_32x32x16_bf16(kf0[d0], qr[d0], p0, 0, 0, 0); p1 = __builtin_amdgcn_mfma_f32_32x32x16_bf16(kf1[d0], qr[d0], p1, 0, 0, 0); } \
      SBAR(); VRD4(lb, hb, 1, vb_); LGK(8); PVB(la, ha, 0); \
      SBAR(); VRD4(la, ha, 2, vb_); LGK(8); PVB(lb, hb, 1); \
      SBAR(); VRD4(lb, hb, 3, vb_); LGK(8); PVB(la, ha, 2); \
      LGK(0); PVB(lb, hb, 3); } while (0)
#define XFIRST() do { bf16x8 kf0[4], kf1[4]; \
      _Pragma("unroll") for (int d0 = 0; d0 < 4; ++d0) { const int cb = (cq * 64 + d0 * 16 + hi * 8) * 2; kf0[d0] = *reinterpret_cast<const bf16x8*>(K_lds + KSWZ(r32, cb)); kf1[d0] = *reinterpret_cast<const bf16x8*>(K_lds + KSWZ(32 + r32, cb)); } \
      p0 = __builtin_amdgcn_mfma_f32_32x32x16_bf16(kf0[0], qr[0], negm, 0, 0, 0); p1 = __builtin_amdgcn_mfma_f32_32x32x16_bf16(kf1[0], qr[0], negm, 0, 0, 0); \
      _Pragma("unroll") for (int d0 = 1; d0 < 4; ++d0) { p0 = __builtin_amdgcn_mfma_f32_32x32x16_bf16(kf0[d0], qr[d0], p0, 0, 0, 0); p1 = __builtin_amdgcn_mfma_f32_32x32x16_bf16(kf1[d0], qr[d0], p1, 0, 0, 0); } } while (0)
#define XLAST(so) do { pv_d0(o, vb0 + (so), pa0, pa1, pa2, pa3); } while (0)
#define MX3(a, b, c) __builtin_fmaxf(__builtin_fmaxf((a), (b)), (c))
#define PK4(P, BASE, OUT) do { unsigned a0 = cvt_pk_bf16(P[BASE + 0], P[BASE + 1]), a1 = cvt_pk_bf16(P[BASE + 2], P[BASE + 3]);   \
    unsigned b0 = cvt_pk_bf16(P[BASE + 4], P[BASE + 5]), b1 = cvt_pk_bf16(P[BASE + 6], P[BASE + 7]);                              \
    auto r0 = __builtin_amdgcn_permlane32_swap(a0, b0, false, false); auto r1 = __builtin_amdgcn_permlane32_swap(a1, b1, false, false); \
    u32x4 w = {r0[0], r1[0], r0[1], r1[1]}; OUT = __builtin_bit_cast(bf16x8, w); } while (0)
#define YSOFT(FIRST) do { \
    float a_ = MX3(p0[0], p0[1], p1[0]), b_ = MX3(p0[2], p0[3], p1[1]); a_ = MX3(a_, p1[2], p1[3]); \
    _Pragma("unroll") for (int r = 4; r < 16; r += 4) { a_ = MX3(a_, p0[r], p0[r + 1]); b_ = MX3(b_, p0[r + 2], p0[r + 3]); a_ = MX3(a_, p1[r], p1[r + 1]); b_ = MX3(b_, p1[r + 2], p1[r + 3]); } \
    float rm_ = __builtin_fmaxf(a_, b_); { auto rr = __builtin_amdgcn_permlane32_swap(__float_as_uint(rm_), __float_as_uint(rm_), false, false); rm_ = __builtin_fmaxf(__uint_as_float(rr[0]), __uint_as_float(rr[1])); } \
    if ((FIRST) || __any(rm_ > 8.0f)) { const float dl_ = (FIRST) ? rm_ : __builtin_fmaxf(rm_, 0.f); m_reg += dl_; \
      _Pragma("unroll") for (int r = 0; r < 16; ++r) { p0[r] -= dl_; p1[r] -= dl_; } \
      _Pragma("unroll") for (int r = 0; r < 16; ++r) negm[r] = -m_reg; asm volatile("" : "+v"(negm)); \
      if (!(FIRST)) { const float f_ = __builtin_amdgcn_exp2f(-dl_); l_reg *= f_; RESC(f_); } } \
    _Pragma("unroll") for (int r = 0; r < 16; ++r) p0[r] = __builtin_amdgcn_exp2f(p0[r]); \
    _Pragma("unroll") for (int r = 0; r < 16; ++r) p1[r] = __builtin_amdgcn_exp2f(p1[r]); \
    float s0_ = p0[0] + p0[1], s1_ = p0[2] + p0[3], s2_ = p1[0] + p1[1], s3_ = p1[2] + p1[3]; \
    _Pragma("unroll") for (int r = 4; r < 16; r += 4) { s0_ += p0[r] + p0[r + 1]; s1_ += p0[r + 2] + p0[r + 3]; s2_ += p1[r] + p1[r + 1]; s3_ += p1[r + 2] + p1[r + 3]; } \
    float ps_ = (s0_ + s1_) + (s2_ + s3_); { auto rr = __builtin_amdgcn_permlane32_swap(__float_as_uint(ps_), __float_as_uint(ps_), false, false); ps_ = __uint_as_float(rr[0]) + __uint_as_float(rr[1]); } \
    l_reg += ps_; \
    PK4(p0, 0, pa0); PK4(p0, 8, pa1); PK4(p1, 0, pa2); PK4(p1, 8, pa3); } while (0)
#define YPH() YSOFT(false)
  ISSUE_L(0, 0); ISSUE_L(1, 16384); PBAR_V4();
  int sx = 16384, si = 32768;
  if (cq == 0) {
    XFIRST(); PBAR();
    ISSUE_L(2, si); si = NEXT3(si); YSOFT(true); PBAR_V4();
    for (int t = 1; t < NT; ++t) {
      XFULL(sx, 0, 0); sx = NEXT3(sx); PBAR();
      if (t + 2 <= NT) { ISSUE_L(t + 2, si); si = NEXT3(si); }
      YPH(); if (t + 2 < NT) PBAR_V4(); else PBAR_V0();
    }
    XLAST(sx); PBAR();
    PBAR();
  } else {
    __builtin_amdgcn_s_setprio(1);
    ISSUE_L(2, si); si = NEXT3(si); PBAR();
    XFIRST(); PBAR_V4();
    ISSUE_L(3, si); si = NEXT3(si); YSOFT(true); PBAR();
    XFULL(sx, 0, 0); sx = NEXT3(sx); if (3 < NT) PBAR_V4(); else PBAR_V0();
    for (int t = 2; t < NT; ++t) {
      if (t + 2 <= NT) { ISSUE_L(t + 2, si); si = NEXT3(si); }
      YPH(); PBAR();
      XFULL(sx, 0, 0); sx = NEXT3(sx); if (t + 2 < NT) PBAR_V4(); else PBAR_V0();
    }
    YPH(); PBAR();
    XLAST(sx); PBAR();
    __builtin_amdgcn_s_setprio(0);
  }
#undef XFULL
#undef XFIRST
#undef XLAST
#undef YPH
#undef YSOFT
#undef MX3
#undef PK4
#undef VRD4
#undef PVB
#undef LGK
#undef ISSUE_L
#undef KROWB
  if (hi == 0) li_l[r32] = l_reg; asm volatile("s_waitcnt lgkmcnt(0)" ::: "memory");
  float rli[16];
#pragma unroll
  for (int r = 0; r < 16; ++r) rli[r] = __builtin_amdgcn_rcpf(li_l[crow(r, hi)]);
  PBAR_V0();
  float* xb = (float*)lds + wq * (32 * 128);
  if (cq == 1) {
#pragma unroll
    for (int r = 0; r < 16; ++r)
#pragma unroll
      for (int d0 = 0; d0 < 4; ++d0) xb[crow(r, hi) * 128 + d0 * 32 + r32] = o[d0][r] * rli[r];
  }
  PBAR();
  if (cq == 0) {
    float ss[16];
#pragma unroll
    for (int r = 0; r < 16; ++r) { float s = 0.f;
#pragma unroll
      for (int d0 = 0; d0 < 4; ++d0) { const float v = o[d0][r] * rli[r] - lam * xb[crow(r, hi) * 128 + d0 * 32 + r32]; o[d0][r] = v; s += v * v; }
      ss[r] = s; }
#pragma unroll
    for (int r = 0; r < 16; ++r) { float s = half_sum32(ss[r]); ss[r] = __builtin_amdgcn_rsqf(s * (1.0f / 128.0f) + LN_EPS) * (1.0f - LAM_INIT); }
    float gsub[4];
#pragma unroll
    for (int d0 = 0; d0 < 4; ++d0) gsub[d0] = subg[d0 * 32 + r32];
    bf16_t* Ow = O + (size_t)(qrow0 + wq * QBLK) * DM + h * 128;
#pragma unroll
    for (int r = 0; r < 16; ++r) { const int orow = crow(r, hi);
#pragma unroll
      for (int d0 = 0; d0 < 4; ++d0) Ow[(size_t)orow * DM + d0 * 32 + r32] = (bf16_t)f2bf(o[d0][r] * ss[r] * gsub[d0]); }
  }
  PBAR_V0();
#undef PBAR
#undef PBAR_V0
#undef PBAR_V4
#undef NEXT3
#undef ISSUE_P
#undef RESC
}

__device__ __forceinline__ void attn_unit_f8(const bf16_t* __restrict__ Q, const bf16_t* __restrict__ Kb, const unsigned char* __restrict__ V8, bf16_t* __restrict__ O,
                                             int qrow0, int kc0, int kl0, int NT, int h, float lam, const float* __restrict__ subg, char* lds, const int wave_in) {
  const int tid = opaque_tid(wave_in);
  const int wid = __builtin_amdgcn_readfirstlane(tid >> 6), lane = tid & 63, r32 = lane & 31, hi = lane >> 5;
  const int cq = wid >> 2, wq = wid & 3;
  char* V_lds = lds; char* K_lds = lds + 24576;
  float* ws = (float*)(lds + 49152) + wid * 64; float* li_l = ws; float* al_l = ws + 32;
  float m_reg = 0.f; f32x16 o[5] = {};
  i32x8 qf;
  { const unsigned char* Qw = (const unsigned char*)Q + (size_t)(qrow0 + wq * QBLK + r32) * DM + h * 128 + cq * 64 + hi * 32;
    const u32x4 qa = *reinterpret_cast<const u32x4*>(Qw), qb = *reinterpret_cast<const u32x4*>(Qw + 16); qf = (i32x8){(int)qa.x, (int)qa.y, (int)qa.z, (int)qa.w, (int)qb.x, (int)qb.y, (int)qb.z, (int)qb.w}; }
  unsigned koff, voff;
  { const int row = 8 * wid + (lane >> 3), cpos = lane & 7;
    const int key = 16 * (row & 3) + 8 * ((row >> 2) & 1) + ((row >> 3) & 3) + 4 * (row >> 5);
    koff = (unsigned)(key * DM + 16 * (cpos ^ ((row >> 1) & 7))); }
  { const int e = 16 * wid + (lane >> 2), cpos = lane & 3; voff = (unsigned)(e * 64 + 16 * (cpos ^ ((e >> 2) & 3))); }
  const unsigned ldsK = (unsigned)__builtin_amdgcn_readfirstlane((int)((unsigned)(uintptr_t)K_lds + (unsigned)wid * 1024u));
  const unsigned ldsV = (unsigned)__builtin_amdgcn_readfirstlane((int)((unsigned)(uintptr_t)V_lds + (unsigned)wid * 1024u));
  const char* Kh = (const char*)Kb + h * 128;
  const int fsw = (r32 >> 2) & 3;
  const char* vfa = V_lds + r32 * 64 + 16 * ((2 * hi) ^ fsw); const char* vfb = V_lds + r32 * 64 + 16 * ((2 * hi + 1) ^ fsw);
#define KROWB(j) ((size_t)((j) < 4 ? kc0 + 64 * (j) : kl0 + 64 * ((j) - 4)) * DM)
#define ISSUE_L(t, sl) do { \
    if ((t) < NT) pg8::glds16_s(Kh + KROWB(t), koff, ldsK + (unsigned)(sl) * 8192u); \
    if ((t) >= 1 && (t) <= NT) pg8::glds16_s((const char*)V8 + (size_t)((t) - 1) * 8192, voff, ldsV + (unsigned)(sl) * 8192u); } while (0)
#define PBAR() asm volatile("s_waitcnt lgkmcnt(0)\n\ts_barrier" ::: "memory")
#define PBAR_V0() asm volatile("s_waitcnt vmcnt(0) lgkmcnt(0)\n\ts_barrier" ::: "memory")
#define PBAR_V3() asm volatile("s_waitcnt vmcnt(2) lgkmcnt(0)\n\ts_barrier" ::: "memory")
#define NEXT3(x) (((x) == 2) ? 0 : (x) + 1)
#define RESC(a) do { if (__any((a) < 1.f)) { if (hi == 0) al_l[r32] = (a); asm volatile("s_waitcnt lgkmcnt(0)" ::: "memory"); \
    _Pragma("unroll") for (int d = 0; d < 5; ++d) _Pragma("unroll") for (int r = 0; r < 16; ++r) o[d][r] *= al_l[crow(r, hi)]; } } while (0)
  f32x16 p0, p1; i32x8 p8 = i32x8{};
  i32x8 onesf = (i32x8){0x38383838, 0x38383838, 0x38383838, 0x38383838, 0x38383838, 0x38383838, 0x38383838, 0x38383838}; asm volatile("" : "+v"(onesf));
  f32x16 negm = f32x16{}; asm volatile("" : "+v"(negm));
  const int scl1 = 0x7F7F7F7F;
#define QKT(sl) do { const char* Ks_ = K_lds + (sl) * 8192; const int c0_ = 4 * cq + 2 * hi; \
      const u32x4 ka0 = *reinterpret_cast<const u32x4*>(Ks_ + r32 * 128 + 16 * (c0_ ^ ((r32 >> 1) & 7))), ka1 = *reinterpret_cast<const u32x4*>(Ks_ + r32 * 128 + 16 * ((c0_ + 1) ^ ((r32 >> 1) & 7))); \
      const u32x4 kb0 = *reinterpret_cast<const u32x4*>(Ks_ + (32 + r32) * 128 + 16 * (c0_ ^ ((r32 >> 1) & 7))), kb1 = *reinterpret_cast<const u32x4*>(Ks_ + (32 + r32) * 128 + 16 * ((c0_ + 1) ^ ((r32 >> 1) & 7))); \
      const i32x8 kfa_ = (i32x8){(int)ka0.x, (int)ka0.y, (int)ka0.z, (int)ka0.w, (int)ka1.x, (int)ka1.y, (int)ka1.z, (int)ka1.w}, kfb_ = (i32x8){(int)kb0.x, (int)kb0.y, (int)kb0.z, (int)kb0.w, (int)kb1.x, (int)kb1.y, (int)kb1.z, (int)kb1.w}; \
      p0 = __builtin_amdgcn_mfma_scale_f32_32x32x64_f8f6f4(kfa_, qf, negm, 0, 0, 0, scl1, 0, scl1); p1 = __builtin_amdgcn_mfma_scale_f32_32x32x64_f8f6f4(kfb_, qf, negm, 0, 0, 0, scl1, 0, scl1); } while (0)
#define PV8(sl) do { u32x4 va_[4], vb_[4]; \
      _Pragma("unroll") for (int d0 = 0; d0 < 4; ++d0) { va_[d0] = *reinterpret_cast<const u32x4*>(vfa + (sl) * 8192 + d0 * 2048); vb_[d0] = *reinterpret_cast<const u32x4*>(vfb + (sl) * 8192 + d0 * 2048); } \
      _Pragma("unroll") for (int d0 = 0; d0 < 4; ++d0) { const i32x8 vf_ = (i32x8){(int)va_[d0].x, (int)va_[d0].y, (int)va_[d0].z, (int)va_[d0].w, (int)vb_[d0].x, (int)vb_[d0].y, (int)vb_[d0].z, (int)vb_[d0].w}; \
        o[d0] = __builtin_amdgcn_mfma_scale_f32_32x32x64_f8f6f4(p8, vf_, o[d0], 0, 0, 0, scl1, 0, scl1); } \
      o[4] = __builtin_amdgcn_mfma_scale_f32_32x32x64_f8f6f4(p8, onesf, o[4], 0, 0, 0, scl1, 0, scl1); } while (0)
#define MX3(a, b, c) __builtin_fmaxf(__builtin_fmaxf((a), (b)), (c))
#define YSOFT(FIRST) do { \
    float a_ = MX3(p0[0], p0[1], p1[0]), b_ = MX3(p0[2], p0[3], p1[1]); a_ = MX3(a_, p1[2], p1[3]); \
    _Pragma("unroll") for (int r = 4; r < 16; r += 4) { a_ = MX3(a_, p0[r], p0[r + 1]); b_ = MX3(b_, p0[r + 2], p0[r + 3]); a_ = MX3(a_, p1[r], p1[r + 1]); b_ = MX3(b_, p1[r + 2], p1[r + 3]); } \
    float rm_ = __builtin_fmaxf(a_, b_); { auto rr = __builtin_amdgcn_permlane32_swap(__float_as_uint(rm_), __float_as_uint(rm_), false, false); rm_ = __builtin_fmaxf(__uint_as_float(rr[0]), __uint_as_float(rr[1])); } \
    if ((FIRST) || __any(rm_ > 8.0f)) { const float dl_ = (FIRST) ? (rm_ - 6.0f) : __builtin_fmaxf(rm_ - 6.0f, 0.f); m_reg += dl_; \
      _Pragma("unroll") for (int r = 0; r < 16; ++r) { p0[r] -= dl_; p1[r] -= dl_; } \
      _Pragma("unroll") for (int r = 0; r < 16; ++r) negm[r] = -m_reg; asm volatile("" : "+v"(negm)); \
      if (!(FIRST)) { const float f_ = __builtin_amdgcn_exp2f(-dl_); RESC(f_); } } \
    _Pragma("unroll") for (int r = 0; r < 16; ++r) p0[r] = __builtin_amdgcn_exp2f(p0[r]); \
    _Pragma("unroll") for (int r = 0; r < 16; ++r) p1[r] = __builtin_amdgcn_exp2f(p1[r]); \
    _Pragma("unroll") for (int d = 0; d < 4; ++d) { p8[d] = __builtin_amdgcn_cvt_pk_fp8_f32(p0[4 * d], p0[4 * d + 1], p8[d], false); p8[d] = __builtin_amdgcn_cvt_pk_fp8_f32(p0[4 * d + 2], p0[4 * d + 3], p8[d], true); \
      p8[4 + d] = __builtin_amdgcn_cvt_pk_fp8_f32(p1[4 * d], p1[4 * d + 1], p8[4 + d], false); p8[4 + d] = __builtin_amdgcn_cvt_pk_fp8_f32(p1[4 * d + 2], p1[4 * d + 3], p8[4 + d], true); } } while (0)
#define YPH() YSOFT(false)
  ISSUE_L(0, 0); ISSUE_L(1, 1); PBAR_V3();
  int sx = 1, si = 2;
  if (cq == 0) {
    QKT(0); ISSUE_L(2, si); si = NEXT3(si); PBAR();
    YSOFT(true); PBAR_V3();
    for (int t = 1; t < NT; ++t) {
      __builtin_amdgcn_s_setprio(1); QKT(sx); PV8(sx); sx = NEXT3(sx);
      if (t + 2 <= NT) { ISSUE_L(t + 2, si); si = NEXT3(si); }
      __builtin_amdgcn_s_setprio(0);
      PBAR();
      YPH(); if (t + 2 < NT) PBAR_V3(); else PBAR_V0();
    }
    PV8(sx); PBAR();
    PBAR();
  } else {
    ISSUE_L(2, si); si = NEXT3(si); PBAR();
    QKT(0); PBAR_V3();
    YSOFT(true); PBAR();
    __builtin_amdgcn_s_setprio(1); QKT(sx); PV8(sx); sx = NEXT3(sx); __builtin_amdgcn_s_setprio(0);
    ISSUE_L(3, si); si = NEXT3(si); if (3 < NT) PBAR_V3(); else PBAR_V0();
    for (int t = 2; t < NT; ++t) {
      YPH(); PBAR();
      __builtin_amdgcn_s_setprio(1); QKT(sx); PV8(sx); sx = NEXT3(sx);
      if (t + 2 <= NT) { ISSUE_L(t + 2, si); si = NEXT3(si); }
      __builtin_amdgcn_s_setprio(0);
      if (t + 2 < NT) PBAR_V3(); else PBAR_V0();
    }
    YPH(); PBAR();
    PV8(sx); PBAR();
  }
#undef QKT
#undef PV8
#undef YPH
#undef YSOFT
#undef MX3
#undef ISSUE_L
#undef KROWB
  float rli[16];
#pragma unroll
  for (int r = 0; r < 16; ++r) rli[r] = __builtin_amdgcn_rcpf(o[4][r]);
  PBAR_V0();
  float* xb = (float*)lds + wq * (32 * 128);
  if (cq == 1) {
#pragma unroll
    for (int r = 0; r < 16; ++r)
#pragma unroll
      for (int d0 = 0; d0 < 4; ++d0) xb[crow(r, hi) * 128 + d0 * 32 + r32] = o[d0][r] * rli[r];
  }
  PBAR();
  if (cq == 0) {
    float ss[16];
#pragma unroll
    for (int r = 0; r < 16; ++r) { float s = 0.f;
#pragma unroll
      for (int d0 = 0; d0 < 4; ++d0) { const float v = o[d0][r] * rli[r] - lam * xb[crow(r, hi) * 128 + d0 * 32 + r32]; o[d0][r] = v; s += v * v; }
      ss[r] = s; }
#pragma unroll
    for (int r = 0; r < 16; ++r) { float s = half_sum32(ss[r]); ss[r] = __builtin_amdgcn_rsqf(s * (1.0f / 128.0f) + LN_EPS) * (1.0f - LAM_INIT); }
    float gsub[4];
#pragma unroll
    for (int d0 = 0; d0 < 4; ++d0) gsub[d0] = subg[d0 * 32 + r32];
    unsigned char* Ow = (unsigned char*)O + (size_t)(qrow0 + wq * QBLK) * DM + h * 128;
#pragma unroll
    for (int r = 0; r < 16; ++r) { const int orow = crow(r, hi);
#pragma unroll
      for (int d0 = 0; d0 < 4; ++d0) Ow[(size_t)orow * DM + d0 * 32 + r32] = (unsigned char)(cvt_fp8x4(o[d0][r] * ss[r] * gsub[d0], 0.f, 0.f, 0.f) & 0xffu); }
  }
  PBAR_V0();
#undef PBAR
#undef PBAR_V0
#undef PBAR_V3
#undef NEXT3
#undef RESC
}
#undef KSWZ
#undef SBAR
}

struct Args { const float* in[27]; float* out; unsigned char* ws; };
enum { IN_X = 0, IN_C, IN_CTX, IN_CCTX, IN_WMOD, IN_BMOD, IN_LNG, IN_LNB, IN_GWIN, IN_GLNG, IN_GLNB, IN_GWS, IN_GBS, IN_GWOUT, IN_DWQKV, IN_DLAM, IN_DSUBG, IN_DWO,
       IN_CWIN, IN_CW, IN_CWOUT, IN_MWR, IN_MBR, IN_MWGU, IN_MBGU, IN_MWDN, IN_MBDN };


__device__ __forceinline__ const float* inp_ptr(int k) {
    const __attribute__((address_space(4))) char* kp = (const __attribute__((address_space(4))) char*)__builtin_amdgcn_kernarg_segment_ptr();
    asm volatile("" : "+s"(kp));
    return (const float*)*(GAS const float* const __attribute__((address_space(4)))*)(kp + 8 * k);
}
#define INP(k) inp_ptr(k)

struct Frame {
    LAS unsigned char* lds; char* ldsg;
    int tid, lane, wave, G, gw, NGW, bid, wave0;
    float* out; unsigned char* ws; gu32* ctl;
};

__device__ __forceinline__ int drow_map(int kind, int n) {
    if (kind == 1) { if (n < 1024) return 256 * (n >> 7) + (n & 127); const int ff = n - 1024; return 256 * (ff >> 7) + 128 + (ff & 127); }
    if (kind == 2) { if (n < 1024) return 2048 + n; if (n < 2048) { const int ch = n - 1024; return 256 * (ch >> 7) + (ch & 127); } const int ch = n - 2048; return 256 * (ch >> 7) + 128 + (ch & 127); }
    return n;
}
template <bool FP8> __device__ __forceinline__ void p0_transpose_item(const float* W, int K, int N, bf16_t* WT, int kind, LAS float* scr, int item, int lane) {
    const int nblk = N / 32, kb = item / nblk, nb = item % nblk, k0 = 64 * kb, n0 = 32 * nb;
#pragma unroll 8
    for (int i = 0; i < 32; ++i) { const int kk = 2 * i + (lane >> 5); scr[kk * 33 + (lane & 31)] = __builtin_nontemporal_load(&W[(size_t)(k0 + kk) * N + n0 + (lane & 31)]); }
    LDS_WAIT(); asm volatile("" ::: "memory");
    const int c = lane & 7; const int d0 = drow_map(kind, n0);
#pragma unroll
    for (int j = 0; j < 4; ++j) { const int n = (lane >> 3) + 8 * j; const LAS float* s = scr + (8 * c) * 33 + n;
        if (FP8) { u32x2 o; o.x = cvt_fp8x4(s[0 * 33] * W8_SCALE, s[1 * 33] * W8_SCALE, s[2 * 33] * W8_SCALE, s[3 * 33] * W8_SCALE); o.y = cvt_fp8x4(s[4 * 33] * W8_SCALE, s[5 * 33] * W8_SCALE, s[6 * 33] * W8_SCALE, s[7 * 33] * W8_SCALE);
            *(GAS u32x2*)((unsigned char*)WT + (size_t)(d0 + n) * K + k0 + 8 * c) = o; }
        else { u32x4 o; o.x = pk2(s[0 * 33], s[1 * 33]); o.y = pk2(s[2 * 33], s[3 * 33]); o.z = pk2(s[4 * 33], s[5 * 33]); o.w = pk2(s[6 * 33], s[7 * 33]);
            *(GAS u32x4*)(WT + (size_t)(d0 + n) * K + k0 + 8 * c) = o; } }
    LDS_WAIT(); asm volatile("" ::: "memory");
}
template <bool FP8> __device__ __forceinline__ void p0_job(Frame& F, LAS float* scr, long& base, const float* src, int K, int N, int M, bf16_t* dst, int ND, int kind) {
    const int per = (K / 64) * (N / 32); const long tot = (long)per * M;
    long first = (long)F.gw - (base % F.NGW); if (first < 0) first += F.NGW;
    for (long it = first; it < tot; it += F.NGW) { const int mtx = (int)(it / per), loc = (int)(it % per);
        p0_transpose_item<FP8>(src + (size_t)mtx * K * N, K, N, (bf16_t*)((unsigned char*)dst + (size_t)mtx * ND * K * (FP8 ? 1 : 2)), kind, scr, loc, F.lane); }
    base += tot;
}
__device__ __forceinline__ void p0_weights(Frame& F) {
    LAS float* scr = (LAS float*)(F.lds + F.wave * 16384);
    long base = 0;
    p0_job<true>(F, scr, base, INP(IN_GWIN), 1024, 4096, 2, (bf16_t*)(F.ws + WS_WIN), 4096, 0);
    p0_job<false>(F, scr, base, INP(IN_GWOUT), 2048, 1024, 2, (bf16_t*)(F.ws + WS_WOUT), 1024, 0);
    p0_job<true>(F, scr, base, INP(IN_DWQKV), 1024, 3072, 1, (bf16_t*)(F.ws + WS_WQKV), 3072, 0);
    p0_job<true>(F, scr, base, INP(IN_DWO), 1024, 1024, 1, (bf16_t*)(F.ws + WS_WO), 1024, 0);
    p0_job<false>(F, scr, base, INP(IN_CWIN), 1024, 3072, 1, (bf16_t*)(F.ws + WS_CWIN), 3072, 2);
    p0_job<false>(F, scr, base, INP(IN_CWOUT), 1024, 1024, 1, (bf16_t*)(F.ws + WS_CWOUT), 1024, 0);
    p0_job<false>(F, scr, base, INP(IN_MWR), 1024, 32, 4, (bf16_t*)(F.ws + WS_WR), 256, 0);
    p0_job<true>(F, scr, base, INP(IN_MWGU), 1024, 2048, 128, (bf16_t*)(F.ws + WS_WGU), 2048, 1);
    p0_job<true>(F, scr, base, INP(IN_MWDN), 1024, 1024, 128, (bf16_t*)(F.ws + WS_WDN), 1024, 0);
    { const float* src = INP(IN_GWS); bf16_t* dst = (bf16_t*)(F.ws + WS_WS); const int n4 = 2 * 8 * 128 * 128 / 4;
      for (int i = F.gw * 64 + F.lane; i < n4; i += F.NGW * 64) { const f32x4 v = *(const f32x4*)(src + 4 * (size_t)i); u32x2 w; w.x = pk2(v[0], v[1]); w.y = pk2(v[2], v[3]); *(u32x2*)(dst + 4 * (size_t)i) = w; } }
}
__device__ __forceinline__ void p0_mod(Frame& F) {
    LAS float* cond = (LAS float*)(F.lds);
    LAS float* red = (LAS float*)(F.lds + 40960);
    const int nitem = 4 * 96;
    if (F.bid >= nitem) return;
    for (int i = F.tid; i < 9 * 1024; i += 512) { const int m = i >> 10, k = i & 1023; const float c = (m < 8) ? INP(IN_C)[m * 1024 + k] : INP(IN_CCTX)[k]; cond[i] = c / (1.0f + __expf(-c)); }
    __syncthreads();
    float* MOD = (float*)(F.ws + WS_MOD);
    for (int it = F.bid; it < nitem; it += F.G) {
        const int layer = it / 96, n0 = (it % 96) * 64;
        const float* W = INP(IN_WMOD) + (size_t)layer * 1024 * 6144 + n0 + F.lane;
        float acc[9];
#pragma unroll
        for (int m = 0; m < 9; ++m) acc[m] = 0.f;
        const int kb = F.wave * 128;
#pragma unroll 8
        for (int k = 0; k < 128; ++k) { const float w = W[(size_t)(kb + k) * 6144];
#pragma unroll
            for (int m = 0; m < 9; ++m) acc[m] += cond[m * 1024 + kb + k] * w; }
#pragma unroll
        for (int m = 0; m < 9; ++m) red[(F.wave * 9 + m) * 64 + F.lane] = acc[m];
        __syncthreads();
        for (int i = F.tid; i < 9 * 64; i += 512) { const int m = i >> 6, l = i & 63; float s = 0.f;
#pragma unroll
            for (int w = 0; w < 8; ++w) s += red[(w * 9 + m) * 64 + l];
            MOD[((size_t)layer * 9 + m) * 6144 + n0 + l] = s + INP(IN_BMOD)[layer * 6144 + n0 + l]; }
        __syncthreads();
    }
}
__device__ __forceinline__ void p0_misc(Frame& F) {
    const int gt = F.bid * 512 + F.tid;
    if (gt < 2048) { const int pos = gt >> 4, i = gt & 15; const float inv = powf(10000.0f, -(float)i / 16.0f); const float ang = (float)pos * inv; float s, c; sincosf(ang, &s, &c);
        ((float*)(F.ws + WS_ROPE))[gt] = c; ((float*)(F.ws + WS_ROPE))[2048 + gt] = s; }
    if (F.bid == F.G - 1) { bf16_t* H = (bf16_t*)(F.ws + WS_H); for (int i = F.tid; i < 1024; i += 512) H[(size_t)TALL * DM + i] = 0;
        unsigned* H8z = (unsigned*)(F.ws + WS_H8 + (size_t)TALL * DM); for (int i = F.tid; i < 256; i += 512) H8z[i] = 0u; }
}

__device__ __forceinline__ int mod_index(int row) { return row < NCTX ? 8 : ((row - NCTX) >> 13); }

template <int MODE, bool FIRSTX>
__device__ __forceinline__ void row_pass(Frame& F, int layer, bool final_out, int row0) {
    const float* MOD = (const float*)(F.ws + WS_MOD);
    bf16_t* X = (bf16_t*)(F.ws + WS_X); bf16_t* H = (bf16_t*)(F.ws + WS_H);
    const bf16_t* Y = (const bf16_t*)(F.ws + WS_Y); const bf16_t* YK = (const bf16_t*)(F.ws + WS_R1 + R1_YK); const int* TS = (const int*)(F.ws + WS_SLOTDST);
    const int rpw = (TALL - row0 + F.NGW - 1) / F.NGW;
    const int r0 = row0 + F.gw * rpw, r1 = (r0 + rpw < TALL) ? r0 + rpw : TALL;
    const int sub = (MODE == 2) ? 1 : 0;
    const int gate_i = (MODE == 2) ? 5 : 2;
    const int nlayer = (MODE == 2) ? layer + 1 : layer;
    const int sh_i = (MODE == 1) ? 3 : 0, sc_i = (MODE == 1) ? 4 : 1;
    const int lc = 8 * F.lane;
#define RP_COL(q) (lc + 512 * ((q) >> 1) + 4 * ((q) & 1))
    f32x4 lg[4], lb[4], gt[4], sh[4], sc[4];
    if (MODE != 0) {
#pragma unroll
        for (int q = 0; q < 4; ++q) { lg[q] = *(const f32x4*)(INP(IN_LNG) + (layer * 2 + sub) * 1024 + RP_COL(q)); lb[q] = *(const f32x4*)(INP(IN_LNB) + (layer * 2 + sub) * 1024 + RP_COL(q)); } }
    constexpr int NY = (MODE == 2) ? 4 : (MODE == 1 ? 1 : 0);
    f32x4 xf[4], xfn[4]; u32x4 xb[2], xbn[2]; u32x4 yb[NY ? NY : 1][2], ybn[NY ? NY : 1][2];
#define RP_LOAD(row_, XF, XB, YB) do { const int rw_ = (row_); \
        if (FIRSTX) { const float* xr_ = (rw_ < NCTX ? INP(IN_CTX) + (size_t)rw_ * DM : INP(IN_X) + (size_t)(rw_ - NCTX) * DM); _Pragma("unroll") for (int q = 0; q < 4; ++q) XF[q] = *(const f32x4*)(xr_ + RP_COL(q)); } \
        else { _Pragma("unroll") for (int j = 0; j < 2; ++j) XB[j] = *(const u32x4*)(X + (size_t)rw_ * DM + lc + 512 * j); } \
        if (MODE == 1) { _Pragma("unroll") for (int j = 0; j < 2; ++j) YB[0][j] = *(const u32x4*)(Y + (size_t)rw_ * DM + lc + 512 * j); } \
        if (MODE == 2) { const int4 sl_ = *(const int4*)(TS + (size_t)rw_ * 4); const int sk_[4] = {sl_.x, sl_.y, sl_.z, sl_.w}; \
            _Pragma("unroll") for (int k = 0; k < 4; ++k) _Pragma("unroll") for (int j = 0; j < 2; ++j) { const u32x2 t8_ = *(const u32x2*)((const unsigned char*)YK + (size_t)sk_[k] * DM + lc + 512 * j); YB[k][j] = (u32x4){t8_.x, t8_.y, 0u, 0u}; } } } while (0)
#define RP_UNPK(V_, H_) ((H_) ? (f32x4){bflo((V_)[2]), bfhi((V_)[2]), bflo((V_)[3]), bfhi((V_)[3])} : (f32x4){bflo((V_)[0]), bfhi((V_)[0]), bflo((V_)[1]), bfhi((V_)[1])})
    if (r0 < r1) RP_LOAD(r0, xf, xb, yb);
    int curm = -1;
    for (int row = r0; row < r1; ++row) {
        if (row + 1 < r1) RP_LOAD(row + 1, xfn, xbn, ybn);
        const int mi = mod_index(row);
        if (mi != curm) { curm = mi;
#pragma unroll
            for (int q = 0; q < 4; ++q) { const int c = RP_COL(q);
                if (MODE != 0) gt[q] = *(const f32x4*)(MOD + ((size_t)layer * 9 + mi) * 6144 + gate_i * 1024 + c);
                if (!final_out) { sh[q] = *(const f32x4*)(MOD + ((size_t)nlayer * 9 + mi) * 6144 + sh_i * 1024 + c); sc[q] = *(const f32x4*)(MOD + ((size_t)nlayer * 9 + mi) * 6144 + sc_i * 1024 + c); } } }
        f32x4 v[4];
#pragma unroll
        for (int q = 0; q < 4; ++q) v[q] = FIRSTX ? xf[q] : RP_UNPK(xb[q >> 1], q & 1);
        if (MODE != 0) {
#pragma unroll
            for (int q = 0; q < 4; ++q) { f32x4 y = (f32x4){0.f, 0.f, 0.f, 0.f};
#pragma unroll
                for (int k = 0; k < NY; ++k) { if (MODE == 2) { const unsigned w8 = yb[k][q >> 1][q & 1]; const f32x2 lo = __builtin_amdgcn_cvt_pk_f32_fp8((int)w8, false), hi = __builtin_amdgcn_cvt_pk_f32_fp8((int)w8, true); y += (f32x4){lo.x, lo.y, hi.x, hi.y}; }
                                                else y += RP_UNPK(yb[k][q >> 1], q & 1); }
                if (MODE == 2) y = y * (1.0f / YK8_SCALE);
                v[q] = v[q] * DN_ALPHA + gt[q] * y; }
            float s = 0.f;
#pragma unroll
            for (int q = 0; q < 4; ++q) s += (v[q][0] + v[q][1]) + (v[q][2] + v[q][3]);
            const float mean = wave_sum(s) * (1.0f / DM); float qq = 0.f;
#pragma unroll
            for (int q = 0; q < 4; ++q) { v[q] = v[q] - mean; qq += (v[q][0] * v[q][0] + v[q][1] * v[q][1]) + (v[q][2] * v[q][2] + v[q][3] * v[q][3]); }
            const float rstd = 1.0f / sqrtf(wave_sum(qq) * (1.0f / DM) + LN_EPS);
#pragma unroll
            for (int q = 0; q < 4; ++q) v[q] = v[q] * rstd * lg[q] + lb[q];
            if (final_out) { if (row >= NCTX) {
#pragma unroll
                for (int q = 0; q < 4; ++q) *(f32x4*)(F.out + (size_t)(row - NCTX) * DM + RP_COL(q)) = v[q]; } }
            else {
#pragma unroll
                for (int j = 0; j < 2; ++j) { u32x4 w; w.x = pk2(v[2 * j][0], v[2 * j][1]); w.y = pk2(v[2 * j][2], v[2 * j][3]); w.z = pk2(v[2 * j + 1][0], v[2 * j + 1][1]); w.w = pk2(v[2 * j + 1][2], v[2 * j + 1][3]);
                    *(u32x4*)(X + (size_t)row * DM + lc + 512 * j) = w; } }
        }
        if (!final_out) {
#pragma unroll
            for (int j = 0; j < 2; ++j) { const f32x4 h0 = v[2 * j] * (sc[2 * j] + 1.0f) + sh[2 * j], h1 = v[2 * j + 1] * (sc[2 * j + 1] + 1.0f) + sh[2 * j + 1];
                if (MODE == 1 || (nlayer % 3) == 2) { u32x4 w; w.x = pk2(h0[0], h0[1]); w.y = pk2(h0[2], h0[3]); w.z = pk2(h1[0], h1[1]); w.w = pk2(h1[2], h1[3]);
                    *(u32x4*)(H + (size_t)row * DM + lc + 512 * j) = w; }
                if (MODE == 1 || (nlayer % 3) != 2) {                                u32x2 w8; w8.x = cvt_fp8x4(h0[0], h0[1], h0[2], h0[3]); w8.y = cvt_fp8x4(h1[0], h1[1], h1[2], h1[3]); *(u32x2*)(F.ws + WS_H8 + (size_t)row * DM + lc + 512 * j) = w8; } }
        }
#pragma unroll
        for (int q = 0; q < 4; ++q) xf[q] = xfn[q];
#pragma unroll
        for (int j = 0; j < 2; ++j) { xb[j] = xbn[j];
#pragma unroll
            for (int k = 0; k < (NY ? NY : 1); ++k) yb[k][j] = ybn[k][j]; }
    }
#undef RP_LOAD
#undef RP_UNPK
#undef RP_COL
}


__device__ __forceinline__ void gmlp_spatial_fused(Frame& F, int j, int row0) {
    const bf16_t* Z = (const bf16_t*)(F.ws + WS_R1 + R1_Z); const float* PART = (const float*)(F.ws + WS_PART); bf16_t* T = (bf16_t*)(F.ws + WS_R1 + R1_T);
    LAS f32x2* stl = (LAS f32x2*)(F.lds + MISC_OFF + 1024);
    LAS float* bsl = (LAS float*)(F.lds + MISC_OFF + 2048);
    const bf16_t* WSb = (const bf16_t*)(F.ws + WS_WS) + (size_t)j * 8 * 128 * 128; const float* bs = INP(IN_GBS) + j * 8 * 128;
    const float* lng = INP(IN_GLNG) + j * 2048; const float* lnb = INP(IN_GLNB) + j * 2048;
    const int wave = F.wave;
    char* lds = F.ldsg; bf16_t* outl = (bf16_t*)lds; char* wl = lds + 65536;
    const int nunit = ((TALL - row0) / 128) * 8, ch0 = row0 / 128;
#define WSWZ(row, colB) ((row) * 256 + ((colB) ^ (((row) & 7) << 4)))
    const unsigned wlds = (unsigned)__builtin_amdgcn_readfirstlane((int)((unsigned)(uintptr_t)wl + (unsigned)wave * 4096u));
    const int ehalf = wave >> 2, d0 = wave & 3;
    u32x4 zin[8]; f32x4 pin[4];
    int u = F.bid;
#define SP_LANE() const int tid = opaque_tid(wave), lane = tid & 63, r32 = lane & 31, hi = lane >> 5, c8 = tid & 31, q0 = tid >> 5
#define SP_LOAD(uu) do { const int ch_ = ch0 + ((uu) >> 3), g_ = (uu) & 7; _Pragma("unroll") for (int i = 0; i < 8; ++i) zin[i] = *(const u32x4*)(Z + (size_t)(ch_ * 128 + q0 + 16 * i) * 4096 + 2048 + 256 * g_ + 8 * c8); \
        _Pragma("unroll") for (int i = 0; i < 4; ++i) pin[i] = *(const f32x4*)(PART + ((size_t)(ch_ * 128 + (tid >> 2)) * 32 + 8 * (tid & 3)) * 2 + 4 * i); } while (0)
    if (u < nunit) { SP_LANE(); SP_LOAD(u); }
    for (; u < nunit; u += F.G) {
        const int chunk = ch0 + (u >> 3), g = u & 7;
        SP_LANE();
        const int vb = (int)(uintptr_t)lds + ehalf * 16384 + d0 * 512 + att::v_rd_base(lane);
        unsigned woff[4];
#pragma unroll
        for (int i = 0; i < 4; ++i) { const int row = 4 * (4 * wave + i) + (lane >> 4), cpos = (lane & 15) << 4; woff[i] = (unsigned)(row * 256 + (cpos ^ ((row & 7) << 4))); }
        int sto[8];
#pragma unroll
        for (int i = 0; i < 8; ++i) { const int q = q0 + 16 * i, e = 8 * c8; sto[i] = ((q >> 6) * 2 + (e >> 7)) * 16384 + att::v_st(q & 63, e & 127); }
        if (tid < 128) bsl[tid] = bs[g * 128 + tid];
        { const char* wg = (const char*)(WSb + (size_t)g * 128 * 128);
#pragma unroll
          for (int i = 0; i < 4; ++i) pg8::glds16_s(wg, woff[i], wlds + (unsigned)i * 1024u); }
        { float sm = (pin[0][0] + pin[0][2]) + (pin[1][0] + pin[1][2]) + (pin[2][0] + pin[2][2]) + (pin[3][0] + pin[3][2]), sq = (pin[0][1] + pin[0][3]) + (pin[1][1] + pin[1][3]) + (pin[2][1] + pin[2][3]) + (pin[3][1] + pin[3][3]);
          sm += swz_xor_f<1>(sm); sq += swz_xor_f<1>(sq); sm += swz_xor_f<2>(sm); sq += swz_xor_f<2>(sq);
          const float mean = sm * (1.0f / 2048.0f), var = __builtin_fmaxf(sq * (1.0f / 2048.0f) - mean * mean, 0.f);
          if ((tid & 3) == 0) stl[tid >> 2] = (f32x2){mean, 1.0f / sqrtf(var + LN_EPS)}; }
        asm volatile("s_waitcnt lgkmcnt(0)" ::: "memory");
        __syncthreads();
        { const f32x4 ga = *(const f32x4*)(lng + 256 * g + 8 * c8), gb = *(const f32x4*)(lng + 256 * g + 8 * c8 + 4), ba = *(const f32x4*)(lnb + 256 * g + 8 * c8), bb = *(const f32x4*)(lnb + 256 * g + 8 * c8 + 4);
#pragma unroll
          for (int i = 0; i < 8; ++i) { const f32x2 st = stl[q0 + 16 * i]; const u32x4 w = zin[i];
              f32x4 x0 = (f32x4){bflo(w.x), bfhi(w.x), bflo(w.y), bfhi(w.y)}, x1 = (f32x4){bflo(w.z), bfhi(w.z), bflo(w.w), bfhi(w.w)};
              x0 = (x0 - st.x) * st.y * ga + ba; x1 = (x1 - st.x) * st.y * gb + bb;
              *(u32x4*)(lds + sto[i]) = pg8::pack8(x0, x1); } }
        asm volatile("s_waitcnt vmcnt(0) lgkmcnt(0)" ::: "memory");
        __syncthreads();
        const int un = u + F.G;
        u32x4 uin[8];
#pragma unroll
        for (int i = 0; i < 8; ++i) uin[i] = *(const u32x4*)(Z + ((size_t)chunk * 128 + q0 + 16 * i) * 4096 + 256 * g + 8 * c8);
        if (un < nunit) SP_LOAD(un);
        f32x16 acc[4];
#pragma unroll
        for (int mt = 0; mt < 4; ++mt) acc[mt] = f32x16{};
#define SP_KS(QH, KS) do { s16x4 l_, h_; \
            asm volatile("ds_read_b64_tr_b16 %0, %1 offset:%2" : "=&v"(l_) : "v"(vb), "i"((QH) * 32768 + (KS) * 4096) : "memory"); \
            asm volatile("ds_read_b64_tr_b16 %0, %1 offset:%2" : "=&v"(h_) : "v"(vb), "i"((QH) * 32768 + (KS) * 4096 + 2048) : "memory"); \
            bf16x8 af_[4]; _Pragma("unroll") for (int mt = 0; mt < 4; ++mt) af_[mt] = *(const bf16x8*)(wl + WSWZ(32 * mt + r32, (16 * ((QH) * 4 + (KS)) + 8 * hi) * 2)); \
            asm volatile("s_waitcnt lgkmcnt(0)" ::: "memory"); __builtin_amdgcn_sched_barrier(0); \
            const bf16x8 bf_ = (bf16x8){l_[0], l_[1], l_[2], l_[3], h_[0], h_[1], h_[2], h_[3]}; \
            _Pragma("unroll") for (int mt = 0; mt < 4; ++mt) acc[mt] = __builtin_amdgcn_mfma_f32_32x32x16_bf16(af_[mt], bf_, acc[mt], 0, 0, 0); } while (0)
        SP_KS(0, 0); SP_KS(0, 1); SP_KS(0, 2); SP_KS(0, 3); SP_KS(1, 0); SP_KS(1, 1); SP_KS(1, 2); SP_KS(1, 3);
#undef SP_KS
        asm volatile("s_waitcnt lgkmcnt(0)" ::: "memory");
        __syncthreads();
        { const int e = 32 * wave + r32;
#pragma unroll
          for (int mt = 0; mt < 4; ++mt)
#pragma unroll
            for (int r = 0; r < 16; ++r) { const int p = 32 * mt + att::crow(r, hi); outl[p * 256 + e] = (bf16_t)f2bf(acc[mt][r] + bsl[p]); } }
        asm volatile("s_waitcnt lgkmcnt(0)" ::: "memory");
        __syncthreads();
#pragma unroll
        for (int i = 0; i < 8; ++i) { const int p = q0 + 16 * i; const size_t row = (size_t)chunk * 128 + p;
            const u32x4 o = *(const u32x4*)(outl + p * 256 + 8 * c8); const u32x4 uu = uin[i];
            u32x4 t;
#pragma unroll
            for (int e = 0; e < 4; ++e) t[e] = pk2(bflo(o[e]) * bflo(uu[e]), bfhi(o[e]) * bfhi(uu[e]));
            *(u32x4*)(T + row * 2048 + 256 * g + 8 * c8) = t; }
    }
#undef SP_LOAD
#undef SP_LANE
#undef WSWZ
    asm volatile("s_waitcnt lgkmcnt(0)" ::: "memory");
    __syncthreads();
}
__device__ __forceinline__ void conv_mix(Frame& F, int row0) {
    const bf16_t* P = (const bf16_t*)(F.ws + WS_R1 + R1_P); const bf16_t* BG = (const bf16_t*)(F.ws + WS_R1 + R1_BG); bf16_t* T2 = (bf16_t*)(F.ws + WS_R1 + R1_T2);
    const float* cw = INP(IN_CW);
    const long nitem = (long)TALL * 128;
    for (long it = (long)row0 * 128 + (long)F.bid * 512 + F.tid; it < nitem; it += (long)F.G * 512) {
        const int row = (int)(it >> 7), c8 = (int)(it & 127) * 8;
        const bool first = row < NCTX ? ((row & 255) == 0) : (((row - NCTX) & (SEQ - 1)) == 0);
        const bool last = row < NCTX ? ((row & 255) == 255) : (((row - NCTX) & (SEQ - 1)) == SEQ - 1);
        const u32x4 zero = (u32x4){0u, 0u, 0u, 0u};
        const u32x4 pm = first ? zero : *(const u32x4*)(P + (size_t)(row - 1) * DM + c8);
        const u32x4 pc = *(const u32x4*)(P + (size_t)row * DM + c8);
        const u32x4 pp = last ? zero : *(const u32x4*)(P + (size_t)(row + 1) * DM + c8);
        const u32x4 bg = *(const u32x4*)(BG + (size_t)row * DM + c8);
        float o[8];
#pragma unroll
        for (int e = 0; e < 4; ++e) {
            const float w0a = cw[c8 + 2 * e], w0b = cw[c8 + 2 * e + 1], w1a = cw[1024 + c8 + 2 * e], w1b = cw[1024 + c8 + 2 * e + 1], w2a = cw[2048 + c8 + 2 * e], w2b = cw[2048 + c8 + 2 * e + 1];
            o[2 * e] = bflo(bg[e]) * (w0a * bflo(pm[e]) + w1a * bflo(pc[e]) + w2a * bflo(pp[e]));
            o[2 * e + 1] = bfhi(bg[e]) * (w0b * bfhi(pm[e]) + w1b * bfhi(pc[e]) + w2b * bfhi(pp[e])); }
        u32x4 w; w.x = pk2(o[0], o[1]); w.y = pk2(o[2], o[3]); w.z = pk2(o[4], o[5]); w.w = pk2(o[6], o[7]);
        *(u32x4*)(T2 + (size_t)row * DM + c8) = w;
    }
}

__device__ __forceinline__ void router_phase(Frame& F, const bf16_t* H, int layer, int row0) {
    constexpr int PITCH = 2064;
    char* wl = F.ldsg;
    { const bf16_t* Wr = (const bf16_t*)(F.ws + WS_WR) + (size_t)layer * 256 * 1024;
      for (int i = F.tid; i < 32 * 128; i += NWAVES * 64) { const int r = i >> 7, c = i & 127; *(u32x4*)(wl + r * PITCH + c * 16) = *(const u32x4*)(Wr + (size_t)r * 1024 + c * 8); } }
    asm volatile("s_waitcnt vmcnt(0) lgkmcnt(0)" ::: "memory");
    __syncthreads();
    float* L = (float*)(F.ws + WS_LOGIT);
    const int fr = F.lane & 15, fq = F.lane >> 4;
    const int ng = (TALL - row0) / 16;
    const char* wb = wl + fr * PITCH + fq * 16;
    for (int g = F.wave * F.G + F.bid; g < ng; g += F.NGW) {
        const int tok = row0 + g * 16 + fr;
        const char* hp = (const char*)(H + (size_t)tok * DM) + fq * 16;
        f32x4 acc0 = (f32x4){0.f, 0.f, 0.f, 0.f}, acc1 = (f32x4){0.f, 0.f, 0.f, 0.f};
#pragma clang loop unroll(disable)
        for (int half = 0; half < 2; ++half) {
            u32x4 a[16];
#pragma unroll
            for (int s_ = 0; s_ < 16; ++s_) a[s_] = *(const u32x4*)(hp + half * 1024 + s_ * 64);
#pragma unroll
            for (int s_ = 0; s_ < 16; ++s_) {
                const bf16x8 w0 = *(const bf16x8*)(wb + half * 1024 + s_ * 64), w1 = *(const bf16x8*)(wb + 16 * PITCH + half * 1024 + s_ * 64);
                const bf16x8 hf = __builtin_bit_cast(bf16x8, a[s_]);
                acc0 = __builtin_amdgcn_mfma_f32_16x16x32_bf16(w0, hf, acc0, 0, 0, 0);
                acc1 = __builtin_amdgcn_mfma_f32_16x16x32_bf16(w1, hf, acc1, 0, 0, 0); } }
        *(f32x4*)(L + (size_t)tok * NEXP + 4 * fq) = acc0; *(f32x4*)(L + (size_t)tok * NEXP + 16 + 4 * fq) = acc1;
    }
    asm volatile("s_waitcnt lgkmcnt(0)" ::: "memory");
    __syncthreads();
}

__device__ __forceinline__ void moe_topk(Frame& F, int layer, int row0) {
    const float* L = (const float*)(F.ws + WS_LOGIT); const float* br = INP(IN_MBR) + layer * 32;
    int* TE = (int*)(F.ws + WS_TOKE); float* TG = (float*)(F.ws + WS_TOKG);
    int* ST = (int*)(F.ws + WS_SLOTTOK); int* SD = (int*)(F.ws + WS_SLOTDST); float* SG = (float*)(F.ws + WS_SLOTGATE);
    for (int i = F.bid * 512 + F.tid; i < NSLOT_MAX; i += F.G * 512) { ST[i] = TALL; SG[i] = 0.f; }
    gu32* cnt = F.ctl + CW_CNT + layer * 64;
    for (int g = F.wave * F.G + F.bid; g < (TALL - row0) / 64; g += F.NGW) {
        const int tok = row0 + g * 64 + F.lane;
        float lg[32];
#pragma unroll
        for (int j = 0; j < 8; ++j) { const f32x4 v = *(const f32x4*)(L + (size_t)tok * 32 + 4 * j); const f32x4 b = *(const f32x4*)(br + 4 * j);
            lg[4 * j] = v[0] + b[0]; lg[4 * j + 1] = v[1] + b[1]; lg[4 * j + 2] = v[2] + b[2]; lg[4 * j + 3] = v[3] + b[3]; }
        int e[4]; float tv[4];
#pragma unroll
        for (int k = 0; k < 4; ++k) { float best = -INFINITY; int bi = 0;
#pragma unroll
            for (int i = 0; i < 32; ++i) { const bool take = lg[i] > best; best = take ? lg[i] : best; bi = take ? i : bi; }
            e[k] = bi; tv[k] = best;
#pragma unroll
            for (int i = 0; i < 32; ++i) lg[i] = (i == bi) ? -INFINITY : lg[i]; }
        const float e1 = __expf(tv[1] - tv[0]), e2 = __expf(tv[2] - tv[0]), e3 = __expf(tv[3] - tv[0]); const float inv = 1.0f / (1.0f + e1 + e2 + e3);
        *(int4*)(TE + (size_t)tok * 4) = make_int4(e[0], e[1], e[2], e[3]);
        *(f32x4*)(TG + (size_t)tok * 4) = (f32x4){inv, e1 * inv, e2 * inv, e3 * inv};
        unsigned mycnt = 0;
        for (int x = 0; x < 32; ++x) { unsigned c = 0;
#pragma unroll
            for (int k = 0; k < 4; ++k) c += __popcll(__ballot(e[k] == x));
            if (F.lane == x) mycnt = c; }
        if (F.lane < 32 && mycnt) __hip_atomic_fetch_add(cnt + F.lane, mycnt, RLX_AGENT);
    }
}
__device__ __forceinline__ void moe_scatter(Frame& F, int layer, int row0) {
    const int* TE = (const int*)(F.ws + WS_TOKE); const float* TG = (const float*)(F.ws + WS_TOKG);
    int* ST = (int*)(F.ws + WS_SLOTTOK); int* SD = (int*)(F.ws + WS_SLOTDST); float* SG = (float*)(F.ws + WS_SLOTGATE);
    gu32* cnt = F.ctl + CW_CNT + layer * 64; gu32* cur = F.ctl + CW_CUR + layer * 64;
    unsigned c = (F.lane < 32) ? __hip_atomic_load(cnt + F.lane, RLX_AGENT) : 0u;
    const unsigned padded = (c + 255u) & ~255u; unsigned incl = 0u, total = 0u;
    for (int x = 0; x < 32; ++x) { total += (unsigned)__builtin_amdgcn_readlane((int)padded, x); if (F.lane == x) incl = total; }
    const unsigned pstart = incl - padded;
    if (F.bid == 0 && F.wave == NWAVES - 1) {
        int* BE = (int*)(F.ws + WS_META);
        const unsigned nblk = total / 256u;
        for (unsigned b0 = 0; b0 < nblk; b0 += 64) { const unsigned blk = b0 + F.lane; int ex = 0;
            for (int x = 0; x < 32; ++x) { const unsigned ps = (unsigned)__builtin_amdgcn_readlane((int)pstart, x), pe = (unsigned)__builtin_amdgcn_readlane((int)incl, x); if (blk * 256u >= ps && blk * 256u < pe) ex = x; }
            if (blk < nblk) BE[blk] = ex; }
    }
    for (int g = F.wave * F.G + F.bid; g < (TALL - row0) / 64; g += F.NGW) {
        const int tok = row0 + g * 64 + F.lane;
        const int4 ev = *(const int4*)(TE + (size_t)tok * 4); const f32x4 gv = *(const f32x4*)(TG + (size_t)tok * 4);
        const int e[4] = {ev.x, ev.y, ev.z, ev.w};
        unsigned mycnt = 0; unsigned rank[4] = {0u, 0u, 0u, 0u};
        const unsigned long long lt = (1ull << F.lane) - 1ull;
        for (int x = 0; x < 32; ++x) { unsigned run = 0;
#pragma unroll
            for (int k = 0; k < 4; ++k) { const unsigned long long m = __ballot(e[k] == x); if (e[k] == x) rank[k] = run + (unsigned)__popcll(m & lt); run += (unsigned)__popcll(m); }
            if (F.lane == x) mycnt = run; }
        unsigned base = 0;
        if (F.lane < 32 && mycnt) base = __hip_atomic_fetch_add(cur + F.lane, mycnt, RLX_AGENT);
        base += pstart;
#pragma unroll
        for (int k = 0; k < 4; ++k) { const unsigned slot = (unsigned)__builtin_amdgcn_ds_bpermute(e[k] << 2, (int)base) + rank[k];
            ST[slot] = tok; SG[slot] = gv[k]; SD[tok * 4 + k] = (int)slot; }
    }
}


__device__ __forceinline__ void attn_phase(Frame& F) {
    const bf16_t* Q = (const bf16_t*)(F.ws + WS_R1 + R1_Q); const bf16_t* Kb = (const bf16_t*)(F.ws + WS_R1 + R1_K); const bf16_t* Vb = (const bf16_t*)(F.ws + WS_R1 + R1_V);
    bf16_t* O = (bf16_t*)(F.ws + WS_R1 + R1_O); const unsigned char* V8 = F.ws + WS_R1 + R1_V8;
    float lam;
    { const float* lp = INP(IN_DLAM); const float a = wave_sum(lp[F.lane] * lp[64 + F.lane]), b = wave_sum(lp[128 + F.lane] * lp[192 + F.lane]); lam = expf(a) - expf(b) + LAM_INIT; }
    const float* subg = INP(IN_DSUBG);
    const int bx = F.bid; const int vcu = (F.G % 8 == 0) ? (bx % 8) * (F.G / 8) + bx / 8 : bx;
    for (int id = vcu; id < 4096; id += F.G) {
        { const int bh = id >> 6, qb = id & 63, b = bh >> 3, h = bh & 7;
            att::attn_unit_f8(Q, Kb, V8 + (size_t)bh * 132 * 8192, O, NCTX + b * SEQ + qb * 128, b * CTXL, NCTX + b * SEQ, 4 + SEQ / 64, h, lam, subg, F.ldsg, F.wave0); }
    }
}

__global__ void __launch_bounds__(NWAVES * 64, 2) fwd_kernel(Args args) {
    extern __shared__ __attribute__((aligned(16))) unsigned char lds[];
    Frame F;
    F.lds = (LAS unsigned char*)lds; F.ldsg = (char*)lds;
    F.wave0 = __builtin_amdgcn_readfirstlane((int)(threadIdx.x >> 6));
    F.tid = opaque_tid(F.wave0); F.lane = F.tid & 63; F.wave = F.wave0;
    F.G = gridDim.x; F.bid = blockIdx.x; F.gw = blockIdx.x * NWAVES + F.wave; F.NGW = F.G * NWAVES;
    F.out = args.out; F.ws = args.ws; F.ctl = (gu32*)(args.ws + WS_CTL);
    volatile LAS unsigned* MISC = (volatile LAS unsigned*)(F.lds + MISC_OFF);
    for (int u = F.tid; u < (LDS_BYTES - MISC_OFF) / 4; u += NWAVES * 64) MISC[u] = 0u;
    __syncthreads();
    XcdBarrier bar; bar.bar = (unsigned*)(F.ctl + CW_BAR); bar.x = 0; bar.st = MISC + 8;
    if (F.tid == 0) (void)xb_add(&bar.bar[XB_XCNT(xb_xcc_id())], 1u);
#define GRID_BAR() xcd_barrier(bar, opaque_tid(F.wave0) == 0)
#ifndef PROBE_CLASS
#define PROBE_CLASS 0
#endif
#define PROBE_MULT 4
#if PROBE_CLASS
    unsigned long long pr_t0 = __builtin_amdgcn_s_memrealtime(), pr_acc = 0ull;
#define MARK(c) do { const unsigned long long t_ = __builtin_amdgcn_s_memrealtime(); if ((c) == PROBE_CLASS) pr_acc += t_ - pr_t0; pr_t0 = t_; } while (0)
#else
#define MARK(c) do { } while (0)
#endif
#define REFRESH() do { { int w_ = F.wave0; asm volatile("" : "+s"(w_)); F.wave = w_; } F.tid = opaque_tid(F.wave); F.lane = F.tid & 63; { int b_ = blockIdx.x, g_ = gridDim.x; asm volatile("" : "+s"(b_), "+s"(g_)); F.bid = b_; F.G = g_; F.NGW = g_ * NWAVES; } F.gw = F.bid * NWAVES + F.wave; \
    { GAS unsigned char* g_ = (GAS unsigned char*)F.ws; asm volatile("" : "+s"(g_)); unsigned char* w_ = (unsigned char*)g_; F.ws = w_; F.ctl = (gu32*)(w_ + WS_CTL); R1 = w_ + WS_R1; H = (bf16_t*)(w_ + WS_H); Y = (bf16_t*)(w_ + WS_Y); } } while (0)
    unsigned char* R1 = F.ws + WS_R1;
    bf16_t* H = (bf16_t*)(F.ws + WS_H); bf16_t* Y = (bf16_t*)(F.ws + WS_Y);

    p0_weights(F); __syncthreads(); p0_mod(F); p0_misc(F);
    GRID_BAR(); REFRESH(); MARK(1);
    row_pass<0, true>(F, 0, false, 0);
    GRID_BAR(); REFRESH(); MARK(4);

    for (int layer = 0; layer < DEPTH; ++layer) {
        const int kind = layer % 3, j = layer / 3;
        const int row0i = (layer >= 2) ? NCTX : 0, row0 = (layer >= 1) ? NCTX : 0;
        const int nPanI = (TALL - row0i) / 256, pan0I = row0i / 256, nPan = (TALL - row0) / 256, pan0 = row0 / 256;
        const bf16_t* yA; const bf16_t* yW; int yK;
        if (kind == 0) {
            { pg8::DenseSched S; S.o.init(nPanI, 4096 / 256, F.G, F.bid, pan0I); S.K = 512;
              pg8::EpiGeluStats E{(bf16_t*)(R1 + R1_Z), (float*)(F.ws + WS_PART)};
              pg8::gemm_phase<pg8::EpiGeluStats, pg8::DenseSched, true, true>(F.lds, (const bf16_t*)(F.ws + WS_H8), (const bf16_t*)(F.ws + WS_WIN + (size_t)j * 4096 * 1024), 512, S, E, F.wave0); }
            GRID_BAR(); REFRESH(); MARK(7);
            gmlp_spatial_fused(F, j, row0i);
            GRID_BAR(); REFRESH(); MARK(2);
            yA = (const bf16_t*)(R1 + R1_T); yW = (const bf16_t*)(F.ws + WS_WOUT) + (size_t)j * 1024 * 2048; yK = 2048;
        } else if (kind == 1) {
            { pg8::DenseSched S; S.o.init(nPanI, 3072 / 256, F.G, F.bid, pan0I); S.K = 512;
              pg8::EpiQKV E{(bf16_t*)(R1 + R1_Q), (size_t)(R1_K - R1_Q) / 2, (const float*)(F.ws + WS_ROPE), (const float*)(F.ws + WS_ROPE) + 2048, R1 + R1_V8};
              pg8::gemm_phase<pg8::EpiQKV, pg8::DenseSched, true, true>(F.lds, (const bf16_t*)(F.ws + WS_H8), (const bf16_t*)(F.ws + WS_WQKV), 512, S, E, F.wave0); }
            GRID_BAR(); REFRESH(); MARK(7);
            attn_phase(F);
            GRID_BAR(); REFRESH(); MARK(3);
            yA = (const bf16_t*)(R1 + R1_O); yW = (const bf16_t*)(F.ws + WS_WO); yK = 512;
        } else {
            { pg8::DenseSched S; S.o.init(nPanI, 3072 / 256, F.G, F.bid, pan0I); S.K = 1024;
              pg8::EpiConvIn E{(bf16_t*)(R1 + R1_P), (bf16_t*)(R1 + R1_BG)};
              pg8::gemm_phase<pg8::EpiConvIn, pg8::DenseSched, true>(F.lds, H, (const bf16_t*)(F.ws + WS_CWIN), 1024, S, E, F.wave0); }
            GRID_BAR(); REFRESH(); MARK(7);
            conv_mix(F, row0i);
            GRID_BAR(); REFRESH(); MARK(8);
            yA = (const bf16_t*)(R1 + R1_T2); yW = (const bf16_t*)(F.ws + WS_CWOUT); yK = 1024;
        }
        { pg8::DenseSched S; S.o.init(nPan, 1024 / 256, F.G, F.bid, pan0); S.K = yK;
          pg8::EpiBf16<0> E{Y, 1024};
          if (kind == 1) pg8::gemm_phase<pg8::EpiBf16<0>, pg8::DenseSched, true, true>(F.lds, yA, yW, yK, S, E, F.wave0);
          else pg8::gemm_phase<pg8::EpiBf16<0>, pg8::DenseSched, true>(F.lds, yA, yW, yK, S, E, F.wave0); }
        GRID_BAR(); REFRESH(); MARK(7);
        if (layer == 0) row_pass<1, true>(F, layer, false, row0); else row_pass<1, false>(F, layer, false, row0);
        GRID_BAR(); REFRESH(); MARK(4);
        router_phase(F, H, layer, row0);
        GRID_BAR(); REFRESH(); MARK(5);
        moe_topk(F, layer, row0);
        GRID_BAR(); REFRESH(); MARK(5);
        moe_scatter(F, layer, row0);
        GRID_BAR(); REFRESH(); MARK(5);
        int nblk;
        { unsigned c = (F.lane < 32) ? __hip_atomic_load(F.ctl + CW_CNT + layer * 64 + F.lane, RLX_AGENT) : 0u; unsigned nb = (c + 255u) >> 8;
          nb = wave_sum_u(nb);
          nblk = __builtin_amdgcn_readfirstlane((int)nb); }
        LAS int* lds_be = (LAS int*)(F.lds + MISC_OFF + 4096);
        { const int* BE = (const int*)(F.ws + WS_META); for (int i = F.tid; i < nblk; i += NWAVES * 64) lds_be[i] = BE[i]; }
        __syncthreads();
        { pg8::MoeSched<true> S; S.o.init(nblk, 2048 / 256, F.G, F.bid); S.K = 512; S.N = 2048; S.block_e = lds_be; S.slot_tok = (const int*)(F.ws + WS_SLOTTOK);
          pg8::EpiMoe1 E{(bf16_t*)(R1 + R1_ACT), INP(IN_MBGU) + (size_t)layer * 32 * 2048};
          pg8::gemm_phase<pg8::EpiMoe1, pg8::MoeSched<true>, true, true>(F.lds, (const bf16_t*)(F.ws + WS_H8), (const bf16_t*)(F.ws + WS_WGU + (size_t)layer * 32 * 2048 * 1024), 512, S, E, F.wave0); }
        GRID_BAR(); REFRESH(); MARK(6);
        { pg8::MoeSched<false> S; S.o.init(nblk, 1024 / 256, F.G, F.bid); S.K = 512; S.N = 1024; S.block_e = lds_be; S.slot_tok = nullptr;
          pg8::EpiMoe2 E{(bf16_t*)(R1 + R1_YK), INP(IN_MBDN) + (size_t)layer * 32 * 1024, (const float*)(F.ws + WS_SLOTGATE)};
          pg8::gemm_phase<pg8::EpiMoe2, pg8::MoeSched<false>, true, true>(F.lds, (const bf16_t*)(R1 + R1_ACT), (const bf16_t*)(F.ws + WS_WDN + (size_t)layer * 32 * 1024 * 1024), 512, S, E, F.wave0); }
        GRID_BAR(); REFRESH(); MARK(6);
        row_pass<2, false>(F, layer, layer == DEPTH - 1, row0);
        if (layer != DEPTH - 1) { GRID_BAR(); REFRESH(); MARK(4); }
    }
#if PROBE_CLASS
    GRID_BAR(); MARK(4);
    if (F.bid == 0 && F.tid == 0) { const unsigned long long tend = __builtin_amdgcn_s_memrealtime() + PROBE_MULT * pr_acc; while (__builtin_amdgcn_s_memrealtime() < tend) __builtin_amdgcn_s_sleep(8); }
#endif
}

extern "C" void kernel_launch(void* const* d_in, const int* in_sizes, int n_in, void* d_out, int out_size, void* d_ws, size_t ws_size, hipStream_t stream) {
    static int grid = 0;
    if (grid == 0) {
        if (n_in != 27 || out_size != NLAT * DM || ws_size < WS_END) { fprintf(stderr, "kernel_launch: unexpected shapes (n_in %d, out %d, ws %zu < %zu)\n", n_in, out_size, ws_size, (size_t)WS_END); grid = -1; return; }
        int dev = 0, cus = 0, per_cu = 0;
        if (hipGetDevice(&dev) != hipSuccess || hipDeviceGetAttribute(&cus, hipDeviceAttributeMultiprocessorCount, dev) != hipSuccess) { grid = -1; return; }
        if (hipFuncSetAttribute((const void*)fwd_kernel, hipFuncAttributeMaxDynamicSharedMemorySize, LDS_BYTES) != hipSuccess) { fprintf(stderr, "kernel_launch: hipFuncSetAttribute failed\n"); grid = -1; return; }
        if (hipOccupancyMaxActiveBlocksPerMultiprocessor(&per_cu, (const void*)fwd_kernel, NWAVES * 64, LDS_BYTES) != hipSuccess || per_cu < 1) { fprintf(stderr, "kernel_launch: occupancy query reports %d\n", per_cu); }
        (void)hipGetLastError();
        grid = cus;
    }
    if (grid < 0) return;
    if (hipMemsetAsync((char*)d_ws + WS_CTL, 0, CTL_ZERO_BYTES, stream) != hipSuccess) return;
    Args a{};
    for (int i = 0; i < 27; ++i) a.in[i] = (const float*)d_in[i];
    a.out = (float*)d_out; a.ws = (unsigned char*)d_ws;
    hipLaunchKernelGGL(fwd_kernel, dim3(grid), dim3(NWAVES * 64), LDS_BYTES, stream, a);
}
```

```cpp
#include <hip/hip_runtime.h>
#include <hip/hip_bf16.h>
#include <cstdio>
#include <cstdint>
#include <cmath>

#define GAS __attribute__((address_space(1)))
#define LAS __attribute__((address_space(3)))
typedef unsigned short bf16_t;
typedef short bf16x8 __attribute__((ext_vector_type(8)));
typedef short s16x4 __attribute__((ext_vector_type(4)));
typedef float f32x4 __attribute__((ext_vector_type(4)));
typedef float f32x2 __attribute__((ext_vector_type(2)));
typedef float f32x16 __attribute__((ext_vector_type(16)));
typedef unsigned u32x4 __attribute__((ext_vector_type(4)));
typedef unsigned u32x2 __attribute__((ext_vector_type(2)));
typedef GAS unsigned gu32;
#define RLX_AGENT __ATOMIC_RELAXED, __HIP_MEMORY_SCOPE_AGENT

constexpr int DM = 1024, NB = 8, SEQ = 8192, CTXL = 256, DEPTH = 4;
constexpr int NCTX = NB * CTXL;
constexpr int NLAT = NB * SEQ;
constexpr int TALL = NCTX + NLAT;
constexpr int NEXP = 32, TOPK = 4;
constexpr int NBLK_MAX = TALL * TOPK / 256 + NEXP;
constexpr int NSLOT_MAX = NBLK_MAX * 256;
constexpr float LN_EPS = 1e-5f;
constexpr float DN_ALPHA = 1.681792830507429f;
constexpr float LAM_INIT = 0.35550906759096927f;
constexpr int NWAVES = 8;
constexpr float QK_PRESCALE = 0.125f * 1.4426950408889634f;

constexpr size_t MiB = 1u << 20;
constexpr size_t WS_CTL = 0, CTL_ZERO_BYTES = 1 * MiB;
constexpr size_t WS_MOD = 1 * MiB;
constexpr size_t WS_ROPE = 2 * MiB;
constexpr size_t WS_META = 2 * MiB + 64 * 1024;
constexpr size_t WS_STAT = 3 * MiB;
constexpr size_t WS_LOGIT = 4 * MiB;
constexpr size_t WS_TOKE = 13 * MiB;
constexpr size_t WS_TOKG = 15 * MiB;
constexpr size_t WS_SLOTTOK = 17 * MiB;
constexpr size_t WS_SLOTGATE = 19 * MiB;
constexpr size_t WS_SLOTDST = 21 * MiB;
constexpr size_t WS_WIN = 24 * MiB;
constexpr size_t WS_WOUT = 40 * MiB;
constexpr size_t WS_WS = 48 * MiB;
constexpr size_t WS_WQKV = 49 * MiB;
constexpr size_t WS_WO = 55 * MiB;
constexpr size_t WS_CWIN = 57 * MiB;
constexpr size_t WS_CWOUT = 63 * MiB;
constexpr size_t WS_WR = 65 * MiB;
constexpr size_t WS_WGU = 68 * MiB;
constexpr size_t WS_WDN = 580 * MiB;
constexpr size_t WS_X = 836 * MiB;
constexpr size_t WS_H = 1100 * MiB;
constexpr size_t WS_Y = 1234 * MiB;
constexpr size_t WS_R1 = 1368 * MiB;
constexpr size_t R1_Z = 0, R1_VT = 528 * MiB, R1_T = 792 * MiB;
constexpr size_t R1_Q = 0, R1_K = 132 * MiB, R1_V = 264 * MiB, R1_O = 396 * MiB, R1_V8 = 528 * MiB;
constexpr size_t R1_P = 0, R1_BG = 132 * MiB, R1_T2 = 264 * MiB;
constexpr size_t R1_ACT = 0, R1_YK = 288 * MiB;
static_assert(R1_V - R1_K == R1_K - R1_Q, "Q | K | V equally spaced");
constexpr size_t WS_H8 = WS_R1 + 1080 * MiB;
constexpr size_t WS_PART = WS_H8 + 68 * MiB;
constexpr size_t WS_END = WS_PART + 18 * MiB;
static_assert((size_t)TALL * 4096 * 2 <= 528 * MiB && (size_t)NSLOT_MAX * 1024 <= 288 * MiB && R1_YK + (size_t)NSLOT_MAX * 1024 * 2 <= 1080 * MiB, "R1 map");
static_assert((size_t)(TALL + 256) * 1024 * 2 <= 134 * MiB && (size_t)TALL * 1024 * 4 <= 264 * MiB, "X/H map");
constexpr int CW_TMO = 0;
constexpr int CW_CNT = 1024;
constexpr int CW_CUR = 2048;
constexpr int CW_BAR = 4096;

constexpr int RING_BYTES = 131072;
constexpr int MISC_OFF = RING_BYTES;
constexpr int LDS_BYTES = 147456;

#define LDS_WAIT() asm volatile("s_waitcnt lgkmcnt(0)" ::: "memory")
#define VM_WAIT() asm volatile("s_waitcnt vmcnt(0)" ::: "memory")

__device__ __forceinline__ unsigned f2bf(float f) { unsigned u = __builtin_bit_cast(unsigned, f); return (u + 0x7fffu + ((u >> 16) & 1u)) >> 16; }
__device__ __forceinline__ unsigned pk2(float lo, float hi) { return f2bf(lo) | (f2bf(hi) << 16); }
__device__ __forceinline__ float bf2f(unsigned short b) { return __builtin_bit_cast(float, (unsigned)b << 16); }
__device__ __forceinline__ float bflo(unsigned w) { return __builtin_bit_cast(float, w << 16); }
__device__ __forceinline__ float bfhi(unsigned w) { return __builtin_bit_cast(float, w & 0xffff0000u); }
__device__ __forceinline__ unsigned cvt_pk_bf16(float lo, float hi) { unsigned r; asm volatile("v_cvt_pk_bf16_f32 %0, %1, %2" : "=v"(r) : "v"(lo), "v"(hi)); return r; }
typedef int i32x8 __attribute__((ext_vector_type(8)));
__device__ __forceinline__ unsigned cvt_fp8x4(float a, float b, float c, float d) { int w = __builtin_amdgcn_cvt_pk_fp8_f32(a, b, 0, false); w = __builtin_amdgcn_cvt_pk_fp8_f32(c, d, w, true); return (unsigned)w; }
constexpr float YK8_SCALE = 16.0f;
__device__ __forceinline__ unsigned cvt_fp8x4_sat(float a, float b, float c, float d) { return cvt_fp8x4(__builtin_amdgcn_fmed3f(a, -448.f, 448.f), __builtin_amdgcn_fmed3f(b, -448.f, 448.f), __builtin_amdgcn_fmed3f(c, -448.f, 448.f), __builtin_amdgcn_fmed3f(d, -448.f, 448.f)); }
constexpr float W8_SCALE = 32.0f;
constexpr int W8_E8M0 = 0x7A7A7A7A, A8_E8M0 = 0x7F7F7F7F;
__device__ __forceinline__ int opaque_tid(int wave) { int l; asm volatile("v_mbcnt_lo_u32_b32 %0, -1, 0\n\tv_mbcnt_hi_u32_b32 %0, -1, %0" : "=v"(l)); return wave * 64 + l; }
template <int M> __device__ __forceinline__ int swz_xor_i(int v) { return __builtin_amdgcn_ds_swizzle(v, (M << 10) | 0x1f); }
template <int M> __device__ __forceinline__ float swz_xor_f(float v) { return __builtin_bit_cast(float, __builtin_amdgcn_ds_swizzle(__builtin_bit_cast(int, v), (M << 10) | 0x1f)); }
__device__ __forceinline__ float half_sum32(float v) { v += swz_xor_f<1>(v); v += swz_xor_f<2>(v); v += swz_xor_f<4>(v); v += swz_xor_f<8>(v); v += swz_xor_f<16>(v); return v; }
__device__ __forceinline__ float wave_sum(float v) {
    v = half_sum32(v);
    const auto rr = __builtin_amdgcn_permlane32_swap(__float_as_uint(v), __float_as_uint(v), false, false);
    return __uint_as_float(rr[0]) + __uint_as_float(rr[1]);
}
__device__ __forceinline__ unsigned wave_sum_u(unsigned v) {
    v += (unsigned)swz_xor_i<1>((int)v); v += (unsigned)swz_xor_i<2>((int)v); v += (unsigned)swz_xor_i<4>((int)v); v += (unsigned)swz_xor_i<8>((int)v); v += (unsigned)swz_xor_i<16>((int)v);
    const auto rr = __builtin_amdgcn_permlane32_swap(v, v, false, false);
    return rr[0] + rr[1];
}

#define XB_TMO      128
#define XB_XCNT(j)  (256  + 64 * (j))
#define XB_XSUB(j)  (1280 + 64 * (j))
#define XB_XGEN(j)  (2304 + 64 * (j))
#define XB_TOP      3328
#define XB_TOPGEN   3392
#define XCD_BAR_WORDS 3456
#define XB_SPIN_CAP (1u << 22)

__device__ __forceinline__ unsigned xb_ld(unsigned* p)              { return __hip_atomic_load(p, __ATOMIC_RELAXED, __HIP_MEMORY_SCOPE_AGENT); }
__device__ __forceinline__ unsigned xb_add(unsigned* p, unsigned v) { return __hip_atomic_fetch_add(p, v, __ATOMIC_RELAXED, __HIP_MEMORY_SCOPE_AGENT); }
__device__ __forceinline__ unsigned xb_xcc_id() { return (unsigned)__builtin_amdgcn_s_getreg((3 << 11) | 20) & 0xFu; }
#define XB_SPIN(cond, bar) do { unsigned _sp = 0; while (cond) { __builtin_amdgcn_s_sleep(1); \
    if ((++_sp & 255u) == 0u) { if (xb_ld(&(bar)[XB_TMO])) break; if (_sp > XB_SPIN_CAP) { atomicAdd(&(bar)[XB_TMO], 1u); break; } } } } while (0)

struct XcdBarrier { unsigned* bar; unsigned x; volatile LAS unsigned* st; };

__device__ __forceinline__ XcdBarrier xcd_barrier_post(unsigned* bar, volatile LAS unsigned* st) {
    XcdBarrier b; b.bar = bar; b.x = xb_xcc_id(); b.st = st;
    if (threadIdx.x == 0) (void)xb_add(&bar[XB_XCNT(b.x)], 1u);
    return b;
}
__device__ __forceinline__ void xcd_barrier_complete(unsigned* bar, unsigned x, unsigned& nloc, unsigned& nx) {
    const unsigned G = gridDim.x * gridDim.y * gridDim.z;
    unsigned sum, cnt, mine, sp = 0u;
    for (;;) {
        sum = 0u; cnt = 0u; mine = 0u;
#pragma unroll
        for (unsigned j = 0; j < 16; ++j) { const unsigned c = xb_ld(&bar[XB_XCNT(j)]); sum += c; cnt += (c > 0u) ? 1u : 0u; mine = (j == x) ? c : mine; }
        if (sum == G) break;
        __builtin_amdgcn_s_sleep(1);
        if ((++sp & 255u) == 0u) { if (xb_ld(&bar[XB_TMO])) break; if (sp > XB_SPIN_CAP) { atomicAdd(&bar[XB_TMO], 1u); break; } }
    }
    nloc = mine > 0u ? mine : 1u; nx = cnt > 0u ? cnt : 1u;
}
__device__ __forceinline__ void xcd_barrier(const XcdBarrier& b, const bool leader) {
    asm volatile("s_waitcnt vmcnt(0)" ::: "memory");
    __syncthreads();
    if (leader) {
        GAS unsigned* gbar_ = (GAS unsigned*)b.bar; asm volatile("" : "+s"(gbar_)); unsigned* bar = (unsigned*)gbar_; const unsigned bx_ = (unsigned)__builtin_amdgcn_readfirstlane((int)xb_xcc_id());
        __builtin_amdgcn_s_waitcnt(0);
        unsigned nloc = b.st[0], nx = b.st[1];
        if (nloc == 0u) { xcd_barrier_complete(bar, bx_, nloc, nx); b.st[0] = nloc; b.st[1] = nx; }
        const unsigned old = xb_add(&bar[XB_XSUB(bx_)], 1u);
        const unsigned gen = old / nloc;
        if (old + 1u == (gen + 1u) * nloc) {
            __builtin_amdgcn_fence(__ATOMIC_RELEASE, "agent");
            asm volatile("s_waitcnt vmcnt(0)" ::: "memory");
            const unsigned og = xb_add(&bar[XB_TOP], 1u);
            const unsigned tg = og / nx;
            if (og + 1u == (tg + 1u) * nx) xb_add(&bar[XB_TOPGEN], 1u);
            else XB_SPIN(xb_ld(&bar[XB_TOPGEN]) == tg, bar);
            __builtin_amdgcn_fence(__ATOMIC_ACQUIRE, "agent");
            xb_add(&bar[XB_XGEN(bx_)], 1u);
            asm volatile("s_waitcnt vmcnt(0)" ::: "memory");
        } else {
            XB_SPIN(xb_ld(&bar[XB_XGEN(bx_)]) == gen, bar);
            __builtin_amdgcn_fence(__ATOMIC_ACQUIRE, "agent");
            asm volatile("s_waitcnt vmcnt(0)" ::: "memory");
        }
    }
    __syncthreads();
}

namespace pg8 {
constexpr int BM = 256, BK = 64, HALF = 128, HTB = HALF * BK * 2, STAGE_BYTES = 8 * HTB, NXCD = 8, WGM = 8;
__host__ __device__ __forceinline__ int lds_byte(int r, int c) { const int st = (r >> 4) * 2 + (c >> 5), rr = r & 15, cc = c & 31, ob = rr * 64 + cc * 2; return st * 1024 + (ob ^ (((ob >> 9) & 1) << 5)); }
__host__ __device__ __forceinline__ void stage_rc(int b, int& R, int& C) { const int st = b / 1024, sb = b % 1024, swz = sb ^ (((sb >> 9) & 1) << 5); R = (st >> 1) * 16 + swz / 64; C = (st & 1) * 32 + (swz % 64) / 2; }
__host__ __device__ __forceinline__ int perm32(int rho) { const int n = rho >> 4, i = rho & 15; return 8 * (i >> 2) + 4 * n + (i & 3); }

struct Unit { int pm, pn, e; };
__device__ __forceinline__ void glds16_s(const char* gbase, unsigned voff, unsigned lds_dst);
constexpr int EPI_LDS_OFF = MISC_OFF + 8704, EPI_LDS_BUF = 3072;

struct TileOrder {
    int nM, nN, nwg, G, c, pm0;
    __device__ __forceinline__ void init(int nM_, int nN_, int G_, int c_, int pm0_ = 0) { nM = nM_; nN = nN_; nwg = nM * nN; G = G_; c = c_; pm0 = pm0_; }
    __device__ __forceinline__ bool tile(int i, int& pm, int& pn) const {
        const long L = (long)i * G + c; if (L >= nwg) return false;
        int wgid = (int)L; { const int q = nwg / NXCD, r = nwg % NXCD, xcd = wgid % NXCD, off = wgid / NXCD; wgid = (xcd < r ? xcd * (q + 1) : r * (q + 1) + (xcd - r) * q) + off; }
        const int nig = WGM * nN, gid = wgid / nig, fm = gid * WGM, gsz = (nM - fm) < WGM ? (nM - fm) : WGM;
        pm = pm0 + fm + ((wgid % nig) % gsz); pn = (wgid % nig) / gsz; return true;
    }
};
struct DenseSched {
    TileOrder o; int K;
    static constexpr bool ASYNC_ROWS = false;
    __device__ __forceinline__ bool next(int i, Unit& u) const { u.e = 0; return o.tile(i, u.pm, u.pn); }
    __device__ __forceinline__ unsigned a_row(const Unit& u, int r) const { return (unsigned)(u.pm * BM + r); }
    __device__ __forceinline__ unsigned a_row_async(const Unit& u, int r) const { return a_row(u, r); }
    __device__ __forceinline__ size_t b_off(const Unit& u) const { return (size_t)u.pn * BM * K; }
};
template <bool GATHER> struct MoeSched {
    TileOrder o; int K, N; const LAS int* block_e; const int* slot_tok;
    static constexpr bool ASYNC_ROWS = GATHER;
    __device__ __forceinline__ bool next(int i, Unit& u) const {
        if (!o.tile(i, u.pm, u.pn)) return false;
        u.e = __builtin_amdgcn_readfirstlane(block_e[u.pm]); return true; }
    __device__ __forceinline__ unsigned a_row(const Unit& u, int r) const { if (GATHER) return (unsigned)slot_tok[u.pm * BM + r]; else return (unsigned)(u.pm * BM + r); }
    __device__ __forceinline__ unsigned a_row_async(const Unit& u, int r) const {
        if (GATHER) { unsigned v; asm volatile("global_load_dword %0, %1, %2" : "=v"(v) : "v"((unsigned)(u.pm * BM + r) * 4u), "s"(slot_tok) : "memory"); return v; }
        else return (unsigned)(u.pm * BM + r); }
    __device__ __forceinline__ size_t b_off(const Unit& u) const { return ((size_t)u.e * N + (size_t)u.pn * BM) * K; }
};

__device__ __forceinline__ f32x2 gelu_pk(f32x2 v) {
    const f32x2 av = __builtin_elementwise_abs(v), d = av * 0.2316418882f + 1.0f;
    f32x2 t; t.x = __builtin_amdgcn_rcpf(d.x); t.y = __builtin_amdgcn_rcpf(d.y);
    f32x2 q = t * 0.5307027145f + (-0.7265760135f); q = q * t + 0.7107068705f; q = q * t + (-0.142248368f); q = q * t + 0.127414796f; q = q * t;
    const f32x2 s = (v * v) * (-0.72134752044f);
    f32x2 e; e.x = __builtin_amdgcn_exp2f(s.x); e.y = __builtin_amdgcn_exp2f(s.y);
    const f32x2 m = v * (q * e), r = v - m;
    f32x2 o; o.x = v.x < 0.f ? m.x : r.x; o.y = v.y < 0.f ? m.y : r.y; return o;
}
__device__ __forceinline__ u32x4 pack8(f32x4 v0, f32x4 v1) { u32x4 w; w.x = cvt_pk_bf16(v0[0], v0[1]); w.y = cvt_pk_bf16(v0[2], v0[3]); w.z = cvt_pk_bf16(v1[0], v1[1]); w.w = cvt_pk_bf16(v1[2], v1[3]); return w; }
__device__ __forceinline__ u32x2 pack4(f32x4 v) { u32x2 w; w.x = cvt_pk_bf16(v[0], v[1]); w.y = cvt_pk_bf16(v[2], v[3]); return w; }

template <int ACT> struct EpiBf16 {
    __device__ __forceinline__ void prefetch(const Unit&, unsigned, int, int) const {}
    static constexpr bool PERM = true;
    bf16_t* O; int ldc;
    __device__ __forceinline__ void operator()(const f32x4 (&acc)[2][2][4][2], const Unit& u, int wr, int wc, int fr, int fq, const LAS unsigned char* epl) const {
        const int row0 = u.pm * BM + wr * 64 + fr, col0 = u.pn * BM + wc * 32 + 8 * fq;
#pragma unroll
        for (int ai = 0; ai < 2; ++ai)
#pragma unroll
            for (int m = 0; m < 4; ++m) { bf16_t* rowp = O + (size_t)(row0 + ai * HALF + m * 16) * ldc + col0;
#pragma unroll
                for (int bj = 0; bj < 2; ++bj) { f32x4 v0 = acc[ai][bj][m][0], v1 = acc[ai][bj][m][1];
                    if (ACT == 1) { f32x2 a = gelu_pk((f32x2){v0[0], v0[1]}), b = gelu_pk((f32x2){v0[2], v0[3]}), c = gelu_pk((f32x2){v1[0], v1[1]}), d = gelu_pk((f32x2){v1[2], v1[3]});
                        v0 = (f32x4){a.x, a.y, b.x, b.y}; v1 = (f32x4){c.x, c.y, d.x, d.y}; }
                    *(u32x4*)(rowp + bj * HALF) = pack8(v0, v1); } }
    }
};
struct EpiGeluStats {
    static constexpr bool PERM = true;
    __device__ __forceinline__ void prefetch(const Unit&, unsigned, int, int) const {}
    bf16_t* O; float* part;
    __device__ __forceinline__ void operator()(const f32x4 (&acc)[2][2][4][2], const Unit& u, int wr, int wc, int fr, int fq, const LAS unsigned char*) const {
        const int row0 = u.pm * BM + wr * 64 + fr, col0 = u.pn * BM + wc * 32 + 8 * fq;
#pragma unroll
        for (int ai = 0; ai < 2; ++ai)
#pragma unroll
            for (int m = 0; m < 4; ++m) { const int row = row0 + ai * HALF + m * 16; bf16_t* rowp = O + (size_t)row * 4096 + col0; float sm = 0.f, sq = 0.f;
#pragma unroll
                for (int bj = 0; bj < 2; ++bj) { f32x4 v0 = acc[ai][bj][m][0], v1 = acc[ai][bj][m][1];
                    { f32x2 a = gelu_pk((f32x2){v0[0], v0[1]}), b = gelu_pk((f32x2){v0[2], v0[3]}), c = gelu_pk((f32x2){v1[0], v1[1]}), d = gelu_pk((f32x2){v1[2], v1[3]});
                      v0 = (f32x4){a.x, a.y, b.x, b.y}; v1 = (f32x4){c.x, c.y, d.x, d.y}; }
                    sm += ((v0[0] + v0[1]) + (v0[2] + v0[3])) + ((v1[0] + v1[1]) + (v1[2] + v1[3]));
                    sq += ((v0[0] * v0[0] + v0[1] * v0[1]) + (v0[2] * v0[2] + v0[3] * v0[3])) + ((v1[0] * v1[0] + v1[1] * v1[1]) + (v1[2] * v1[2] + v1[3] * v1[3]));
                    *(u32x4*)(rowp + bj * HALF) = pack8(v0, v1); }
                if (u.pn >= 8) {
                    sm += swz_xor_f<16>(sm); sq += swz_xor_f<16>(sq);
                    { const auto r1 = __builtin_amdgcn_permlane32_swap(__float_as_uint(sm), __float_as_uint(sm), false, false); sm = __uint_as_float(r1[0]) + __uint_as_float(r1[1]);
                      const auto r2 = __builtin_amdgcn_permlane32_swap(__float_as_uint(sq), __float_as_uint(sq), false, false); sq = __uint_as_float(r2[0]) + __uint_as_float(r2[1]); }
                    if (fq == 0) *(f32x2*)(part + ((size_t)row * 32 + (u.pn - 8) * 4 + wc) * 2) = (f32x2){sm, sq}; } }
    }
};
struct EpiQKV {
    __device__ __forceinline__ void prefetch(const Unit&, unsigned, int, int) const {}
    static constexpr bool PERM = false;
    bf16_t* Q; size_t qkv_stride; const float* ropec; const float* ropes; unsigned char* V8;
    __device__ __forceinline__ void operator()(const f32x4 (&acc)[2][2][4][2], const Unit& u, int wr, int wc, int fr, int fq, const LAS unsigned char* epl) const {
        const int t = u.pn >> 2, colt = (u.pn & 3) * BM;
        if (t == 2) {
#pragma unroll
            for (int ai = 0; ai < 2; ++ai) {
                const int g0 = u.pm * BM + ai * HALF + wr * 64;
                const int b = g0 < NCTX ? (g0 >> 8) : ((g0 - NCTX) >> 13), jt = g0 < NCTX ? ((g0 & 255) >> 6) : 4 + (((g0 - NCTX) & (SEQ - 1)) >> 6);
#pragma unroll
                for (int bj = 0; bj < 2; ++bj) { const int h = (u.pn & 3) * 2 + bj;
                    unsigned char* img = V8 + ((size_t)((b * 8 + h) * 132 + jt)) * 8192 + (wc * 32 + 4 * fq) * 64 + 4 * fr;
#pragma unroll
                    for (int n = 0; n < 2; ++n)
#pragma unroll
                        for (int j = 0; j < 4; ++j) *(unsigned*)(img + (16 * n + j) * 64) = cvt_fp8x4(acc[ai][bj][0][n][j], acc[ai][bj][1][n][j], acc[ai][bj][2][n][j], acc[ai][bj][3][n][j]); } }
            return;
        }
        bf16_t* base = Q + (size_t)t * qkv_stride;
#pragma unroll
        for (int ai = 0; ai < 2; ++ai)
#pragma unroll
            for (int m = 0; m < 4; ++m) {
                const int row = u.pm * BM + ai * HALF + wr * 64 + m * 16 + fr;
                f32x4 cs = (f32x4){1.f, 1.f, 1.f, 1.f}, sn = (f32x4){0.f, 0.f, 0.f, 0.f};
                if (row >= NCTX) { const int tp = (row - NCTX) & (SEQ - 1); const int pos = (wc & 1) ? (tp & 63) : (tp >> 6);
                    cs = *(const f32x4*)(ropec + pos * 16 + 4 * fq); sn = *(const f32x4*)(ropes + pos * 16 + 4 * fq); }
#pragma unroll
                for (int bj = 0; bj < 2; ++bj) { const f32x4 x1 = acc[ai][bj][m][0], x2 = acc[ai][bj][m][1];
                    f32x4 o1 = x1 * cs - x2 * sn, o2 = x1 * sn + x2 * cs;
                    if (t == 0) { o1 = o1 * QK_PRESCALE; o2 = o2 * QK_PRESCALE; }
                    { unsigned char* r8 = (unsigned char*)base + (size_t)row * DM + colt + wc * 32 + 4 * fq + bj * HALF;
                        *(unsigned*)r8 = cvt_fp8x4_sat(o1[0], o1[1], o1[2], o1[3]); *(unsigned*)(r8 + 16) = cvt_fp8x4_sat(o2[0], o2[1], o2[2], o2[3]); } } }
    }
};
struct EpiConvIn {
    __device__ __forceinline__ void prefetch(const Unit&, unsigned, int, int) const {}
    static constexpr bool PERM = true;
    bf16_t* P; bf16_t* BG;
    __device__ __forceinline__ void operator()(const f32x4 (&acc)[2][2][4][2], const Unit& u, int wr, int wc, int fr, int fq, const LAS unsigned char* epl) const {
        const int row0 = u.pm * BM + wr * 64 + fr;
#pragma unroll
        for (int ai = 0; ai < 2; ++ai)
#pragma unroll
            for (int m = 0; m < 4; ++m) { const size_t row = (size_t)(row0 + ai * HALF + m * 16);
                if (u.pn < 8) { *(u32x4*)(P + row * DM + u.pn * HALF + wc * 32 + 8 * fq) = pack8(acc[ai][0][m][0] * acc[ai][1][m][0], acc[ai][0][m][1] * acc[ai][1][m][1]); }
                else {
#pragma unroll
                    for (int bj = 0; bj < 2; ++bj) *(u32x4*)(BG + row * DM + (u.pn - 8) * BM + bj * HALF + wc * 32 + 8 * fq) = pack8(acc[ai][bj][m][0], acc[ai][bj][m][1]); } }
    }
};
struct EpiRouter {
    __device__ __forceinline__ void prefetch(const Unit&, unsigned, int, int) const {}
    static constexpr bool PERM = false;
    float* L;
    __device__ __forceinline__ void operator()(const f32x4 (&acc)[2][2][4][2], const Unit& u, int wr, int wc, int fr, int fq, const LAS unsigned char* epl) const {
        if (wc != 0) return;
#pragma unroll
        for (int ai = 0; ai < 2; ++ai)
#pragma unroll
            for (int m = 0; m < 4; ++m) { float* rowp = L + (size_t)(u.pm * BM + ai * HALF + wr * 64 + m * 16 + fr) * NEXP + 4 * fq;
                *(f32x4*)(rowp) = acc[ai][0][m][0]; *(f32x4*)(rowp + 16) = acc[ai][0][m][1]; }
    }
};
struct EpiMoe1 {
    static constexpr bool PERM = true;
    bf16_t* ACT; const float* bgu;
    __device__ __forceinline__ void prefetch(const Unit& u, unsigned lds_dst, int wid, int lane) const {
        if (wid == 0) { const unsigned off = (unsigned)((u.e * 2048 + (lane >> 5) * 1024 + u.pn * HALF) * 4 + (lane & 31) * 16); glds16_s((const char*)bgu, off, lds_dst); } }
    __device__ __forceinline__ void operator()(const f32x4 (&acc)[2][2][4][2], const Unit& u, int wr, int wc, int fr, int fq, const LAS unsigned char* epl) const {
        const int ff0 = u.pn * HALF + wc * 32 + 8 * fq;
        f32x4 bg[2], bu[2];
#pragma unroll
        for (int n = 0; n < 2; ++n) { bg[n] = *(const LAS f32x4*)(epl + (wc * 32 + 8 * fq + 4 * n) * 4); bu[n] = *(const LAS f32x4*)(epl + 512 + (wc * 32 + 8 * fq + 4 * n) * 4); }
#pragma unroll
        for (int ai = 0; ai < 2; ++ai)
#pragma unroll
            for (int m = 0; m < 4; ++m) { const size_t row = (size_t)(u.pm * BM + ai * HALF + wr * 64 + m * 16 + fr);
                f32x4 o[2];
#pragma unroll
                for (int n = 0; n < 2; ++n) { const f32x4 gv = acc[ai][0][m][n] + bg[n], uv = acc[ai][1][m][n] + bu[n];
#pragma unroll
                    for (int jj = 0; jj < 2; ++jj) { f32x2 g, up; g.x = fminf(gv[2 * jj], 7.0f); g.y = fminf(gv[2 * jj + 1], 7.0f);
                        up.x = __builtin_amdgcn_fmed3f(uv[2 * jj], -7.0f, 7.0f); up.y = __builtin_amdgcn_fmed3f(uv[2 * jj + 1], -7.0f, 7.0f);
                        const f32x2 ea = g * (-1.702f * 1.4426950408889634f); f32x2 e; e.x = __builtin_amdgcn_exp2f(ea.x); e.y = __builtin_amdgcn_exp2f(ea.y);
                        const f32x2 de = e + 1.0f; f32x2 sg; sg.x = __builtin_amdgcn_rcpf(de.x); sg.y = __builtin_amdgcn_rcpf(de.y);
                        const f32x2 r = (up + 1.0f) * (g * sg); o[n][2 * jj] = r.x; o[n][2 * jj + 1] = r.y; } }
                u32x2 w8; w8.x = cvt_fp8x4(o[0][0], o[0][1], o[0][2], o[0][3]); w8.y = cvt_fp8x4(o[1][0], o[1][1], o[1][2], o[1][3]);
                *(u32x2*)((unsigned char*)ACT + row * DM + ff0) = w8; }
    }
};
struct EpiMoe2 {
    static constexpr bool PERM = true;
    bf16_t* YK; const float* bdn; const float* slot_gate;
    __device__ __forceinline__ void prefetch(const Unit& u, unsigned lds_dst, int wid, int lane) const {
        if (wid == 0) glds16_s((const char*)bdn, (unsigned)((u.e * 1024 + u.pn * BM) * 4 + lane * 16), lds_dst);
        else if (wid == 2) glds16_s((const char*)slot_gate, (unsigned)(u.pm * BM * 4 + lane * 16), lds_dst + 2048u); }
    __device__ __forceinline__ void operator()(const f32x4 (&acc)[2][2][4][2], const Unit& u, int wr, int wc, int fr, int fq, const LAS unsigned char* epl) const {
        const int col0 = u.pn * BM + wc * 32 + 8 * fq;
        f32x4 bv[2][2];
#pragma unroll
        for (int bj = 0; bj < 2; ++bj)
#pragma unroll
            for (int n = 0; n < 2; ++n) bv[bj][n] = *(const LAS f32x4*)(epl + (wc * 32 + 8 * fq + bj * HALF + 4 * n) * 4);
#pragma unroll
        for (int ai = 0; ai < 2; ++ai)
#pragma unroll
            for (int m = 0; m < 4; ++m) { const int sl = ai * HALF + wr * 64 + m * 16 + fr;
                const float gate = *(const LAS float*)(epl + 2048 + sl * 4);
                unsigned char* rowp = (unsigned char*)YK + (size_t)(u.pm * BM + sl) * DM + col0;
                const float g8 = gate * YK8_SCALE;
#pragma unroll
                for (int bj = 0; bj < 2; ++bj) { const f32x4 a0 = (acc[ai][bj][m][0] + bv[bj][0]) * g8, a1 = (acc[ai][bj][m][1] + bv[bj][1]) * g8;
                    u32x2 w8; w8.x = cvt_fp8x4(a0[0], a0[1], a0[2], a0[3]); w8.y = cvt_fp8x4(a1[0], a1[1], a1[2], a1[3]); *(u32x2*)(rowp + bj * HALF) = w8; } }
    }
};

__device__ __forceinline__ void glds16_s(const char* gbase, unsigned voff, unsigned lds_dst) { unsigned keep;
    asm volatile("s_mov_b32 %0, m0\n\ts_mov_b32 m0, %3\n\ts_nop 0\n\tglobal_load_lds_dwordx4 %1, %2\n\ts_mov_b32 m0, %0" : "=&s"(keep) : "v"(voff), "s"(gbase), "s"(lds_dst) : "memory"); }
template <class Epi, class Sched, bool ALIGN_EPI, bool FP8 = false>
__device__ __forceinline__ void gemm_phase(LAS unsigned char* lds, const bf16_t* A, const bf16_t* Bt, const int K, const Sched& S, const Epi& E, const int wave_in) {
    const int tid = opaque_tid(wave_in); const int wid = __builtin_amdgcn_readfirstlane(tid >> 6), lane = tid & 63, wr = wid >> 2, wc = wid & 3, fr = lane & 15, fq = lane >> 4;
    const int nt = K / BK;
    int sR[2], sC[2]; unsigned voffB[2];
#pragma unroll
    for (int i = 0; i < 2; ++i) { stage_rc(tid * 16 + i * 8192, sR[i], sC[i]); const int Rb = Epi::PERM ? ((sR[i] & ~31) + perm32(sR[i] & 31)) : sR[i];
        voffB[i] = (unsigned)(Rb * K + sC[i]) * 2u; }
    const size_t kstep = (size_t)(BK * 2);
    const size_t hstep = (size_t)HALF * K * 2;
    const unsigned ldsw = (unsigned)wid * 1024u;
    const unsigned ldsbase = (unsigned)__builtin_amdgcn_readfirstlane((int)((unsigned)(uintptr_t)lds + ldsw));
    const int aoff = lds_byte(wr * 64 + fr, fq * 8), boff = lds_byte(wc * 32 + fr, fq * 8);
#define PG8_SA(b, h) (((b) * 2 + (h)) * HTB)
#define PG8_SB(b, h) ((4 + (b) * 2 + (h)) * HTB)
#define PG8_STAGE(bufoff, gbase, v0, v1) do { glds16_s((gbase), (v0), ldsbase + (unsigned)(bufoff)); glds16_s((gbase), (v1), ldsbase + (unsigned)(bufoff) + 8192u); } while (0)
#define PG8_LDA(dst, b, h) do { _Pragma("unroll") for (int m = 0; m < 4; ++m) _Pragma("unroll") for (int k = 0; k < 2; ++k) dst[m][k] = *(const LAS bf16x8*)(lds + PG8_SA(b, h) + aoff + m * 2048 + k * 1024); } while (0)
#define PG8_LDB(dst, b, h) do { _Pragma("unroll") for (int n = 0; n < 2; ++n) _Pragma("unroll") for (int k = 0; k < 2; ++k) dst[n][k] = *(const LAS bf16x8*)(lds + PG8_SB(b, h) + boff + n * 2048 + k * 1024); } while (0)
#define PG8_CAT(x, y) __builtin_bit_cast(i32x8, __builtin_shufflevector(x, y, 0, 1, 2, 3, 4, 5, 6, 7, 8, 9, 10, 11, 12, 13, 14, 15))
#define PG8_MMA(ai, bj, At, Bt_) do { __builtin_amdgcn_s_setprio(1); _Pragma("unroll") for (int m = 0; m < 4; ++m) _Pragma("unroll") for (int n = 0; n < 2; ++n) { \
        if constexpr (FP8) asm volatile("v_mfma_scale_f32_16x16x128_f8f6f4 %0, %1, %2, %0, %3, %4 op_sel_hi:[0,0,0]" : "+v"(acc[ai][bj][m][n]) : "v"(PG8_CAT(Bt_[n][0], Bt_[n][1])), "v"(PG8_CAT(At[m][0], At[m][1])), "v"(sclW), "v"(sclA)); \
        else { _Pragma("unroll") for (int k = 0; k < 2; ++k) acc[ai][bj][m][n] = __builtin_amdgcn_mfma_f32_16x16x32_bf16(Bt_[n][k], At[m][k], acc[ai][bj][m][n], 0, 0, 0); } } __builtin_amdgcn_s_setprio(0); } while (0)
#define PG8_WAIT_V(n) asm volatile("s_waitcnt vmcnt(" #n ")" ::: "memory")
#define PG8_WAIT_L(n) asm volatile("s_waitcnt lgkmcnt(" #n ")" ::: "memory")
#define PG8_BAR __builtin_amdgcn_s_barrier()
#define PG8_SCHED __builtin_amdgcn_sched_barrier(0)
#define PG8_AOFF(dst, u) do { _Pragma("unroll") for (int h = 0; h < 2; ++h) _Pragma("unroll") for (int i = 0; i < 2; ++i) dst[h][i] = (S.a_row(u, h * HALF + sR[i]) * (unsigned)K + (unsigned)sC[i]) * 2u; } while (0)
    Unit cur, nxt; int ui = 0;
    if (!S.next(0, cur)) return;
    f32x4 acc[2][2][4][2];
#pragma unroll
    for (int a = 0; a < 2; ++a)
#pragma unroll
        for (int b = 0; b < 2; ++b)
#pragma unroll
            for (int m = 0; m < 4; ++m)
#pragma unroll
                for (int n = 0; n < 2; ++n) acc[a][b][m][n] = (f32x4){0.f, 0.f, 0.f, 0.f};
    bf16x8 At[4][2], B0[2][2], B1[2][2];
    const int sclW = W8_E8M0, sclA = A8_E8M0;
    unsigned vA[2][2], vN[2][2];
    PG8_AOFF(vA, cur);
    const char* const cA = (const char*)A;
    const char* cB = (const char*)Bt + S.b_off(cur) * 2;
    PG8_STAGE(PG8_SB(0, 0), cB, voffB[0], voffB[1]); PG8_STAGE(PG8_SB(0, 1), cB + hstep, voffB[0], voffB[1]); PG8_STAGE(PG8_SA(0, 0), cA, vA[0][0], vA[0][1]); PG8_STAGE(PG8_SA(0, 1), cA, vA[1][0], vA[1][1]);
    if (wr == 1) PG8_BAR;
    PG8_WAIT_V(2); PG8_BAR;
    PG8_STAGE(PG8_SB(1, 0), cB + kstep, voffB[0], voffB[1]); PG8_STAGE(PG8_SA(1, 0), cA + kstep, vA[0][0], vA[0][1]); PG8_STAGE(PG8_SB(1, 1), cB + hstep + kstep, voffB[0], voffB[1]);
    PG8_WAIT_V(6); PG8_BAR;
    for (;;) {
        const bool has_next = S.next(ui + 1, nxt);
        const char* nB = cB;
        E.prefetch(cur, (unsigned)__builtin_amdgcn_readfirstlane((int)((unsigned)(uintptr_t)lds + (unsigned)(EPI_LDS_OFF - 0) + (unsigned)((ui & 1) * EPI_LDS_BUF))), wid, lane);
        if (has_next) { nB = (const char*)Bt + S.b_off(nxt) * 2;
#pragma unroll
            for (int h = 0; h < 2; ++h)
#pragma unroll
                for (int i = 0; i < 2; ++i) { if constexpr (Sched::ASYNC_ROWS) vN[h][i] = S.a_row_async(nxt, h * HALF + sR[i]);
                                              else vN[h][i] = (S.a_row(nxt, h * HALF + sR[i]) * (unsigned)K + (unsigned)sC[i]) * 2u; } }
        else {
#pragma unroll
            for (int h = 0; h < 2; ++h)
#pragma unroll
                for (int i = 0; i < 2; ++i) vN[h][i] = vA[h][i]; }
#pragma clang loop unroll(disable)
        for (int t = 0; t < nt; t += 2) {
            const bool last = (t == nt - 2);
            const char* a1 = cA + (size_t)(t + 1) * kstep;
            const char* a2 = last ? cA : cA + (size_t)(t + 2) * kstep; const char* b2 = last ? nB : cB + (size_t)(t + 2) * kstep;
            const char* a3 = a2 + kstep; const char* b3 = b2 + kstep;
            if constexpr (Sched::ASYNC_ROWS) { if (last && has_next) { asm volatile("" : "+v"(vN[0][0]), "+v"(vN[0][1]), "+v"(vN[1][0]), "+v"(vN[1][1]));
#pragma unroll
                for (int h = 0; h < 2; ++h)
#pragma unroll
                    for (int i = 0; i < 2; ++i) vN[h][i] = (vN[h][i] * (unsigned)K + (unsigned)sC[i]) * 2u; } }
            const unsigned w00 = last ? vN[0][0] : vA[0][0], w01 = last ? vN[0][1] : vA[0][1], w10 = last ? vN[1][0] : vA[1][0], w11 = last ? vN[1][1] : vA[1][1];
            PG8_LDB(B0, 0, 0); PG8_LDB(B1, 0, 1); PG8_SCHED; PG8_LDA(At, 0, 0); PG8_STAGE(PG8_SA(1, 1), a1, vA[1][0], vA[1][1]);
            PG8_WAIT_V(8); PG8_WAIT_L(0); PG8_BAR; PG8_MMA(0, 0, At, B0); PG8_MMA(0, 1, At, B1); PG8_BAR; PG8_SCHED;
            PG8_LDA(At, 0, 1); PG8_STAGE(PG8_SB(0, 0), b2, voffB[0], voffB[1]); PG8_STAGE(PG8_SB(0, 1), b2 + hstep, voffB[0], voffB[1]); PG8_STAGE(PG8_SA(0, 0), a2, w00, w01);
            PG8_WAIT_V(8); PG8_WAIT_L(0); PG8_BAR; PG8_MMA(1, 0, At, B0); PG8_MMA(1, 1, At, B1); PG8_BAR; PG8_SCHED;
            PG8_LDB(B0, 1, 0); PG8_LDB(B1, 1, 1); PG8_SCHED; PG8_LDA(At, 1, 0); PG8_STAGE(PG8_SA(0, 1), a2, w10, w11);
            PG8_WAIT_V(8); PG8_WAIT_L(0); PG8_BAR; PG8_MMA(0, 0, At, B0); PG8_MMA(0, 1, At, B1); PG8_BAR; PG8_SCHED;
            PG8_LDA(At, 1, 1); PG8_STAGE(PG8_SB(1, 0), b3, voffB[0], voffB[1]); PG8_STAGE(PG8_SB(1, 1), b3 + hstep, voffB[0], voffB[1]); PG8_STAGE(PG8_SA(1, 0), a3, w00, w01);
            PG8_WAIT_V(8); PG8_WAIT_L(0); PG8_BAR; PG8_MMA(1, 0, At, B0); PG8_MMA(1, 1, At, B1); PG8_BAR; PG8_SCHED;
        }
        if constexpr (FP8) asm volatile("s_nop 15\n\ts_nop 15" ::: "memory");
        if constexpr (ALIGN_EPI) { if (wr == 0) PG8_BAR; }
        { int fr_ = fr, fq_ = fq; asm volatile("" : "+v"(fr_), "+v"(fq_)); E(acc, cur, wr, wc, fr_, fq_, lds + EPI_LDS_OFF + (ui & 1) * EPI_LDS_BUF); }
        if (!has_next) break;
#pragma unroll
        for (int a = 0; a < 2; ++a)
#pragma unroll
            for (int b = 0; b < 2; ++b)
#pragma unroll
                for (int m = 0; m < 4; ++m)
#pragma unroll
                    for (int n = 0; n < 2; ++n) acc[a][b][m][n] = (f32x4){0.f, 0.f, 0.f, 0.f};
        cur = nxt; cB = nB; ++ui;
#pragma unroll
        for (int h = 0; h < 2; ++h)
#pragma unroll
            for (int i = 0; i < 2; ++i) vA[h][i] = vN[h][i];
        if constexpr (ALIGN_EPI) { if (wr == 1) PG8_BAR; }
    }
    PG8_WAIT_V(0);
    if constexpr (!ALIGN_EPI) { if (wr == 0) PG8_BAR; }
    PG8_BAR;
#undef PG8_SA
#undef PG8_SB
#undef PG8_STAGE
#undef PG8_LDA
#undef PG8_LDB
#undef PG8_MMA
#undef PG8_WAIT_V
#undef PG8_WAIT_L
#undef PG8_BAR
#undef PG8_SCHED
#undef PG8_AOFF
#undef PG8_CAT
}
}

namespace att {
constexpr int QBLK = 32, KVBLK = 64;
constexpr float SCALE = 0.125f;
constexpr float THR = 8.f;
constexpr int SHM_V = KVBLK * 128 * 2, SHM_K = KVBLK * 128 * 2;
constexpr int LDS_WSF = 2 * SHM_V + 2 * SHM_K;
#define KSWZ(row, colB) ((row) * 256 + ((colB) ^ (((row) & 7) << 4)))
#define SBAR() __builtin_amdgcn_sched_barrier(0)
__device__ __forceinline__ int crow(int r, int hi) { return (r & 3) + 8 * (r >> 2) + 4 * hi; }

__device__ __forceinline__ void qkt(f32x16& p0, f32x16& p1, const char* Ks, const bf16x8* qr, int r32, int hi, int cq) {
  p0 = f32x16{}; p1 = f32x16{};
#pragma unroll
  for (int d0 = 0; d0 < 4; ++d0) { const int cb = (cq * 64 + d0 * 16 + hi * 8) * 2;
    const bf16x8 b0 = *reinterpret_cast<const bf16x8*>(Ks + KSWZ(r32, cb));
    const bf16x8 b1 = *reinterpret_cast<const bf16x8*>(Ks + KSWZ(32 + r32, cb));
    p0 = __builtin_amdgcn_mfma_f32_32x32x16_bf16(b0, qr[d0], p0, 0, 0, 0);
    p1 = __builtin_amdgcn_mfma_f32_32x32x16_bf16(b1, qr[d0], p1, 0, 0, 0); }
}
__device__ __forceinline__ int v_st(int k, int c) { const int kk = (k & ~0xC) | ((k & 4) << 1) | ((k & 8) >> 1); return ((kk >> 3) * 4 + (c >> 5)) * 512 + ((kk & 7) * 32 + (c & 31)) * 2; }
__device__ __forceinline__ int v_rd_base(int lane) { return ((lane & 3) << 3) | (((lane >> 2) & 3) << 6) | (((lane >> 4) & 1) << 5) | (((lane >> 5) & 1) << 8); }
constexpr int v_rd_off(int d0, int ks, int half) { return d0 * 512 + ks * 4096 + half * 2048; }
template <int OFF> __device__ __forceinline__ s16x4 tr_read(int vb) {
  s16x4 r; asm volatile("ds_read_b64_tr_b16 %0, %1 offset:%2" : "=&v"(r) : "v"(vb), "i"(OFF) : "memory"); return r;
}
template <int D0> __device__ __forceinline__ void pv_one(f32x16& od, int vb, bf16x8 pa0, bf16x8 pa1, bf16x8 pa2, bf16x8 pa3) {
  const s16x4 l0 = tr_read<v_rd_off(D0, 0, 0)>(vb), h0 = tr_read<v_rd_off(D0, 0, 1)>(vb), l1 = tr_read<v_rd_off(D0, 1, 0)>(vb), h1 = tr_read<v_rd_off(D0, 1, 1)>(vb);
  const s16x4 l2 = tr_read<v_rd_off(D0, 2, 0)>(vb), h2 = tr_read<v_rd_off(D0, 2, 1)>(vb), l3 = tr_read<v_rd_off(D0, 3, 0)>(vb), h3 = tr_read<v_rd_off(D0, 3, 1)>(vb);
  asm volatile("s_waitcnt lgkmcnt(0)" ::: "memory"); SBAR();
#define PK(L, H) (bf16x8){L[0], L[1], L[2], L[3], H[0], H[1], H[2], H[3]}
  od = __builtin_amdgcn_mfma_f32_32x32x16_bf16(pa0, PK(l0, h0), od, 0, 0, 0);
  od = __builtin_amdgcn_mfma_f32_32x32x16_bf16(pa1, PK(l1, h1), od, 0, 0, 0);
  od = __builtin_amdgcn_mfma_f32_32x32x16_bf16(pa2, PK(l2, h2), od, 0, 0, 0);
  od = __builtin_amdgcn_mfma_f32_32x32x16_bf16(pa3, PK(l3, h3), od, 0, 0, 0);
#undef PK
}
__device__ __forceinline__ void pv_d0(f32x16* o, int vb, bf16x8 pa0, bf16x8 pa1, bf16x8 pa2, bf16x8 pa3) {
  pv_one<0>(o[0], vb, pa0, pa1, pa2, pa3); pv_one<1>(o[1], vb, pa0, pa1, pa2, pa3); pv_one<2>(o[2], vb, pa0, pa1, pa2, pa3); pv_one<3>(o[3], vb, pa0, pa1, pa2, pa3);
}


__device__ __forceinline__ void attn_unit_pp(const bf16_t* __restrict__ Q, const bf16_t* __restrict__ Kb, const bf16_t* __restrict__ Vb, bf16_t* __restrict__ O,
                                             int qrow0, int kc0, int kl0, int NT, int h, float lam, const float* __restrict__ subg, char* lds, const int wave_in) {
  const int tid = opaque_tid(wave_in);
  const int wid = __builtin_amdgcn_readfirstlane(tid >> 6), lane = tid & 63, r32 = lane & 31, hi = lane >> 5;
  const int cq = wid >> 2, wq = wid & 3;
  char* V_lds = lds; char* K_lds = lds + 3 * SHM_V;
  float* ws = (float*)(lds + 6 * SHM_V) + wid * 64; float* li_l = ws; float* al_l = ws + 32;
  float m_reg = -1e30f, l_reg = 0; f32x16 o[4] = {}; bf16x8 qr[4];
  const bf16_t* Qw = Q + (size_t)(qrow0 + wq * QBLK + r32) * DM + h * 128 + cq * 64 + hi * 8;
#pragma unroll
  for (int d0 = 0; d0 < 4; ++d0) qr[d0] = *reinterpret_cast<const bf16x8*>(Qw + d0 * 16);
  const int vb0 = (int)(uintptr_t)V_lds + v_rd_base(lane);
  unsigned koff[2], voff[2];
#pragma unroll
  for (int i = 0; i < 2; ++i) { const int pc = 2 * wid + i;
    { const int row = 4 * pc + (lane >> 4), cpos = (lane & 15) << 4, colB = cpos ^ ((row & 7) << 4); koff[i] = (unsigned)(row * (DM * 2) + colB); }
    { const int kg = pc >> 1, cb0 = (pc & 1) * 2, sub = lane >> 5, kr = (lane & 31) >> 2, chunk = lane & 3; const int kk = kg * 8 + kr, k = (kk & ~0xC) | ((kk & 4) << 1) | ((kk & 8) >> 1), c = (cb0 + sub) * 32 + chunk * 8;
      voff[i] = (unsigned)(k * (DM * 2) + c * 2); } }
  const unsigned ldsK = (unsigned)__builtin_amdgcn_readfirstlane((int)((unsigned)(uintptr_t)K_lds + (unsigned)wid * 2048u));
  const unsigned ldsV = (unsigned)__builtin_amdgcn_readfirstlane((int)((unsigned)(uintptr_t)V_lds + (unsigned)wid * 2048u));
  const char* Kh = (const char*)(Kb + h * 128); const char* Vh = (const char*)(Vb + h * 128);
#define KROWB(j) ((size_t)((j) < 4 ? kc0 + 64 * (j) : kl0 + 64 * ((j) - 4)) * (DM * 2))
#define ISSUE_P(t, so, i) do { if ((i) < 2) { if ((t) < NT) pg8::glds16_s(Kh + KROWB(t), koff[(i) & 1], ldsK + (unsigned)(so) + (unsigned)((i) & 1) * 1024u); } \
    else { if ((t) >= 1 && (t) <= NT) pg8::glds16_s(Vh + KROWB((t) - 1), voff[(i) & 1], ldsV + (unsigned)(so) + (unsigned)((i) & 1) * 1024u); } } while (0)
#define ISSUE_L(t, so) do { const unsigned so_ = (unsigned)(so); \
    if ((t) < NT) { const char* kb_ = Kh + KROWB(t); pg8::glds16_s(kb_, koff[0], ldsK + so_); pg8::glds16_s(kb_, koff[1], ldsK + so_ + 1024u); } \
    if ((t) >= 1) { const char* vb_ = Vh + KROWB((t) - 1); pg8::glds16_s(vb_, voff[0], ldsV + so_); pg8::glds16_s(vb_, voff[1], ldsV + so_ + 1024u); } } while (0)
#define PBAR() asm volatile("s_waitcnt lgkmcnt(0)\n\ts_barrier" ::: "memory")
#define PBAR_V0() asm volatile("s_waitcnt vmcnt(0) lgkmcnt(0)\n\ts_barrier" ::: "memory")
#define PBAR_V4() asm volatile("s_waitcnt vmcnt(4) lgkmcnt(0)\n\ts_barrier" ::: "memory")
#define NEXT3(x) (((x) == 32768) ? 0 : (x) + 16384)
#define RESC(a) do { if (__any((a) < 1.f)) { if (hi == 0) al_l[r32] = (a); asm volatile("s_waitcnt lgkmcnt(0)" ::: "memory"); \
    _Pragma("unroll") for (int d = 0; d < 4; ++d) _Pragma("unroll") for (int r = 0; r < 16; ++r) o[d][r] *= al_l[crow(r, hi)]; } } while (0)
  f32x16 p0, p1; bf16x8 pa0, pa1, pa2, pa3;
  f32x16 negm = f32x16{}; asm volatile("" : "+v"(negm));
  m_reg = 0.f;
#define VRD4(L, H, D0, vb_) do { _Pragma("unroll") for (int ks_ = 0; ks_ < 4; ++ks_) { \
      asm volatile("ds_read_b64_tr_b16 %0, %1 offset:%2" : "=&v"(L[ks_]) : "v"(vb_), "i"((D0) * 512 + ks_ * 4096) : "memory"); \
      asm volatile("ds_read_b64_tr_b16 %0, %1 offset:%2" : "=&v"(H[ks_]) : "v"(vb_), "i"((D0) * 512 + ks_ * 4096 + 2048) : "memory"); } } while (0)
#define PVB(L, H, D0) do { \
      o[D0] = __builtin_amdgcn_mfma_f32_32x32x16_bf16(pa0, (bf16x8){L[0][0], L[0][1], L[0][2], L[0][3], H[0][0], H[0][1], H[0][2], H[0][3]}, o[D0], 0, 0, 0); \
      o[D0] = __builtin_amdgcn_mfma_f32_32x32x16_bf16(pa1, (bf16x8){L[1][0], L[1][1], L[1][2], L[1][3], H[1][0], H[1][1], H[1][2], H[1][3]}, o[D0], 0, 0, 0); \
      o[D0] = __builtin_amdgcn_mfma_f32_32x32x16_bf16(pa2, (bf16x8){L[2][0], L[2][1], L[2][2], L[2][3], H[2][0], H[2][1], H[2][2], H[2][3]}, o[D0], 0, 0, 0); \
      o[D0] = __builtin_amdgcn_mfma_f32_32x32x16_bf16(pa3, (bf16x8){L[3][0], L[3][1], L[3][2], L[3][3], H[3][0], H[3][1], H[3][2], H[3][3]}, o[D0], 0, 0, 0); } while (0)
#define LGK(n) do { asm volatile("s_waitcnt lgkmcnt(" #n ")" ::: "memory"); SBAR(); } while (0)
#define XFULL(so, ti, si) do { const int so_ = (so); const int vb_ = vb0 + so_; s16x4 la[4], ha[4], lb[4], hb[4]; bf16x8 kf0[4], kf1[4]; const char* Ks_ = K_lds + so_; \
      _Pragma("unroll") for (int d0 = 0; d0 < 4; ++d0) { const int cb = (cq * 64 + d0 * 16 + hi * 8) * 2; kf0[d0] = *reinterpret_cast<const bf16x8*>(Ks_ + KSWZ(r32, cb)); kf1[d0] = *reinterpret_cast<const bf16x8*>(Ks_ + KSWZ(32 + r32, cb)); } \
      asm volatile("" ::: "memory"); VRD4(la, ha, 0, vb_); \
      LGK(8);                                                             \
      p0 = __builtin_amdgcn_mfma_f32_32x32x16_bf16(kf0[0], qr[0], negm, 0, 0, 0); p1 = __builtin_amdgcn_mfma_f32_32x32x16_bf16(kf1[0], qr[0], negm, 0, 0, 0); \
      _Pragma("unroll") for (int d0 = 1; d0 < 4; ++d0) { p0 = __builtin_amdgcn_mfma_f32_32x32x16_bf16(kf0[d0], qr[d0], p0, 0, 0, 0); p1 = __builtin_amdgcn_mfma_f32_32x32x16_bf16(kf1[d0], qr[d0], p1, 0, 0, 0); } \
      SBAR(); VRD4(lb, hb, 1, vb_); LGK(8); PVB(la, ha, 0); \
      SBAR(); VRD4(la, ha, 2, vb_); LGK(8); PVB(lb, hb, 1); \
      SBAR(); VRD4(lb, hb, 3, vb_); LGK(8); PVB(la, ha, 2); \
      LGK(0); PVB(lb, hb, 3); } while (0)
#define XFIRST() do { bf16x8 kf0[4], kf1[4]; \
      _Pragma("unroll") for (int d0 = 0; d0 < 4; ++d0) { const int cb = (cq * 64 + d0 * 16 + hi * 8) * 2; kf0[d0] = *reinterpret_cast<const bf16x8*>(K_lds + KSWZ(r32, cb)); kf1[d0] = *reinterpret_cast<const bf16x8*>(K_lds + KSWZ(32 + r32, cb)); } \
      p0 = __builtin_amdgcn_mfma_f32_32x32x16_bf16(kf0[0], qr[0], negm, 0, 0, 0); p1 = __builtin_amdgcn_mfma_f32_32x32x16_bf16(kf1[0], qr[0], negm, 0, 0, 0); \
      _Pragma("unroll") for (int d0 = 1; d0 < 4; ++d0) { p0 = __builtin_amdgcn_mfma_f32_32x32x16_bf16(kf0[d0], qr[d0], p0, 0, 0, 0); p1 = __builtin_amdgcn_mfma_f32_32x32x16_bf16(kf1[d0], qr[d0], p1, 0, 0, 0); } } while (0)
#define XLAST(so) do { pv_d0(o, vb0 + (so), pa0, pa1, pa2, pa3); } while (0)
#define MX3(a, b, c) __builtin_fmaxf(__builtin_fmaxf((a), (b)), (c))
#define PK4(P, BASE, OUT) do { unsigned a0 = cvt_pk_bf16(P[BASE + 0], P[BASE + 1]), a1 = cvt_pk_bf16(P[BASE + 2], P[BASE + 3]);   \
    unsigned b0 = cvt_pk_bf16(P[BASE + 4], P[BASE + 5]), b1 = cvt_pk_bf16(P[BASE + 6], P[BASE + 7]);                              \
    auto r0 = __builtin_amdgcn_permlane32_swap(a0, b0, false, false); auto r1 = __builtin_amdgcn_permlane32_swap(a1, b1, false, false); \
    u32x4 w = {r0[0], r1[0], r0[1], r1[1]}; OUT = __builtin_bit_cast(bf16x8, w); } while (0)
#define YSOFT(FIRST) do { \
    float a_ = MX3(p0[0], p0[1], p1[0]), b_ = MX3(p0[2], p0[3], p1[1]); a_ = MX3(a_, p1[2], p1[3]); \
    _Pragma("unroll") for (int r = 4; r < 16; r += 4) { a_ = MX3(a_, p0[r], p0[r + 1]); b_ = MX3(b_, p0[r + 2], p0[r + 3]); a_ = MX3(a_, p1[r], p1[r + 1]); b_ = MX3(b_, p1[r + 2], p1[r + 3]); } \
    float rm_ = __builtin_fmaxf(a_, b_); { auto rr = __builtin_amdgcn_permlane32_swap(__float_as_uint(rm_), __float_as_uint(rm_), false, false); rm_ = __builtin_fmaxf(__uint_as_float(rr[0]), __uint_as_float(rr[1])); } \
    if ((FIRST) || __any(rm_ > 8.0f)) { const float dl_ = (FIRST) ? rm_ : __builtin_fmaxf(rm_, 0.f); m_reg += dl_; \
      _Pragma("unroll") for (int r = 0; r < 16; ++r) { p0[r] -= dl_; p1[r] -= dl_; } \
      _Pragma("unroll") for (int r = 0; r < 16; ++r) negm[r] = -m_reg; asm volatile("" : "+v"(negm)); \
      if (!(FIRST)) { const float f_ = __builtin_amdgcn_exp2f(-dl_); l_reg *= f_; RESC(f_); } } \
    _Pragma("unroll") for (int r = 0; r < 16; ++r) p0[r] = __builtin_amdgcn_exp2f(p0[r]); \
    _Pragma("unroll") for (int r = 0; r < 16; ++r) p1[r] = __builtin_amdgcn_exp2f(p1[r]); \
    float s0_ = p0[0] + p0[1], s1_ = p0[2] + p0[3], s2_ = p1[0] + p1[1], s3_ = p1[2] + p1[3]; \
    _Pragma("unroll") for (int r = 4; r < 16; r += 4) { s0_ += p0[r] + p0[r + 1]; s1_ += p0[r + 2] + p0[r + 3]; s2_ += p1[r] + p1[r + 1]; s3_ += p1[r + 2] + p1[r + 3]; } \
    float ps_ = (s0_ + s1_) + (s2_ + s3_); { auto rr = __builtin_amdgcn_permlane32_swap(__float_as_uint(ps_), __float_as_uint(ps_), false, false); ps_ = __uint_as_float(rr[0]) + __uint_as_float(rr[1]); } \
    l_reg += ps_; \
    PK4(p0, 0, pa0); PK4(p0, 8, pa1); PK4(p1, 0, pa2); PK4(p1, 8, pa3); } while (0)
#define YPH() YSOFT(false)
  ISSUE_L(0, 0); ISSUE_L(1, 16384); PBAR_V4();
  int sx = 16384, si = 32768;
  if (cq == 0) {
    XFIRST(); PBAR();
    ISSUE_L(2, si); si = NEXT3(si); YSOFT(true); PBAR_V4();
    for (int t = 1; t < NT; ++t) {
      XFULL(sx, 0, 0); sx = NEXT3(sx); PBAR();
      if (t + 2 <= NT) { ISSUE_L(t + 2, si); si = NEXT3(si); }
      YPH(); if (t + 2 < NT) PBAR_V4(); else PBAR_V0();
    }
    XLAST(sx); PBAR();
    PBAR();
  } else {
    __builtin_amdgcn_s_setprio(1);
    ISSUE_L(2, si); si = NEXT3(si); PBAR();
    XFIRST(); PBAR_V4();
    ISSUE_L(3, si); si = NEXT3(si); YSOFT(true); PBAR();
    XFULL(sx, 0, 0); sx = NEXT3(sx); if (3 < NT) PBAR_V4(); else PBAR_V0();
    for (int t = 2; t < NT; ++t) {
      if (t + 2 <= NT) { ISSUE_L(t + 2, si); si = NEXT3(si); }
      YPH(); PBAR();
      XFULL(sx, 0, 0); sx = NEXT3(sx); if (t + 2 < NT) PBAR_V4(); else PBAR_V0();
    }
    YPH(); PBAR();
    XLAST(sx); PBAR();
    __builtin_amdgcn_s_setprio(0);
  }
#undef XFULL
#undef XFIRST
#undef XLAST
#undef YPH
#undef YSOFT
#undef MX3
#undef PK4
#undef VRD4
#undef PVB
#undef LGK
#undef ISSUE_L
#undef KROWB
  if (hi == 0) li_l[r32] = l_reg; asm volatile("s_waitcnt lgkmcnt(0)" ::: "memory");
  float rli[16];
#pragma unroll
  for (int r = 0; r < 16; ++r) rli[r] = __builtin_amdgcn_rcpf(li_l[crow(r, hi)]);
  PBAR_V0();
  float* xb = (float*)lds + wq * (32 * 128);
  if (cq == 1) {
#pragma unroll
    for (int r = 0; r < 16; ++r)
#pragma unroll
      for (int d0 = 0; d0 < 4; ++d0) xb[crow(r, hi) * 128 + d0 * 32 + r32] = o[d0][r] * rli[r];
  }
  PBAR();
  if (cq == 0) {
    float ss[16];
#pragma unroll
    for (int r = 0; r < 16; ++r) { float s = 0.f;
#pragma unroll
      for (int d0 = 0; d0 < 4; ++d0) { const float v = o[d0][r] * rli[r] - lam * xb[crow(r, hi) * 128 + d0 * 32 + r32]; o[d0][r] = v; s += v * v; }
      ss[r] = s; }
#pragma unroll
    for (int r = 0; r < 16; ++r) { float s = half_sum32(ss[r]); ss[r] = __builtin_amdgcn_rsqf(s * (1.0f / 128.0f) + LN_EPS) * (1.0f - LAM_INIT); }
    float gsub[4];
#pragma unroll
    for (int d0 = 0; d0 < 4; ++d0) gsub[d0] = subg[d0 * 32 + r32];
    bf16_t* Ow = O + (size_t)(qrow0 + wq * QBLK) * DM + h * 128;
#pragma unroll
    for (int r = 0; r < 16; ++r) { const int orow = crow(r, hi);
#pragma unroll
      for (int d0 = 0; d0 < 4; ++d0) Ow[(size_t)orow * DM + d0 * 32 + r32] = (bf16_t)f2bf(o[d0][r] * ss[r] * gsub[d0]); }
  }
  PBAR_V0();
#undef PBAR
#undef PBAR_V0
#undef PBAR_V4
#undef NEXT3
#undef ISSUE_P
#undef RESC
}

__device__ __forceinline__ void attn_unit_f8(const bf16_t* __restrict__ Q, const bf16_t* __restrict__ Kb, const unsigned char* __restrict__ V8, bf16_t* __restrict__ O,
                                             int qrow0, int kc0, int kl0, int NT, int h, float lam, const float* __restrict__ subg, char* lds, const int wave_in,
                                             const bool pref_in, const bool pref_out, const unsigned char* __restrict__ V8n, int kc0n, int hn, int qrow0n, i32x8& qf) {
  const int tid = opaque_tid(wave_in);
  const int wid = __builtin_amdgcn_readfirstlane(tid >> 6), lane = tid & 63, r32 = lane & 31, hi = lane >> 5;
  const int cq = wid >> 2, wq = wid & 3;
  char* V_lds = lds; char* K_lds = lds + 24576;
  float* ws = (float*)(lds + 49152) + wid * 64; float* li_l = ws; float* al_l = ws + 32;
  float m_reg = 0.f; f32x16 o[5] = {};
  if (!pref_in) { const unsigned char* Qw = (const unsigned char*)Q + (size_t)(qrow0 + wq * QBLK + r32) * DM + h * 128 + cq * 64 + hi * 32;
    const u32x4 qa = *reinterpret_cast<const u32x4*>(Qw), qb = *reinterpret_cast<const u32x4*>(Qw + 16); qf = (i32x8){(int)qa.x, (int)qa.y, (int)qa.z, (int)qa.w, (int)qb.x, (int)qb.y, (int)qb.z, (int)qb.w}; }
  unsigned koff, voff;
  { const int row = 8 * wid + (lane >> 3), cpos = lane & 7;
    const int key = 16 * (row & 3) + 8 * ((row >> 2) & 1) + ((row >> 3) & 3) + 4 * (row >> 5);
    koff = (unsigned)(key * DM + 16 * (cpos ^ ((row >> 1) & 7))); }
  { const int e = 16 * wid + (lane >> 2), cpos = lane & 3; voff = (unsigned)(e * 64 + 16 * (cpos ^ ((e >> 2) & 3))); }
  const unsigned ldsK = (unsigned)__builtin_amdgcn_readfirstlane((int)((unsigned)(uintptr_t)K_lds + (unsigned)wid * 1024u));
  const unsigned ldsV = (unsigned)__builtin_amdgcn_readfirstlane((int)((unsigned)(uintptr_t)V_lds + (unsigned)wid * 1024u));
  const char* Kh = (const char*)Kb + h * 128;
  const int fsw = (r32 >> 2) & 3;
  const char* vfa = V_lds + r32 * 64 + 16 * ((2 * hi) ^ fsw); const char* vfb = V_lds + r32 * 64 + 16 * ((2 * hi + 1) ^ fsw);
#define KROWB(j) ((size_t)((j) < 4 ? kc0 + 64 * (j) : kl0 + 64 * ((j) - 4)) * DM)
#define ISSUE_L(t, sl) do { \
    if ((t) < NT) pg8::glds16_s(Kh + KROWB(t), koff, ldsK + (unsigned)(sl) * 8192u); \
    if ((t) >= 1 && (t) <= NT) pg8::glds16_s((const char*)V8 + (size_t)((t) - 1) * 8192, voff, ldsV + (unsigned)(sl) * 8192u); } while (0)
#define PBAR() asm volatile("s_waitcnt lgkmcnt(0)\n\ts_barrier" ::: "memory")
#define PBAR_V0() asm volatile("s_waitcnt vmcnt(0) lgkmcnt(0)\n\ts_barrier" ::: "memory")
#define PBAR_V3() asm volatile("s_waitcnt vmcnt(2) lgkmcnt(0)\n\ts_barrier" ::: "memory")
#define NEXT3(x) (((x) == 2) ? 0 : (x) + 1)
#define RESC(a) do { if (__any((a) < 1.f)) { if (hi == 0) al_l[r32] = (a); asm volatile("s_waitcnt lgkmcnt(0)" ::: "memory"); \
    _Pragma("unroll") for (int d = 0; d < 5; ++d) _Pragma("unroll") for (int r = 0; r < 16; ++r) o[d][r] *= al_l[crow(r, hi)]; } } while (0)
  f32x16 p0, p1; i32x8 p8 = i32x8{};
  i32x8 onesf = (i32x8){0x38383838, 0x38383838, 0x38383838, 0x38383838, 0x38383838, 0x38383838, 0x38383838, 0x38383838}; asm volatile("" : "+v"(onesf));
  f32x16 negm = f32x16{}; asm volatile("" : "+v"(negm));
  const int scl1 = 0x7F7F7F7F;
#define QKT(sl) do { const char* Ks_ = K_lds + (sl) * 8192; const int c0_ = 4 * cq + 2 * hi; \
      const u32x4 ka0 = *reinterpret_cast<const u32x4*>(Ks_ + r32 * 128 + 16 * (c0_ ^ ((r32 >> 1) & 7))), ka1 = *reinterpret_cast<const u32x4*>(Ks_ + r32 * 128 + 16 * ((c0_ + 1) ^ ((r32 >> 1) & 7))); \
      const u32x4 kb0 = *reinterpret_cast<const u32x4*>(Ks_ + (32 + r32) * 128 + 16 * (c0_ ^ ((r32 >> 1) & 7))), kb1 = *reinterpret_cast<const u32x4*>(Ks_ + (32 + r32) * 128 + 16 * ((c0_ + 1) ^ ((r32 >> 1) & 7))); \
      const i32x8 kfa_ = (i32x8){(int)ka0.x, (int)ka0.y, (int)ka0.z, (int)ka0.w, (int)ka1.x, (int)ka1.y, (int)ka1.z, (int)ka1.w}, kfb_ = (i32x8){(int)kb0.x, (int)kb0.y, (int)kb0.z, (int)kb0.w, (int)kb1.x, (int)kb1.y, (int)kb1.z, (int)kb1.w}; \
      p0 = __builtin_amdgcn_mfma_scale_f32_32x32x64_f8f6f4(kfa_, qf, negm, 0, 0, 0, scl1, 0, scl1); p1 = __builtin_amdgcn_mfma_scale_f32_32x32x64_f8f6f4(kfb_, qf, negm, 0, 0, 0, scl1, 0, scl1); } while (0)
#define PV8(sl) do { u32x4 va_[4], vb_[4]; \
      _Pragma("unroll") for (int d0 = 0; d0 < 4; ++d0) { va_[d0] = *reinterpret_cast<const u32x4*>(vfa + (sl) * 8192 + d0 * 2048); vb_[d0] = *reinterpret_cast<const u32x4*>(vfb + (sl) * 8192 + d0 * 2048); } \
      _Pragma("unroll") for (int d0 = 0; d0 < 4; ++d0) { const i32x8 vf_ = (i32x8){(int)va_[d0].x, (int)va_[d0].y, (int)va_[d0].z, (int)va_[d0].w, (int)vb_[d0].x, (int)vb_[d0].y, (int)vb_[d0].z, (int)vb_[d0].w}; \
        o[d0] = __builtin_amdgcn_mfma_scale_f32_32x32x64_f8f6f4(p8, vf_, o[d0], 0, 0, 0, scl1, 0, scl1); } \
      o[4] = __builtin_amdgcn_mfma_scale_f32_32x32x64_f8f6f4(p8, onesf, o[4], 0, 0, 0, scl1, 0, scl1); } while (0)
#define MX3(a, b, c) __builtin_fmaxf(__builtin_fmaxf((a), (b)), (c))
#define YSOFT(FIRST) do { \
    float a_ = MX3(p0[0], p0[1], p1[0]), b_ = MX3(p0[2], p0[3], p1[1]); a_ = MX3(a_, p1[2], p1[3]); \
    _Pragma("unroll") for (int r = 4; r < 16; r += 4) { a_ = MX3(a_, p0[r], p0[r + 1]); b_ = MX3(b_, p0[r + 2], p0[r + 3]); a_ = MX3(a_, p1[r], p1[r + 1]); b_ = MX3(b_, p1[r + 2], p1[r + 3]); } \
    float rm_ = __builtin_fmaxf(a_, b_); { auto rr = __builtin_amdgcn_permlane32_swap(__float_as_uint(rm_), __float_as_uint(rm_), false, false); rm_ = __builtin_fmaxf(__uint_as_float(rr[0]), __uint_as_float(rr[1])); } \
    if ((FIRST) || __any(rm_ > 8.0f)) { const float dl_ = (FIRST) ? (rm_ - 6.0f) : __builtin_fmaxf(rm_ - 6.0f, 0.f); m_reg += dl_; \
      _Pragma("unroll") for (int r = 0; r < 16; ++r) { p0[r] -= dl_; p1[r] -= dl_; } \
      _Pragma("unroll") for (int r = 0; r < 16; ++r) negm[r] = -m_reg; asm volatile("" : "+v"(negm)); \
      if (!(FIRST)) { const float f_ = __builtin_amdgcn_exp2f(-dl_); RESC(f_); } } \
    _Pragma("unroll") for (int r = 0; r < 16; ++r) p0[r] = __builtin_amdgcn_exp2f(p0[r]); \
    _Pragma("unroll") for (int r = 0; r < 16; ++r) p1[r] = __builtin_amdgcn_exp2f(p1[r]); \
    _Pragma("unroll") for (int d = 0; d < 4; ++d) { p8[d] = __builtin_amdgcn_cvt_pk_fp8_f32(p0[4 * d], p0[4 * d + 1], p8[d], false); p8[d] = __builtin_amdgcn_cvt_pk_fp8_f32(p0[4 * d + 2], p0[4 * d + 3], p8[d], true); \
      p8[4 + d] = __builtin_amdgcn_cvt_pk_fp8_f32(p1[4 * d], p1[4 * d + 1], p8[4 + d], false); p8[4 + d] = __builtin_amdgcn_cvt_pk_fp8_f32(p1[4 * d + 2], p1[4 * d + 3], p8[4 + d], true); } } while (0)
#define YPH() YSOFT(false)
  if (!pref_in) { ISSUE_L(0, 0); ISSUE_L(1, 1); PBAR_V3(); }
  else PBAR_V0();
  int sx = 1, si = 2;
  if (cq == 0) {
    QKT(0); ISSUE_L(2, si); si = NEXT3(si); PBAR();
    YSOFT(true); PBAR_V3();
    for (int t = 1; t < NT; ++t) {
      __builtin_amdgcn_s_setprio(1); QKT(sx); PV8(sx); sx = NEXT3(sx);
      if (t + 2 <= NT) { ISSUE_L(t + 2, si); si = NEXT3(si); }
      __builtin_amdgcn_s_setprio(0);
      PBAR();
      YPH(); if (t + 2 < NT) PBAR_V3(); else PBAR_V0();
    }
    PV8(sx); PBAR();
    PBAR();
  } else {
    ISSUE_L(2, si); si = NEXT3(si); PBAR();
    QKT(0); PBAR_V3();
    YSOFT(true); PBAR();
    __builtin_amdgcn_s_setprio(1); QKT(sx); PV8(sx); sx = NEXT3(sx); __builtin_amdgcn_s_setprio(0);
    ISSUE_L(3, si); si = NEXT3(si); if (3 < NT) PBAR_V3(); else PBAR_V0();
    for (int t = 2; t < NT; ++t) {
      YPH(); PBAR();
      __builtin_amdgcn_s_setprio(1); QKT(sx); PV8(sx); sx = NEXT3(sx);
      if (t + 2 <= NT) { ISSUE_L(t + 2, si); si = NEXT3(si); }
      __builtin_amdgcn_s_setprio(0);
      if (t + 2 < NT) PBAR_V3(); else PBAR_V0();
    }
    YPH(); PBAR();
    PV8(sx); PBAR();
  }
#undef QKT
#undef PV8
#undef YPH
#undef YSOFT
#undef MX3
#undef ISSUE_L
#undef KROWB
  float rli[16];
#pragma unroll
  for (int r = 0; r < 16; ++r) rli[r] = __builtin_amdgcn_rcpf(o[4][r]);
  PBAR_V0();
  if (pref_out) { const char* Khn = (const char*)Kb + hn * 128;
    pg8::glds16_s(Khn + (size_t)kc0n * DM, koff, ldsK); pg8::glds16_s(Khn + (size_t)(kc0n + 64) * DM, koff, ldsK + 8192u); pg8::glds16_s((const char*)V8n, voff, ldsV + 8192u);
    const unsigned char* Qw = (const unsigned char*)Q + (size_t)(qrow0n + wq * QBLK + r32) * DM + hn * 128 + cq * 64 + hi * 32;
    const u32x4 qa = *reinterpret_cast<const u32x4*>(Qw), qb = *reinterpret_cast<const u32x4*>(Qw + 16); qf = (i32x8){(int)qa.x, (int)qa.y, (int)qa.z, (int)qa.w, (int)qb.x, (int)qb.y, (int)qb.z, (int)qb.w}; }
  float* xb = (float*)(lds + 65536) + wq * (32 * 128);
  if (cq == 1) {
#pragma unroll
    for (int r = 0; r < 16; ++r)
#pragma unroll
      for (int d0 = 0; d0 < 4; ++d0) xb[crow(r, hi) * 128 + d0 * 32 + r32] = o[d0][r] * rli[r];
  }
  PBAR();
  if (cq == 0) {
    float ss[16];
#pragma unroll
    for (int r = 0; r < 16; ++r) { float s = 0.f;
#pragma unroll
      for (int d0 = 0; d0 < 4; ++d0) { const float v = o[d0][r] * rli[r] - lam * xb[crow(r, hi) * 128 + d0 * 32 + r32]; o[d0][r] = v; s += v * v; }
      ss[r] = s; }
#pragma unroll
    for (int r = 0; r < 16; ++r) { float s = half_sum32(ss[r]); ss[r] = __builtin_amdgcn_rsqf(s * (1.0f / 128.0f) + LN_EPS) * (1.0f - LAM_INIT); }
    float gsub[4];
#pragma unroll
    for (int d0 = 0; d0 < 4; ++d0) gsub[d0] = subg[d0 * 32 + r32];
    unsigned char* Ow = (unsigned char*)O + (size_t)(qrow0 + wq * QBLK) * DM + h * 128;
#pragma unroll
    for (int r = 0; r < 16; ++r) { const int orow = crow(r, hi);
#pragma unroll
      for (int d0 = 0; d0 < 4; ++d0) Ow[(size_t)orow * DM + d0 * 32 + r32] = (unsigned char)(cvt_fp8x4(o[d0][r] * ss[r] * gsub[d0], 0.f, 0.f, 0.f) & 0xffu); }
  }
  PBAR();
#undef PBAR
#undef PBAR_V0
#undef PBAR_V3
#undef NEXT3
#undef RESC
}
#undef KSWZ
#undef SBAR
}

struct Args { const float* in[27]; float* out; unsigned char* ws; };
enum { IN_X = 0, IN_C, IN_CTX, IN_CCTX, IN_WMOD, IN_BMOD, IN_LNG, IN_LNB, IN_GWIN, IN_GLNG, IN_GLNB, IN_GWS, IN_GBS, IN_GWOUT, IN_DWQKV, IN_DLAM, IN_DSUBG, IN_DWO,
       IN_CWIN, IN_CW, IN_CWOUT, IN_MWR, IN_MBR, IN_MWGU, IN_MBGU, IN_MWDN, IN_MBDN };


__device__ __forceinline__ const float* inp_ptr(int k) {
    const __attribute__((address_space(4))) char* kp = (const __attribute__((address_space(4))) char*)__builtin_amdgcn_kernarg_segment_ptr();
    asm volatile("" : "+s"(kp));
    return (const float*)*(GAS const float* const __attribute__((address_space(4)))*)(kp + 8 * k);
}
#define INP(k) inp_ptr(k)

struct Frame {
    LAS unsigned char* lds; char* ldsg;
    int tid, lane, wave, G, gw, NGW, bid, wave0;
    float* out; unsigned char* ws; gu32* ctl;
};

__device__ __forceinline__ int drow_map(int kind, int n) {
    if (kind == 1) { if (n < 1024) return 256 * (n >> 7) + (n & 127); const int ff = n - 1024; return 256 * (ff >> 7) + 128 + (ff & 127); }
    if (kind == 2) { if (n < 1024) return 2048 + n; if (n < 2048) { const int ch = n - 1024; return 256 * (ch >> 7) + (ch & 127); } const int ch = n - 2048; return 256 * (ch >> 7) + 128 + (ch & 127); }
    return n;
}
template <bool FP8> __device__ __forceinline__ void p0_transpose_item(const float* W, int K, int N, bf16_t* WT, int kind, LAS float* scr, int item, int lane) {
    const int nblk = N / 32, kb = item / nblk, nb = item % nblk, k0 = 64 * kb, n0 = 32 * nb;
#pragma unroll 8
    for (int i = 0; i < 32; ++i) { const int kk = 2 * i + (lane >> 5); scr[kk * 33 + (lane & 31)] = __builtin_nontemporal_load(&W[(size_t)(k0 + kk) * N + n0 + (lane & 31)]); }
    LDS_WAIT(); asm volatile("" ::: "memory");
    const int c = lane & 7; const int d0 = drow_map(kind, n0);
#pragma unroll
    for (int j = 0; j < 4; ++j) { const int n = (lane >> 3) + 8 * j; const LAS float* s = scr + (8 * c) * 33 + n;
        if (FP8) { u32x2 o; o.x = cvt_fp8x4(s[0 * 33] * W8_SCALE, s[1 * 33] * W8_SCALE, s[2 * 33] * W8_SCALE, s[3 * 33] * W8_SCALE); o.y = cvt_fp8x4(s[4 * 33] * W8_SCALE, s[5 * 33] * W8_SCALE, s[6 * 33] * W8_SCALE, s[7 * 33] * W8_SCALE);
            *(GAS u32x2*)((unsigned char*)WT + (size_t)(d0 + n) * K + k0 + 8 * c) = o; }
        else { u32x4 o; o.x = pk2(s[0 * 33], s[1 * 33]); o.y = pk2(s[2 * 33], s[3 * 33]); o.z = pk2(s[4 * 33], s[5 * 33]); o.w = pk2(s[6 * 33], s[7 * 33]);
            *(GAS u32x4*)(WT + (size_t)(d0 + n) * K + k0 + 8 * c) = o; } }
    LDS_WAIT(); asm volatile("" ::: "memory");
}
template <bool FP8> __device__ __forceinline__ void p0_job(Frame& F, LAS float* scr, long& base, const float* src, int K, int N, int M, bf16_t* dst, int ND, int kind) {
    const int per = (K / 64) * (N / 32); const long tot = (long)per * M;
    long first = (long)F.gw - (base % F.NGW); if (first < 0) first += F.NGW;
    for (long it = first; it < tot; it += F.NGW) { const int mtx = (int)(it / per), loc = (int)(it % per);
        p0_transpose_item<FP8>(src + (size_t)mtx * K * N, K, N, (bf16_t*)((unsigned char*)dst + (size_t)mtx * ND * K * (FP8 ? 1 : 2)), kind, scr, loc, F.lane); }
    base += tot;
}
__device__ __forceinline__ void p0_weights(Frame& F) {
    LAS float* scr = (LAS float*)(F.lds + F.wave * 16384);
    long base = 0;
    p0_job<true>(F, scr, base, INP(IN_GWIN), 1024, 4096, 2, (bf16_t*)(F.ws + WS_WIN), 4096, 0);
    p0_job<false>(F, scr, base, INP(IN_GWOUT), 2048, 1024, 2, (bf16_t*)(F.ws + WS_WOUT), 1024, 0);
    p0_job<true>(F, scr, base, INP(IN_DWQKV), 1024, 3072, 1, (bf16_t*)(F.ws + WS_WQKV), 3072, 0);
    p0_job<true>(F, scr, base, INP(IN_DWO), 1024, 1024, 1, (bf16_t*)(F.ws + WS_WO), 1024, 0);
    p0_job<false>(F, scr, base, INP(IN_CWIN), 1024, 3072, 1, (bf16_t*)(F.ws + WS_CWIN), 3072, 2);
    p0_job<false>(F, scr, base, INP(IN_CWOUT), 1024, 1024, 1, (bf16_t*)(F.ws + WS_CWOUT), 1024, 0);
    p0_job<false>(F, scr, base, INP(IN_MWR), 1024, 32, 4, (bf16_t*)(F.ws + WS_WR), 256, 0);
    p0_job<true>(F, scr, base, INP(IN_MWGU), 1024, 2048, 128, (bf16_t*)(F.ws + WS_WGU), 2048, 1);
    p0_job<true>(F, scr, base, INP(IN_MWDN), 1024, 1024, 128, (bf16_t*)(F.ws + WS_WDN), 1024, 0);
    { const float* src = INP(IN_GWS); bf16_t* dst = (bf16_t*)(F.ws + WS_WS); const int n4 = 2 * 8 * 128 * 128 / 4;
      for (int i = F.gw * 64 + F.lane; i < n4; i += F.NGW * 64) { const f32x4 v = *(const f32x4*)(src + 4 * (size_t)i); u32x2 w; w.x = pk2(v[0], v[1]); w.y = pk2(v[2], v[3]); *(u32x2*)(dst + 4 * (size_t)i) = w; } }
}
__device__ __forceinline__ void p0_mod(Frame& F) {
    LAS float* cond = (LAS float*)(F.lds);
    LAS float* red = (LAS float*)(F.lds + 40960);
    const int nitem = 4 * 96;
    if (F.bid >= nitem) return;
    for (int i = F.tid; i < 9 * 1024; i += 512) { const int m = i >> 10, k = i & 1023; const float c = (m < 8) ? INP(IN_C)[m * 1024 + k] : INP(IN_CCTX)[k]; cond[i] = c / (1.0f + __expf(-c)); }
    __syncthreads();
    float* MOD = (float*)(F.ws + WS_MOD);
    for (int it = F.bid; it < nitem; it += F.G) {
        const int layer = it / 96, n0 = (it % 96) * 64;
        const float* W = INP(IN_WMOD) + (size_t)layer * 1024 * 6144 + n0 + F.lane;
        float acc[9];
#pragma unroll
        for (int m = 0; m < 9; ++m) acc[m] = 0.f;
        const int kb = F.wave * 128;
#pragma unroll 8
        for (int k = 0; k < 128; ++k) { const float w = W[(size_t)(kb + k) * 6144];
#pragma unroll
            for (int m = 0; m < 9; ++m) acc[m] += cond[m * 1024 + kb + k] * w; }
#pragma unroll
        for (int m = 0; m < 9; ++m) red[(F.wave * 9 + m) * 64 + F.lane] = acc[m];
        __syncthreads();
        for (int i = F.tid; i < 9 * 64; i += 512) { const int m = i >> 6, l = i & 63; float s = 0.f;
#pragma unroll
            for (int w = 0; w < 8; ++w) s += red[(w * 9 + m) * 64 + l];
            MOD[((size_t)layer * 9 + m) * 6144 + n0 + l] = s + INP(IN_BMOD)[layer * 6144 + n0 + l]; }
        __syncthreads();
    }
}
__device__ __forceinline__ void p0_misc(Frame& F) {
    const int gt = F.bid * 512 + F.tid;
    if (gt < 2048) { const int pos = gt >> 4, i = gt & 15; const float inv = powf(10000.0f, -(float)i / 16.0f); const float ang = (float)pos * inv; float s, c; sincosf(ang, &s, &c);
        ((float*)(F.ws + WS_ROPE))[gt] = c; ((float*)(F.ws + WS_ROPE))[2048 + gt] = s; }
    if (F.bid == F.G - 1) { bf16_t* H = (bf16_t*)(F.ws + WS_H); for (int i = F.tid; i < 1024; i += 512) H[(size_t)TALL * DM + i] = 0;
        unsigned* H8z = (unsigned*)(F.ws + WS_H8 + (size_t)TALL * DM); for (int i = F.tid; i < 256; i += 512) H8z[i] = 0u; }
}

__device__ __forceinline__ int mod_index(int row) { return row < NCTX ? 8 : ((row - NCTX) >> 13); }

template <int MODE, bool FIRSTX>
__device__ __forceinline__ void row_pass(Frame& F, int layer, bool final_out, int row0) {
    const float* MOD = (const float*)(F.ws + WS_MOD);
    bf16_t* X = (bf16_t*)(F.ws + WS_X); bf16_t* H = (bf16_t*)(F.ws + WS_H);
    const bf16_t* Y = (const bf16_t*)(F.ws + WS_Y); const bf16_t* YK = (const bf16_t*)(F.ws + WS_R1 + R1_YK); const int* TS = (const int*)(F.ws + WS_SLOTDST);
    const int rpw = (TALL - row0 + F.NGW - 1) / F.NGW;
    const int r0 = row0 + F.gw * rpw, r1 = (r0 + rpw < TALL) ? r0 + rpw : TALL;
    const int sub = (MODE == 2) ? 1 : 0;
    const int gate_i = (MODE == 2) ? 5 : 2;
    const int nlayer = (MODE == 2) ? layer + 1 : layer;
    const int sh_i = (MODE == 1) ? 3 : 0, sc_i = (MODE == 1) ? 4 : 1;
    const int lc = 8 * F.lane;
#define RP_COL(q) (lc + 512 * ((q) >> 1) + 4 * ((q) & 1))
    f32x4 lg[4], lb[4], gt[4], sh[4], sc[4];
    if (MODE != 0) {
#pragma unroll
        for (int q = 0; q < 4; ++q) { lg[q] = *(const f32x4*)(INP(IN_LNG) + (layer * 2 + sub) * 1024 + RP_COL(q)); lb[q] = *(const f32x4*)(INP(IN_LNB) + (layer * 2 + sub) * 1024 + RP_COL(q)); } }
    constexpr int NY = (MODE == 2) ? 4 : (MODE == 1 ? 1 : 0);
    f32x4 xf[4], xfn[4]; u32x4 xb[2], xbn[2]; u32x4 yb[NY ? NY : 1][2], ybn[NY ? NY : 1][2];
#define RP_LOAD(row_, XF, XB, YB) do { const int rw_ = (row_); \
        if (FIRSTX) { const float* xr_ = (rw_ < NCTX ? INP(IN_CTX) + (size_t)rw_ * DM : INP(IN_X) + (size_t)(rw_ - NCTX) * DM); _Pragma("unroll") for (int q = 0; q < 4; ++q) XF[q] = *(const f32x4*)(xr_ + RP_COL(q)); } \
        else { _Pragma("unroll") for (int j = 0; j < 2; ++j) XB[j] = *(const u32x4*)(X + (size_t)rw_ * DM + lc + 512 * j); } \
        if (MODE == 1) { _Pragma("unroll") for (int j = 0; j < 2; ++j) YB[0][j] = *(const u32x4*)(Y + (size_t)rw_ * DM + lc + 512 * j); } \
        if (MODE == 2) { const int4 sl_ = *(const int4*)(TS + (size_t)rw_ * 4); const int sk_[4] = {sl_.x, sl_.y, sl_.z, sl_.w}; \
            _Pragma("unroll") for (int k = 0; k < 4; ++k) _Pragma("unroll") for (int j = 0; j < 2; ++j) { const u32x2 t8_ = *(const u32x2*)((const unsigned char*)YK + (size_t)sk_[k] * DM + lc + 512 * j); YB[k][j] = (u32x4){t8_.x, t8_.y, 0u, 0u}; } } } while (0)
#define RP_UNPK(V_, H_) ((H_) ? (f32x4){bflo((V_)[2]), bfhi((V_)[2]), bflo((V_)[3]), bfhi((V_)[3])} : (f32x4){bflo((V_)[0]), bfhi((V_)[0]), bflo((V_)[1]), bfhi((V_)[1])})
    if (r0 < r1) RP_LOAD(r0, xf, xb, yb);
    int curm = -1;
    for (int row = r0; row < r1; ++row) {
        if (row + 1 < r1) RP_LOAD(row + 1, xfn, xbn, ybn);
        const int mi = mod_index(row);
        if (mi != curm) { curm = mi;
#pragma unroll
            for (int q = 0; q < 4; ++q) { const int c = RP_COL(q);
                if (MODE != 0) gt[q] = *(const f32x4*)(MOD + ((size_t)layer * 9 + mi) * 6144 + gate_i * 1024 + c);
                if (!final_out) { sh[q] = *(const f32x4*)(MOD + ((size_t)nlayer * 9 + mi) * 6144 + sh_i * 1024 + c); sc[q] = *(const f32x4*)(MOD + ((size_t)nlayer * 9 + mi) * 6144 + sc_i * 1024 + c); } } }
        f32x4 v[4];
#pragma unroll
        for (int q = 0; q < 4; ++q) v[q] = FIRSTX ? xf[q] : RP_UNPK(xb[q >> 1], q & 1);
        if (MODE != 0) {
#pragma unroll
            for (int q = 0; q < 4; ++q) { f32x4 y = (f32x4){0.f, 0.f, 0.f, 0.f};
#pragma unroll
                for (int k = 0; k < NY; ++k) { if (MODE == 2) { const unsigned w8 = yb[k][q >> 1][q & 1]; const f32x2 lo = __builtin_amdgcn_cvt_pk_f32_fp8((int)w8, false), hi = __builtin_amdgcn_cvt_pk_f32_fp8((int)w8, true); y += (f32x4){lo.x, lo.y, hi.x, hi.y}; }
                                                else y += RP_UNPK(yb[k][q >> 1], q & 1); }
                if (MODE == 2) y = y * (1.0f / YK8_SCALE);
                v[q] = v[q] * DN_ALPHA + gt[q] * y; }
            float s = 0.f;
#pragma unroll
            for (int q = 0; q < 4; ++q) s += (v[q][0] + v[q][1]) + (v[q][2] + v[q][3]);
            const float mean = wave_sum(s) * (1.0f / DM); float qq = 0.f;
#pragma unroll
            for (int q = 0; q < 4; ++q) { v[q] = v[q] - mean; qq += (v[q][0] * v[q][0] + v[q][1] * v[q][1]) + (v[q][2] * v[q][2] + v[q][3] * v[q][3]); }
            const float rstd = 1.0f / sqrtf(wave_sum(qq) * (1.0f / DM) + LN_EPS);
#pragma unroll
            for (int q = 0; q < 4; ++q) v[q] = v[q] * rstd * lg[q] + lb[q];
            if (final_out) { if (row >= NCTX) {
#pragma unroll
                for (int q = 0; q < 4; ++q) *(f32x4*)(F.out + (size_t)(row - NCTX) * DM + RP_COL(q)) = v[q]; } }
            else {
#pragma unroll
                for (int j = 0; j < 2; ++j) { u32x4 w; w.x = pk2(v[2 * j][0], v[2 * j][1]); w.y = pk2(v[2 * j][2], v[2 * j][3]); w.z = pk2(v[2 * j + 1][0], v[2 * j + 1][1]); w.w = pk2(v[2 * j + 1][2], v[2 * j + 1][3]);
                    *(u32x4*)(X + (size_t)row * DM + lc + 512 * j) = w; } }
        }
        if (!final_out) {
#pragma unroll
            for (int j = 0; j < 2; ++j) { const f32x4 h0 = v[2 * j] * (sc[2 * j] + 1.0f) + sh[2 * j], h1 = v[2 * j + 1] * (sc[2 * j + 1] + 1.0f) + sh[2 * j + 1];
                if (MODE == 1 || (nlayer % 3) == 2) { u32x4 w; w.x = pk2(h0[0], h0[1]); w.y = pk2(h0[2], h0[3]); w.z = pk2(h1[0], h1[1]); w.w = pk2(h1[2], h1[3]);
                    *(u32x4*)(H + (size_t)row * DM + lc + 512 * j) = w; }
                if (MODE == 1 || (nlayer % 3) != 2) {                                u32x2 w8; w8.x = cvt_fp8x4(h0[0], h0[1], h0[2], h0[3]); w8.y = cvt_fp8x4(h1[0], h1[1], h1[2], h1[3]); *(u32x2*)(F.ws + WS_H8 + (size_t)row * DM + lc + 512 * j) = w8; } }
        }
#pragma unroll
        for (int q = 0; q < 4; ++q) xf[q] = xfn[q];
#pragma unroll
        for (int j = 0; j < 2; ++j) { xb[j] = xbn[j];
#pragma unroll
            for (int k = 0; k < (NY ? NY : 1); ++k) yb[k][j] = ybn[k][j]; }
    }
#undef RP_LOAD
#undef RP_UNPK
#undef RP_COL
}


__device__ __forceinline__ void gmlp_spatial_fused(Frame& F, int j, int row0) {
    const bf16_t* Z = (const bf16_t*)(F.ws + WS_R1 + R1_Z); const float* PART = (const float*)(F.ws + WS_PART); bf16_t* T = (bf16_t*)(F.ws + WS_R1 + R1_T);
    LAS f32x2* stl = (LAS f32x2*)(F.lds + MISC_OFF + 1024);
    LAS float* bsl = (LAS float*)(F.lds + MISC_OFF + 2048);
    const bf16_t* WSb = (const bf16_t*)(F.ws + WS_WS) + (size_t)j * 8 * 128 * 128; const float* bs = INP(IN_GBS) + j * 8 * 128;
    const float* lng = INP(IN_GLNG) + j * 2048; const float* lnb = INP(IN_GLNB) + j * 2048;
    const int wave = F.wave;
    char* lds = F.ldsg; bf16_t* outl = (bf16_t*)lds; char* wl = lds + 65536;
    const int nunit = ((TALL - row0) / 128) * 8, ch0 = row0 / 128;
#define WSWZ(row, colB) ((row) * 256 + ((colB) ^ (((row) & 7) << 4)))
    const unsigned wlds = (unsigned)__builtin_amdgcn_readfirstlane((int)((unsigned)(uintptr_t)wl + (unsigned)wave * 4096u));
    const int ehalf = wave >> 2, d0 = wave & 3;
    u32x4 zin[8]; f32x4 pin[4];
    int u = F.bid;
#define SP_LANE() const int tid = opaque_tid(wave), lane = tid & 63, r32 = lane & 31, hi = lane >> 5, c8 = tid & 31, q0 = tid >> 5
#define SP_LOAD(uu) do { const int ch_ = ch0 + ((uu) >> 3), g_ = (uu) & 7; _Pragma("unroll") for (int i = 0; i < 8; ++i) zin[i] = *(const u32x4*)(Z + (size_t)(ch_ * 128 + q0 + 16 * i) * 4096 + 2048 + 256 * g_ + 8 * c8); \
        _Pragma("unroll") for (int i = 0; i < 4; ++i) pin[i] = *(const f32x4*)(PART + ((size_t)(ch_ * 128 + (tid >> 2)) * 32 + 8 * (tid & 3)) * 2 + 4 * i); } while (0)
    if (u < nunit) { SP_LANE(); SP_LOAD(u); }
    for (; u < nunit; u += F.G) {
        const int chunk = ch0 + (u >> 3), g = u & 7;
        SP_LANE();
        const int vb = (int)(uintptr_t)lds + ehalf * 16384 + d0 * 512 + att::v_rd_base(lane);
        unsigned woff[4];
#pragma unroll
        for (int i = 0; i < 4; ++i) { const int row = 4 * (4 * wave + i) + (lane >> 4), cpos = (lane & 15) << 4; woff[i] = (unsigned)(row * 256 + (cpos ^ ((row & 7) << 4))); }
        int sto[8];
#pragma unroll
        for (int i = 0; i < 8; ++i) { const int q = q0 + 16 * i, e = 8 * c8; sto[i] = ((q >> 6) * 2 + (e >> 7)) * 16384 + att::v_st(q & 63, e & 127); }
        if (tid < 128) bsl[tid] = bs[g * 128 + tid];
        { const char* wg = (const char*)(WSb + (size_t)g * 128 * 128);
#pragma unroll
          for (int i = 0; i < 4; ++i) pg8::glds16_s(wg, woff[i], wlds + (unsigned)i * 1024u); }
        { float sm = (pin[0][0] + pin[0][2]) + (pin[1][0] + pin[1][2]) + (pin[2][0] + pin[2][2]) + (pin[3][0] + pin[3][2]), sq = (pin[0][1] + pin[0][3]) + (pin[1][1] + pin[1][3]) + (pin[2][1] + pin[2][3]) + (pin[3][1] + pin[3][3]);
          sm += swz_xor_f<1>(sm); sq += swz_xor_f<1>(sq); sm += swz_xor_f<2>(sm); sq += swz_xor_f<2>(sq);
          const float mean = sm * (1.0f / 2048.0f), var = __builtin_fmaxf(sq * (1.0f / 2048.0f) - mean * mean, 0.f);
          if ((tid & 3) == 0) stl[tid >> 2] = (f32x2){mean, 1.0f / sqrtf(var + LN_EPS)}; }
        asm volatile("s_waitcnt lgkmcnt(0)" ::: "memory");
        __syncthreads();
        { const f32x4 ga = *(const f32x4*)(lng + 256 * g + 8 * c8), gb = *(const f32x4*)(lng + 256 * g + 8 * c8 + 4), ba = *(const f32x4*)(lnb + 256 * g + 8 * c8), bb = *(const f32x4*)(lnb + 256 * g + 8 * c8 + 4);
#pragma unroll
          for (int i = 0; i < 8; ++i) { const f32x2 st = stl[q0 + 16 * i]; const u32x4 w = zin[i];
              f32x4 x0 = (f32x4){bflo(w.x), bfhi(w.x), bflo(w.y), bfhi(w.y)}, x1 = (f32x4){bflo(w.z), bfhi(w.z), bflo(w.w), bfhi(w.w)};
              x0 = (x0 - st.x) * st.y * ga + ba; x1 = (x1 - st.x) * st.y * gb + bb;
              *(u32x4*)(lds + sto[i]) = pg8::pack8(x0, x1); } }
        asm volatile("s_waitcnt vmcnt(0) lgkmcnt(0)" ::: "memory");
        __syncthreads();
        const int un = u + F.G;
        u32x4 uin[8];
#pragma unroll
        for (int i = 0; i < 8; ++i) uin[i] = *(const u32x4*)(Z + ((size_t)chunk * 128 + q0 + 16 * i) * 4096 + 256 * g + 8 * c8);
        if (un < nunit) SP_LOAD(un);
        f32x16 acc[4];
#pragma unroll
        for (int mt = 0; mt < 4; ++mt) acc[mt] = f32x16{};
#define SP_KS(QH, KS) do { s16x4 l_, h_; \
            asm volatile("ds_read_b64_tr_b16 %0, %1 offset:%2" : "=&v"(l_) : "v"(vb), "i"((QH) * 32768 + (KS) * 4096) : "memory"); \
            asm volatile("ds_read_b64_tr_b16 %0, %1 offset:%2" : "=&v"(h_) : "v"(vb), "i"((QH) * 32768 + (KS) * 4096 + 2048) : "memory"); \
            bf16x8 af_[4]; _Pragma("unroll") for (int mt = 0; mt < 4; ++mt) af_[mt] = *(const bf16x8*)(wl + WSWZ(32 * mt + r32, (16 * ((QH) * 4 + (KS)) + 8 * hi) * 2)); \
            asm volatile("s_waitcnt lgkmcnt(0)" ::: "memory"); __builtin_amdgcn_sched_barrier(0); \
            const bf16x8 bf_ = (bf16x8){l_[0], l_[1], l_[2], l_[3], h_[0], h_[1], h_[2], h_[3]}; \
            _Pragma("unroll") for (int mt = 0; mt < 4; ++mt) acc[mt] = __builtin_amdgcn_mfma_f32_32x32x16_bf16(af_[mt], bf_, acc[mt], 0, 0, 0); } while (0)
        SP_KS(0, 0); SP_KS(0, 1); SP_KS(0, 2); SP_KS(0, 3); SP_KS(1, 0); SP_KS(1, 1); SP_KS(1, 2); SP_KS(1, 3);
#undef SP_KS
        asm volatile("s_waitcnt lgkmcnt(0)" ::: "memory");
        __syncthreads();
        { const int e = 32 * wave + r32;
#pragma unroll
          for (int mt = 0; mt < 4; ++mt)
#pragma unroll
            for (int r = 0; r < 16; ++r) { const int p = 32 * mt + att::crow(r, hi); outl[p * 256 + e] = (bf16_t)f2bf(acc[mt][r] + bsl[p]); } }
        asm volatile("s_waitcnt lgkmcnt(0)" ::: "memory");
        __syncthreads();
#pragma unroll
        for (int i = 0; i < 8; ++i) { const int p = q0 + 16 * i; const size_t row = (size_t)chunk * 128 + p;
            const u32x4 o = *(const u32x4*)(outl + p * 256 + 8 * c8); const u32x4 uu = uin[i];
            u32x4 t;
#pragma unroll
            for (int e = 0; e < 4; ++e) t[e] = pk2(bflo(o[e]) * bflo(uu[e]), bfhi(o[e]) * bfhi(uu[e]));
            *(u32x4*)(T + row * 2048 + 256 * g + 8 * c8) = t; }
    }
#undef SP_LOAD
#undef SP_LANE
#undef WSWZ
    asm volatile("s_waitcnt lgkmcnt(0)" ::: "memory");
    __syncthreads();
}
__device__ __forceinline__ void conv_mix(Frame& F, int row0) {
    const bf16_t* P = (const bf16_t*)(F.ws + WS_R1 + R1_P); const bf16_t* BG = (const bf16_t*)(F.ws + WS_R1 + R1_BG); bf16_t* T2 = (bf16_t*)(F.ws + WS_R1 + R1_T2);
    const float* cw = INP(IN_CW);
    const int g = F.bid * (NWAVES * 64) + F.tid, c8 = (g & 127) * 8, rng = g >> 7, nrng = (F.G * NWAVES * 64) >> 7;
    const int per = (TALL - row0 + nrng - 1) / nrng, ra = row0 + rng * per, rb = (ra + per < TALL) ? ra + per : TALL;
    f32x4 w0a = *(const f32x4*)(cw + c8), w0b = *(const f32x4*)(cw + c8 + 4), w1a = *(const f32x4*)(cw + 1024 + c8), w1b = *(const f32x4*)(cw + 1024 + c8 + 4), w2a = *(const f32x4*)(cw + 2048 + c8), w2b = *(const f32x4*)(cw + 2048 + c8 + 4);
    for (int r = ra; r < rb; r += 4) {
        u32x4 p[6], b[4];
#pragma unroll
        for (int k = 0; k < 6; ++k) { int rr = r - 1 + k; rr = rr < 0 ? 0 : (rr > TALL - 1 ? TALL - 1 : rr); p[k] = *(const u32x4*)(P + (size_t)rr * DM + c8); }
#pragma unroll
        for (int k = 0; k < 4; ++k) { int rr = r + k; rr = rr > TALL - 1 ? TALL - 1 : rr; b[k] = *(const u32x4*)(BG + (size_t)rr * DM + c8); }
#pragma unroll
        for (int k = 0; k < 4; ++k) { const int row = r + k;
            if (row < rb) {
                const bool first = row < NCTX ? ((row & 255) == 0) : (((row - NCTX) & (SEQ - 1)) == 0);
                const bool last = row < NCTX ? ((row & 255) == 255) : (((row - NCTX) & (SEQ - 1)) == SEQ - 1);
                const u32x4 zero = (u32x4){0u, 0u, 0u, 0u};
                const u32x4 pm = first ? zero : p[k], pc = p[k + 1], pp = last ? zero : p[k + 2], bg = b[k];
                float o[8];
#pragma unroll
                for (int e = 0; e < 4; ++e) {
                    const float t0a = (e < 2) ? w0a[2 * e] : w0b[2 * e - 4], t0b = (e < 2) ? w0a[2 * e + 1] : w0b[2 * e - 3];
                    const float t1a = (e < 2) ? w1a[2 * e] : w1b[2 * e - 4], t1b = (e < 2) ? w1a[2 * e + 1] : w1b[2 * e - 3];
                    const float t2a = (e < 2) ? w2a[2 * e] : w2b[2 * e - 4], t2b = (e < 2) ? w2a[2 * e + 1] : w2b[2 * e - 3];
                    o[2 * e] = bflo(bg[e]) * (t0a * bflo(pm[e]) + t1a * bflo(pc[e]) + t2a * bflo(pp[e]));
                    o[2 * e + 1] = bfhi(bg[e]) * (t0b * bfhi(pm[e]) + t1b * bfhi(pc[e]) + t2b * bfhi(pp[e])); }
                u32x4 w; w.x = pk2(o[0], o[1]); w.y = pk2(o[2], o[3]); w.z = pk2(o[4], o[5]); w.w = pk2(o[6], o[7]);
                *(u32x4*)(T2 + (size_t)row * DM + c8) = w; } }
    }
}

__device__ __forceinline__ void router_phase(Frame& F, const bf16_t* H, int layer, int row0) {
    constexpr int PITCH = 2064;
    char* wl = F.ldsg;
    { const bf16_t* Wr = (const bf16_t*)(F.ws + WS_WR) + (size_t)layer * 256 * 1024;
      for (int i = F.tid; i < 32 * 128; i += NWAVES * 64) { const int r = i >> 7, c = i & 127; *(u32x4*)(wl + r * PITCH + c * 16) = *(const u32x4*)(Wr + (size_t)r * 1024 + c * 8); } }
    asm volatile("s_waitcnt vmcnt(0) lgkmcnt(0)" ::: "memory");
    __syncthreads();
    float* L = (float*)(F.ws + WS_LOGIT);
    const int fr = F.lane & 15, fq = F.lane >> 4;
    const int ng = (TALL - row0) / 16;
    const char* wb = wl + fr * PITCH + fq * 16;
    for (int g = F.wave * F.G + F.bid; g < ng; g += F.NGW) {
        const int tok = row0 + g * 16 + fr;
        const char* hp = (const char*)(H + (size_t)tok * DM) + fq * 16;
        f32x4 acc0 = (f32x4){0.f, 0.f, 0.f, 0.f}, acc1 = (f32x4){0.f, 0.f, 0.f, 0.f};
#pragma clang loop unroll(disable)
        for (int half = 0; half < 2; ++half) {
            u32x4 a[16];
#pragma unroll
            for (int s_ = 0; s_ < 16; ++s_) a[s_] = *(const u32x4*)(hp + half * 1024 + s_ * 64);
#pragma unroll
            for (int s_ = 0; s_ < 16; ++s_) {
                const bf16x8 w0 = *(const bf16x8*)(wb + half * 1024 + s_ * 64), w1 = *(const bf16x8*)(wb + 16 * PITCH + half * 1024 + s_ * 64);
                const bf16x8 hf = __builtin_bit_cast(bf16x8, a[s_]);
                acc0 = __builtin_amdgcn_mfma_f32_16x16x32_bf16(w0, hf, acc0, 0, 0, 0);
                acc1 = __builtin_amdgcn_mfma_f32_16x16x32_bf16(w1, hf, acc1, 0, 0, 0); } }
        *(f32x4*)(L + (size_t)tok * NEXP + 4 * fq) = acc0; *(f32x4*)(L + (size_t)tok * NEXP + 16 + 4 * fq) = acc1;
    }
    asm volatile("s_waitcnt lgkmcnt(0)" ::: "memory");
    __syncthreads();
}

__device__ __forceinline__ void moe_topk(Frame& F, int layer, int row0) {
    const float* L = (const float*)(F.ws + WS_LOGIT); const float* br = INP(IN_MBR) + layer * 32;
    int* TE = (int*)(F.ws + WS_TOKE); float* TG = (float*)(F.ws + WS_TOKG);
    int* ST = (int*)(F.ws + WS_SLOTTOK); int* SD = (int*)(F.ws + WS_SLOTDST); float* SG = (float*)(F.ws + WS_SLOTGATE);
    for (int i = F.bid * 512 + F.tid; i < NSLOT_MAX; i += F.G * 512) { ST[i] = TALL; SG[i] = 0.f; }
    gu32* cnt = F.ctl + CW_CNT + layer * 64;
    for (int g = F.wave * F.G + F.bid; g < (TALL - row0) / 64; g += F.NGW) {
        const int tok = row0 + g * 64 + F.lane;
        float lg[32];
#pragma unroll
        for (int j = 0; j < 8; ++j) { const f32x4 v = *(const f32x4*)(L + (size_t)tok * 32 + 4 * j); const f32x4 b = *(const f32x4*)(br + 4 * j);
            lg[4 * j] = v[0] + b[0]; lg[4 * j + 1] = v[1] + b[1]; lg[4 * j + 2] = v[2] + b[2]; lg[4 * j + 3] = v[3] + b[3]; }
        int e[4]; float tv[4];
#pragma unroll
        for (int k = 0; k < 4; ++k) { float best = -INFINITY; int bi = 0;
#pragma unroll
            for (int i = 0; i < 32; ++i) { const bool take = lg[i] > best; best = take ? lg[i] : best; bi = take ? i : bi; }
            e[k] = bi; tv[k] = best;
#pragma unroll
            for (int i = 0; i < 32; ++i) lg[i] = (i == bi) ? -INFINITY : lg[i]; }
        const float e1 = __expf(tv[1] - tv[0]), e2 = __expf(tv[2] - tv[0]), e3 = __expf(tv[3] - tv[0]); const float inv = 1.0f / (1.0f + e1 + e2 + e3);
        *(int4*)(TE + (size_t)tok * 4) = make_int4(e[0], e[1], e[2], e[3]);
        *(f32x4*)(TG + (size_t)tok * 4) = (f32x4){inv, e1 * inv, e2 * inv, e3 * inv};
        unsigned mycnt = 0;
        for (int x = 0; x < 32; ++x) { unsigned c = 0;
#pragma unroll
            for (int k = 0; k < 4; ++k) c += __popcll(__ballot(e[k] == x));
            if (F.lane == x) mycnt = c; }
        if (F.lane < 32 && mycnt) __hip_atomic_fetch_add(cnt + F.lane, mycnt, RLX_AGENT);
    }
}
__device__ __forceinline__ void moe_scatter(Frame& F, int layer, int row0) {
    const int* TE = (const int*)(F.ws + WS_TOKE); const float* TG = (const float*)(F.ws + WS_TOKG);
    int* ST = (int*)(F.ws + WS_SLOTTOK); int* SD = (int*)(F.ws + WS_SLOTDST); float* SG = (float*)(F.ws + WS_SLOTGATE);
    gu32* cnt = F.ctl + CW_CNT + layer * 64; gu32* cur = F.ctl + CW_CUR + layer * 64;
    unsigned c = (F.lane < 32) ? __hip_atomic_load(cnt + F.lane, RLX_AGENT) : 0u;
    const unsigned padded = (c + 255u) & ~255u; unsigned incl = 0u, total = 0u;
    for (int x = 0; x < 32; ++x) { total += (unsigned)__builtin_amdgcn_readlane((int)padded, x); if (F.lane == x) incl = total; }
    const unsigned pstart = incl - padded;
    if (F.bid == 0 && F.wave == NWAVES - 1) {
        int* BE = (int*)(F.ws + WS_META);
        const unsigned nblk = total / 256u;
        for (unsigned b0 = 0; b0 < nblk; b0 += 64) { const unsigned blk = b0 + F.lane; int ex = 0;
            for (int x = 0; x < 32; ++x) { const unsigned ps = (unsigned)__builtin_amdgcn_readlane((int)pstart, x), pe = (unsigned)__builtin_amdgcn_readlane((int)incl, x); if (blk * 256u >= ps && blk * 256u < pe) ex = x; }
            if (blk < nblk) BE[blk] = ex; }
    }
    for (int g = F.wave * F.G + F.bid; g < (TALL - row0) / 64; g += F.NGW) {
        const int tok = row0 + g * 64 + F.lane;
        const int4 ev = *(const int4*)(TE + (size_t)tok * 4); const f32x4 gv = *(const f32x4*)(TG + (size_t)tok * 4);
        const int e[4] = {ev.x, ev.y, ev.z, ev.w};
        unsigned mycnt = 0; unsigned rank[4] = {0u, 0u, 0u, 0u};
        const unsigned long long lt = (1ull << F.lane) - 1ull;
        for (int x = 0; x < 32; ++x) { unsigned run = 0;
#pragma unroll
            for (int k = 0; k < 4; ++k) { const unsigned long long m = __ballot(e[k] == x); if (e[k] == x) rank[k] = run + (unsigned)__popcll(m & lt); run += (unsigned)__popcll(m); }
            if (F.lane == x) mycnt = run; }
        unsigned base = 0;
        if (F.lane < 32 && mycnt) base = __hip_atomic_fetch_add(cur + F.lane, mycnt, RLX_AGENT);
        base += pstart;
#pragma unroll
        for (int k = 0; k < 4; ++k) { const unsigned slot = (unsigned)__builtin_amdgcn_ds_bpermute(e[k] << 2, (int)base) + rank[k];
            ST[slot] = tok; SG[slot] = gv[k]; SD[tok * 4 + k] = (int)slot; }
    }
}


__device__ __forceinline__ void attn_phase(Frame& F) {
    const bf16_t* Q = (const bf16_t*)(F.ws + WS_R1 + R1_Q); const bf16_t* Kb = (const bf16_t*)(F.ws + WS_R1 + R1_K); const bf16_t* Vb = (const bf16_t*)(F.ws + WS_R1 + R1_V);
    bf16_t* O = (bf16_t*)(F.ws + WS_R1 + R1_O); const unsigned char* V8 = F.ws + WS_R1 + R1_V8;
    float lam;
    { const float* lp = INP(IN_DLAM); const float a = wave_sum(lp[F.lane] * lp[64 + F.lane]), b = wave_sum(lp[128 + F.lane] * lp[192 + F.lane]); lam = expf(a) - expf(b) + LAM_INIT; }
    const float* subg = INP(IN_DSUBG);
    const int bx = F.bid; const int vcu = (F.G % 8 == 0) ? (bx % 8) * (F.G / 8) + bx / 8 : bx;
    i32x8 qfu = i32x8{};
    for (int id = vcu; id < 4096; id += F.G) {
        { const int bh = id >> 6, qb = id & 63, b = bh >> 3, h = bh & 7;
          const int idn = id + F.G; const bool hasn = idn < 4096; const int bhn = hasn ? (idn >> 6) : bh, bn = bhn >> 3, hn = bhn & 7, qbn = hasn ? (idn & 63) : qb;
            att::attn_unit_f8(Q, Kb, V8 + (size_t)bh * 132 * 8192, O, NCTX + b * SEQ + qb * 128, b * CTXL, NCTX + b * SEQ, 4 + SEQ / 64, h, lam, subg, F.ldsg, F.wave0,
                              id != vcu, hasn, V8 + (size_t)bhn * 132 * 8192, bn * CTXL, hn, NCTX + bn * SEQ + qbn * 128, qfu); }
    }
}

__global__ void __launch_bounds__(NWAVES * 64, 2) fwd_kernel(Args args) {
    extern __shared__ __attribute__((aligned(16))) unsigned char lds[];
    Frame F;
    F.lds = (LAS unsigned char*)lds; F.ldsg = (char*)lds;
    F.wave0 = __builtin_amdgcn_readfirstlane((int)(threadIdx.x >> 6));
    F.tid = opaque_tid(F.wave0); F.lane = F.tid & 63; F.wave = F.wave0;
    F.G = gridDim.x; F.bid = blockIdx.x; F.gw = blockIdx.x * NWAVES + F.wave; F.NGW = F.G * NWAVES;
    F.out = args.out; F.ws = args.ws; F.ctl = (gu32*)(args.ws + WS_CTL);
    volatile LAS unsigned* MISC = (volatile LAS unsigned*)(F.lds + MISC_OFF);
    for (int u = F.tid; u < (LDS_BYTES - MISC_OFF) / 4; u += NWAVES * 64) MISC[u] = 0u;
    __syncthreads();
    XcdBarrier bar; bar.bar = (unsigned*)(F.ctl + CW_BAR); bar.x = 0; bar.st = MISC + 8;
    if (F.tid == 0) (void)xb_add(&bar.bar[XB_XCNT(xb_xcc_id())], 1u);
#define GRID_BAR() xcd_barrier(bar, opaque_tid(F.wave0) == 0)
#ifndef PROBE_CLASS
#define PROBE_CLASS 0
#endif
#define PROBE_MULT 4
#if PROBE_CLASS
    unsigned long long pr_t0 = __builtin_amdgcn_s_memrealtime(), pr_acc = 0ull;
#define MARK(c) do { const unsigned long long t_ = __builtin_amdgcn_s_memrealtime(); if ((c) == PROBE_CLASS) pr_acc += t_ - pr_t0; pr_t0 = t_; } while (0)
#else
#define MARK(c) do { } while (0)
#endif
#define REFRESH() do { { int w_ = F.wave0; asm volatile("" : "+s"(w_)); F.wave = w_; } F.tid = opaque_tid(F.wave); F.lane = F.tid & 63; { int b_ = blockIdx.x, g_ = gridDim.x; asm volatile("" : "+s"(b_), "+s"(g_)); F.bid = b_; F.G = g_; F.NGW = g_ * NWAVES; } F.gw = F.bid * NWAVES + F.wave; \
    { GAS unsigned char* g_ = (GAS unsigned char*)F.ws; asm volatile("" : "+s"(g_)); unsigned char* w_ = (unsigned char*)g_; F.ws = w_; F.ctl = (gu32*)(w_ + WS_CTL); R1 = w_ + WS_R1; H = (bf16_t*)(w_ + WS_H); Y = (bf16_t*)(w_ + WS_Y); } } while (0)
    unsigned char* R1 = F.ws + WS_R1;
    bf16_t* H = (bf16_t*)(F.ws + WS_H); bf16_t* Y = (bf16_t*)(F.ws + WS_Y);

    p0_weights(F); __syncthreads(); p0_mod(F); p0_misc(F);
    GRID_BAR(); REFRESH(); MARK(1);
    row_pass<0, true>(F, 0, false, 0);
    GRID_BAR(); REFRESH(); MARK(4);

    for (int layer = 0; layer < DEPTH; ++layer) {
        const int kind = layer % 3, j = layer / 3;
        const int row0i = (layer >= 2) ? NCTX : 0, row0 = (layer >= 1) ? NCTX : 0;
        const int nPanI = (TALL - row0i) / 256, pan0I = row0i / 256, nPan = (TALL - row0) / 256, pan0 = row0 / 256;
        const bf16_t* yA; const bf16_t* yW; int yK;
        if (kind == 0) {
            { pg8::DenseSched S; S.o.init(nPanI, 4096 / 256, F.G, F.bid, pan0I); S.K = 512;
              pg8::EpiGeluStats E{(bf16_t*)(R1 + R1_Z), (float*)(F.ws + WS_PART)};
              pg8::gemm_phase<pg8::EpiGeluStats, pg8::DenseSched, true, true>(F.lds, (const bf16_t*)(F.ws + WS_H8), (const bf16_t*)(F.ws + WS_WIN + (size_t)j * 4096 * 1024), 512, S, E, F.wave0); }
            GRID_BAR(); REFRESH(); MARK(7);
            gmlp_spatial_fused(F, j, row0i);
            GRID_BAR(); REFRESH(); MARK(2);
            yA = (const bf16_t*)(R1 + R1_T); yW = (const bf16_t*)(F.ws + WS_WOUT) + (size_t)j * 1024 * 2048; yK = 2048;
        } else if (kind == 1) {
            { pg8::DenseSched S; S.o.init(nPanI, 3072 / 256, F.G, F.bid, pan0I); S.K = 512;
              pg8::EpiQKV E{(bf16_t*)(R1 + R1_Q), (size_t)(R1_K - R1_Q) / 2, (const float*)(F.ws + WS_ROPE), (const float*)(F.ws + WS_ROPE) + 2048, R1 + R1_V8};
              pg8::gemm_phase<pg8::EpiQKV, pg8::DenseSched, true, true>(F.lds, (const bf16_t*)(F.ws + WS_H8), (const bf16_t*)(F.ws + WS_WQKV), 512, S, E, F.wave0); }
            GRID_BAR(); REFRESH(); MARK(7);
            attn_phase(F);
            GRID_BAR(); REFRESH(); MARK(3);
            yA = (const bf16_t*)(R1 + R1_O); yW = (const bf16_t*)(F.ws + WS_WO); yK = 512;
        } else {
            { pg8::DenseSched S; S.o.init(nPanI, 3072 / 256, F.G, F.bid, pan0I); S.K = 1024;
              pg8::EpiConvIn E{(bf16_t*)(R1 + R1_P), (bf16_t*)(R1 + R1_BG)};
              pg8::gemm_phase<pg8::EpiConvIn, pg8::DenseSched, true>(F.lds, H, (const bf16_t*)(F.ws + WS_CWIN), 1024, S, E, F.wave0); }
            GRID_BAR(); REFRESH(); MARK(7);
            conv_mix(F, row0i);
            GRID_BAR(); REFRESH(); MARK(8);
            yA = (const bf16_t*)(R1 + R1_T2); yW = (const bf16_t*)(F.ws + WS_CWOUT); yK = 1024;
        }
        { pg8::DenseSched S; S.o.init(nPan, 1024 / 256, F.G, F.bid, pan0); S.K = yK;
          pg8::EpiBf16<0> E{Y, 1024};
          if (kind == 1) pg8::gemm_phase<pg8::EpiBf16<0>, pg8::DenseSched, true, true>(F.lds, yA, yW, yK, S, E, F.wave0);
          else pg8::gemm_phase<pg8::EpiBf16<0>, pg8::DenseSched, true>(F.lds, yA, yW, yK, S, E, F.wave0); }
        GRID_BAR(); REFRESH(); MARK(7);
        if (layer == 0) row_pass<1, true>(F, layer, false, row0); else row_pass<1, false>(F, layer, false, row0);
        GRID_BAR(); REFRESH(); MARK(4);
        router_phase(F, H, layer, row0);
        GRID_BAR(); REFRESH(); MARK(5);
        moe_topk(F, layer, row0);
        GRID_BAR(); REFRESH(); MARK(5);
        moe_scatter(F, layer, row0);
        GRID_BAR(); REFRESH(); MARK(5);
        int nblk;
        { unsigned c = (F.lane < 32) ? __hip_atomic_load(F.ctl + CW_CNT + layer * 64 + F.lane, RLX_AGENT) : 0u; unsigned nb = (c + 255u) >> 8;
          nb = wave_sum_u(nb);
          nblk = __builtin_amdgcn_readfirstlane((int)nb); }
        LAS int* lds_be = (LAS int*)(F.lds + MISC_OFF + 4096);
        { const int* BE = (const int*)(F.ws + WS_META); for (int i = F.tid; i < nblk; i += NWAVES * 64) lds_be[i] = BE[i]; }
        __syncthreads();
        { pg8::MoeSched<true> S; S.o.init(nblk, 2048 / 256, F.G, F.bid); S.K = 512; S.N = 2048; S.block_e = lds_be; S.slot_tok = (const int*)(F.ws + WS_SLOTTOK);
          pg8::EpiMoe1 E{(bf16_t*)(R1 + R1_ACT), INP(IN_MBGU) + (size_t)layer * 32 * 2048};
          pg8::gemm_phase<pg8::EpiMoe1, pg8::MoeSched<true>, true, true>(F.lds, (const bf16_t*)(F.ws + WS_H8), (const bf16_t*)(F.ws + WS_WGU + (size_t)layer * 32 * 2048 * 1024), 512, S, E, F.wave0); }
        GRID_BAR(); REFRESH(); MARK(6);
        { pg8::MoeSched<false> S; S.o.init(nblk, 1024 / 256, F.G, F.bid); S.K = 512; S.N = 1024; S.block_e = lds_be; S.slot_tok = nullptr;
          pg8::EpiMoe2 E{(bf16_t*)(R1 + R1_YK), INP(IN_MBDN) + (size_t)layer * 32 * 1024, (const float*)(F.ws + WS_SLOTGATE)};
          pg8::gemm_phase<pg8::EpiMoe2, pg8::MoeSched<false>, true, true>(F.lds, (const bf16_t*)(R1 + R1_ACT), (const bf16_t*)(F.ws + WS_WDN + (size_t)layer * 32 * 1024 * 1024), 512, S, E, F.wave0); }
        GRID_BAR(); REFRESH(); MARK(6);
        row_pass<2, false>(F, layer, layer == DEPTH - 1, row0);
        if (layer != DEPTH - 1) { GRID_BAR(); REFRESH(); MARK(4); }
    }
#if PROBE_CLASS
    GRID_BAR(); MARK(4);
    if (F.bid == 0 && F.tid == 0) { const unsigned long long tend = __builtin_amdgcn_s_memrealtime() + PROBE_MULT * pr_acc; while (__builtin_amdgcn_s_memrealtime() < tend) __builtin_amdgcn_s_sleep(8); }
#endif
}

extern "C" void kernel_launch(void* const* d_in, const int* in_sizes, int n_in, void* d_out, int out_size, void* d_ws, size_t ws_size, hipStream_t stream) {
    static int grid = 0;
    if (grid == 0) {
        if (n_in != 27 || out_size != NLAT * DM || ws_size < WS_END) { fprintf(stderr, "kernel_launch: unexpected shapes (n_in %d, out %d, ws %zu < %zu)\n", n_in, out_size, ws_size, (size_t)WS_END); grid = -1; return; }
        int dev = 0, cus = 0, per_cu = 0;
        if (hipGetDevice(&dev) != hipSuccess || hipDeviceGetAttribute(&cus, hipDeviceAttributeMultiprocessorCount, dev) != hipSuccess) { grid = -1; return; }
        if (hipFuncSetAttribute((const void*)fwd_kernel, hipFuncAttributeMaxDynamicSharedMemorySize, LDS_BYTES) != hipSuccess) { fprintf(stderr, "kernel_launch: hipFuncSetAttribute failed\n"); grid = -1; return; }
        if (hipOccupancyMaxActiveBlocksPerMultiprocessor(&per_cu, (const void*)fwd_kernel, NWAVES * 64, LDS_BYTES) != hipSuccess || per_cu < 1) { fprintf(stderr, "kernel_launch: occupancy query reports %d\n", per_cu); }
        (void)hipGetLastError();
        grid = cus;
    }
    if (grid < 0) return;
    if (hipMemsetAsync((char*)d_ws + WS_CTL, 0, CTL_ZERO_BYTES, stream) != hipSuccess) return;
    Args a{};
    for (int i = 0; i < 27; ++i) a.in[i] = (const float*)d_in[i];
    a.out = (float*)d_out; a.ws = (unsigned char*)d_ws;
    hipLaunchKernelGGL(fwd_kernel, dim3(grid), dim3(NWAVES * 64), LDS_BYTES, stream, a);
}
```
